# Optimizing an MI355X kernel written in HIP

```python
import math
import jax, jax.numpy as jnp
from jax import lax
import numpy as np

D_MODEL = 4096
BATCH = 4
SEQ = 4096
DEPTH = 1

D_MIX = 2 * D_MODEL
D_SSD = D_MIX // 2
D_CONV = D_MIX - D_SSD
SSD_HEAD_DIM = 64
SSD_HEADS = D_SSD // SSD_HEAD_DIM
SSD_GROUPS = 8
SSD_HEADS_PER_GROUP = SSD_HEADS // SSD_GROUPS
SSD_STATE = 128
SSD_CONV_WIDTH = 4
SSD_CHUNK = 128
D_XBC = D_SSD + 2 * SSD_GROUPS * SSD_STATE
SC_CONV_WIDTH = 3
D_IN_PROJ = D_SSD + D_XBC + SSD_HEADS + 3 * D_CONV
PEER_HEADS = 8
PEER_N_KEYS = 128
PEER_N_EXPERTS = PEER_N_KEYS * PEER_N_KEYS
PEER_TOPK = 16
PEER_QUERY_DIM = 256
PEER_TOKEN_BLOCK = 128
RMS_EPS = 1e-6

kernel_name = "hybrid_ssd_shortconv_peer_block"


def rmsnorm(x, w, groups=1):
    shape = x.shape
    xf = x.astype(jnp.float32).reshape(*shape[:-1], groups, shape[-1] // groups)
    xf = xf * lax.rsqrt(jnp.mean(xf * xf, axis=-1, keepdims=True) + RMS_EPS)
    return (xf.reshape(shape) * w.astype(jnp.float32)).astype(x.dtype)


def causal_dwconv(x, w):
    k_w = w.shape[0]
    s = x.shape[1]
    xp = jnp.pad(x, ((0, 0), (k_w - 1, 0), (0, 0)))
    acc = xp[:, k_w - 1:k_w - 1 + s] * w[k_w - 1]
    for k in range(k_w - 1):
        acc = acc + xp[:, k:k + s] * w[k]
    return acc


def ssd_chunked_scan(xh, dt, a_neg, bm, cm):
    b, s = xh.shape[:2]
    nc = s // SSD_CHUNK

    def to_chunks(t):
        return jnp.moveaxis(t.reshape(b, nc, SSD_CHUNK, *t.shape[2:]), 1, 0)

    causal = jnp.tril(jnp.ones((SSD_CHUNK, SSD_CHUNK), dtype=bool))

    def step(state, inp):
        xc, dtc, bc, cc = inp
        acum = jnp.cumsum(dtc * a_neg, axis=1)
        seg = acum[:, :, None] - acum[:, None, :]
        decay = jnp.exp(jnp.where(causal[None, :, :, None, None], seg, -jnp.inf))
        cb = jnp.einsum('btgn,bsgn->btsg', cc, bc)
        xdt = xc * dtc[..., None]
        y_diag = jnp.einsum('btsg,btsgr,bsgrp->btgrp', cb, decay, xdt)
        y_off = jnp.einsum('btgn,bgrpn->btgrp', cc, state) * jnp.exp(acum)[..., None]
        to_end = jnp.exp(acum[:, -1:] - acum)
        new_state = (state * jnp.exp(acum[:, -1])[..., None, None]
                     + jnp.einsum('bsgn,bsgrp->bgrpn', bc, xdt * to_end[..., None]))
        return new_state, y_diag + y_off

    state0 = jnp.zeros((b, SSD_GROUPS, SSD_HEADS_PER_GROUP, SSD_HEAD_DIM, SSD_STATE), jnp.float32)
    _, ys = lax.scan(step, state0, (to_chunks(xh), to_chunks(dt), to_chunks(bm), to_chunks(cm)))
    return jnp.moveaxis(ys, 0, 1).reshape(xh.shape)


def mixer(xn, w_in, ssd_conv_w, ssd_conv_b, ssd_dt_bias, ssd_a_log, ssd_d, ssd_norm_w,
          sc_conv_w, sc_norm_w, w_out):
    b, s, _ = xn.shape
    proj = xn @ w_in
    o1 = D_SSD
    o2 = o1 + D_XBC
    o3 = o2 + SSD_HEADS
    o4 = o3 + D_CONV
    o5 = o4 + D_CONV
    z, xbc, dt_raw, sc_b, sc_c, sc_h = jnp.split(proj, [o1, o2, o3, o4, o5], axis=-1)

    xbc = jax.nn.silu(causal_dwconv(xbc, ssd_conv_w) + ssd_conv_b)
    xs, bm, cm = jnp.split(xbc, [D_SSD, D_SSD + SSD_GROUPS * SSD_STATE], axis=-1)
    dt = jax.nn.softplus(dt_raw.astype(jnp.float32) + ssd_dt_bias.astype(jnp.float32))
    a_neg = -jnp.exp(ssd_a_log.astype(jnp.float32))
    shp_h = (b, s, SSD_GROUPS, SSD_HEADS_PER_GROUP)
    xh = xs.astype(jnp.float32).reshape(*shp_h, SSD_HEAD_DIM)
    y = ssd_chunked_scan(
        xh, dt.reshape(shp_h), a_neg.reshape(SSD_GROUPS, SSD_HEADS_PER_GROUP),
        bm.astype(jnp.float32).reshape(b, s, SSD_GROUPS, SSD_STATE),
        cm.astype(jnp.float32).reshape(b, s, SSD_GROUPS, SSD_STATE))
    y = y + ssd_d.astype(jnp.float32).reshape(SSD_GROUPS, SSD_HEADS_PER_GROUP, 1) * xh
    y = y.reshape(b, s, D_SSD) * jax.nn.silu(z.astype(jnp.float32))
    y_ssd = rmsnorm(y, ssd_norm_w, groups=SSD_GROUPS).astype(xn.dtype)

    y_sc = sc_b * causal_dwconv(sc_c * sc_h, sc_conv_w)
    y_sc = rmsnorm(y_sc, sc_norm_w)

    return jnp.concatenate([y_ssd, y_sc], axis=-1) @ w_out


def peer_ffn(xn, w_query, sub_keys, u_tab, v_tab):
    b, s, d = xn.shape
    t = b * s
    xt = xn.reshape(t, d)
    q = (xt @ w_query).reshape(t, PEER_HEADS, 2, PEER_QUERY_DIM // 2)
    sc = jnp.einsum('thcd,hckd->thck', q.astype(jnp.float32), sub_keys.astype(jnp.float32))
    top_s, top_i = lax.top_k(sc, PEER_TOPK)
    kk = PEER_TOPK * PEER_TOPK
    cand_s = (top_s[:, :, 0, :, None] + top_s[:, :, 1, None, :]).reshape(t, PEER_HEADS, kk)
    cand_i = (top_i[:, :, 0, :, None] * PEER_N_KEYS + top_i[:, :, 1, None, :]).reshape(t, PEER_HEADS, kk)
    best_s, best_pos = lax.top_k(cand_s, PEER_TOPK)
    expert_idx = jnp.take_along_axis(cand_i, best_pos, axis=-1)
    gates = jax.nn.softmax(best_s, axis=-1).astype(xn.dtype)

    nblk = t // PEER_TOKEN_BLOCK
    hk = PEER_HEADS * PEER_TOPK

    def block(args):
        xb, ib, gb = args
        act = jax.nn.gelu(jnp.einsum('td,tkd->tk', xb, u_tab[ib]), approximate=False) * gb
        return jnp.einsum('tk,tkd->td', act, v_tab[ib])

    out = lax.map(block, (xt.reshape(nblk, PEER_TOKEN_BLOCK, d),
                          expert_idx.reshape(nblk, PEER_TOKEN_BLOCK, hk),
                          gates.reshape(nblk, PEER_TOKEN_BLOCK, hk)))
    return out.reshape(b, s, d)


def setup_inputs(seed: int = 0) -> dict:
    key = jax.random.key(seed)
    ks = jax.random.split(key, 20)
    f32 = jnp.float32
    L = DEPTH

    def nrm(k, shape, scale):
        return jax.random.normal(k, shape, f32) * scale

    def gain(k, shape):
        return 1.0 + 0.05 * jax.random.normal(k, shape, f32)

    dt0 = jnp.exp(jax.random.uniform(ks[4], (L, SSD_HEADS), f32)
                  * (math.log(0.1) - math.log(0.001)) + math.log(0.001))
    dt_bias = dt0 + jnp.log(-jnp.expm1(-dt0))
    a_log = jnp.log(jax.random.uniform(ks[5], (L, SSD_HEADS), f32, 1.0, 16.0))
    return {
        "x": nrm(ks[0], (BATCH, SEQ, D_MODEL), 1.0),
        "w_in": nrm(ks[1], (L, D_MODEL, D_IN_PROJ), D_MODEL ** -0.5),
        "ssd_conv_w": nrm(ks[2], (L, SSD_CONV_WIDTH, D_XBC), SSD_CONV_WIDTH ** -0.5),
        "ssd_conv_b": nrm(ks[3], (L, D_XBC), 0.01),
        "ssd_dt_bias": dt_bias,
        "ssd_a_log": a_log,
        "ssd_d": gain(ks[6], (L, SSD_HEADS)),
        "ssd_norm_w": gain(ks[7], (L, D_SSD)),
        "sc_conv_w": nrm(ks[8], (L, SC_CONV_WIDTH, D_CONV), SC_CONV_WIDTH ** -0.5),
        "sc_norm_w": gain(ks[9], (L, D_CONV)),
        "w_out": nrm(ks[10], (L, D_MIX, D_MODEL), D_MIX ** -0.5),
        "norm_mix_w": gain(ks[11], (L, D_MODEL)),
        "norm_ffn_w": gain(ks[12], (L, D_MODEL)),
        "peer_w_query": nrm(ks[13], (L, D_MODEL, PEER_HEADS * PEER_QUERY_DIM), D_MODEL ** -0.5),
        "peer_sub_keys": nrm(ks[14], (L, PEER_HEADS, 2, PEER_N_KEYS, PEER_QUERY_DIM // 2),
                             (PEER_QUERY_DIM // 2) ** -0.5),
        "peer_u": nrm(ks[15], (L, PEER_N_EXPERTS, D_MODEL), D_MODEL ** -0.5),
        "peer_v": nrm(ks[16], (L, PEER_N_EXPERTS, D_MODEL), PEER_HEADS ** -0.5),
        "norm_final_w": gain(ks[17], (D_MODEL,)),
    }


def reference(x, w_in, ssd_conv_w, ssd_conv_b, ssd_dt_bias, ssd_a_log, ssd_d, ssd_norm_w,
              sc_conv_w, sc_norm_w, w_out, norm_mix_w, norm_ffn_w, peer_w_query,
              peer_sub_keys, peer_u, peer_v, norm_final_w):
    h = x
    for l in range(DEPTH):
        xn = rmsnorm(h, norm_mix_w[l])
        h = h + mixer(xn, w_in[l], ssd_conv_w[l], ssd_conv_b[l], ssd_dt_bias[l], ssd_a_log[l],
                      ssd_d[l], ssd_norm_w[l], sc_conv_w[l], sc_norm_w[l], w_out[l])
        xn = rmsnorm(h, norm_ffn_w[l])
        h = h + peer_ffn(xn, peer_w_query[l], peer_sub_keys[l], peer_u[l], peer_v[l])
    return rmsnorm(h, norm_final_w)
```

```cpp
#include <hip/hip_runtime.h>
#include <cstdio>
#include <cstdint>
namespace pg8 {
#define PG8_LAS __attribute__((address_space(3)))
typedef unsigned short bf16_t;
typedef short bf16x8 __attribute__((ext_vector_type(8)));
typedef float f32x4 __attribute__((ext_vector_type(4)));
typedef unsigned u32x4 __attribute__((ext_vector_type(4)));
constexpr int BM = 256, BK = 64, HALF = 128, HTB = HALF * BK * 2  , STAGE_BYTES = 8 * HTB, NXCD = 8, WGM = 8;

__host__ __device__ __forceinline__ int lds_byte(int r, int c) { const int st = (r >> 4) * 2 + (c >> 5), rr = r & 15, cc = c & 31, ob = rr * 64 + cc * 2; return st * 1024 + (ob ^ (((ob >> 9) & 1) << 5)); }
__host__ __device__ __forceinline__ void stage_rc(int b, int& R, int& C) { const int st = b / 1024, sb = b % 1024, swz = sb ^ (((sb >> 9) & 1) << 5); R = (st >> 1) * 16 + swz / 64; C = (st & 1) * 32 + (swz % 64) / 2; }
__host__ __device__ __forceinline__ int perm32(int rho) { const int n = rho >> 4, i = rho & 15; return 8 * (i >> 2) + 4 * n + (i & 3); }

struct Unit { int pm, pn; };
struct Gemm { const bf16_t* A; const bf16_t* Bt; int M, N, K; };

struct StaticOrder {
    int nM, nN, nwg, G, c;
    __host__ __device__ void init(int M, int N, int G_, int c_) { nM = M / BM; nN = N / BM; nwg = nM * nN; G = G_; c = c_; }
    __host__ __device__ bool next(int i, Unit& u) const {
        const long L = (long)i * G + c; if (L >= nwg) return false;
        int wgid = (int)L; { const int q = nwg / NXCD, r = nwg % NXCD, xcd = wgid % NXCD, off = wgid / NXCD; wgid = (xcd < r ? xcd * (q + 1) : r * (q + 1) + (xcd - r) * q) + off; }
        const int nig = WGM * nN, gid = wgid / nig, fm = gid * WGM, gsz = (nM - fm) < WGM ? (nM - fm) : WGM;
        u.pm = fm + ((wgid % nig) % gsz); u.pn = (wgid % nig) / gsz; return true;
    }
    __device__ __forceinline__ void a_ready(const Unit&) const {}
    __device__ __forceinline__ void done(const Unit&) const {}
};

__device__ __forceinline__ unsigned cvt_pk_bf16(float lo, float hi) { unsigned r; asm volatile("v_cvt_pk_bf16_f32 %0, %1, %2" : "=v"(r) : "v"(lo), "v"(hi)); return r; }
typedef float f32x2 __attribute__((ext_vector_type(2)));
__device__ __forceinline__ f32x2 gelu_pk(f32x2 v) {
    const f32x2 av = __builtin_elementwise_abs(v), d = av * 0.2316418882f + 1.0f;
    f32x2 t; t.x = __builtin_amdgcn_rcpf(d.x); t.y = __builtin_amdgcn_rcpf(d.y);
    f32x2 q = t * 0.5307027145f + (-0.7265760135f); q = q * t + 0.7107068705f; q = q * t + (-0.142248368f); q = q * t + 0.127414796f; q = q * t;
    const f32x2 s = (v * v) * (-0.72134752044f);
    f32x2 e; e.x = __builtin_amdgcn_exp2f(s.x); e.y = __builtin_amdgcn_exp2f(s.y);
    const f32x2 m = v * (q * e), r = v - m;
    f32x2 o; o.x = v.x < 0.f ? m.x : r.x; o.y = v.y < 0.f ? m.y : r.y; return o;
}

template <int ACT  > struct EpiBf16 {
    static constexpr bool PERM = true, AFTER_DRAIN = false; static_assert(ACT == 0 || ACT == 1, "EpiBf16: ACT is 0 (none) or 1 (gelu_pk)");
    bf16_t* O; int ldc; const float* bias; int split_cols; size_t split_stride; float scale0;
    __device__ __forceinline__ void operator()(const f32x4 (&acc)[2][2][4][2], const Unit& u, int wr, int wc, int fr, int fq) const {
        const int row0 = u.pm * BM + wr * 64 + fr; int colt = u.pn * BM; bf16_t* base = O;
        float sc = 1.f; if (split_cols) { const int t = colt / split_cols; base += (size_t)t * split_stride; colt -= t * split_cols; if (t == 0) sc = scale0; }
        const int col0 = colt + wc * 32 + 8 * fq, bcol0 = u.pn * BM + wc * 32 + 8 * fq;
        f32x4 bv[2][2];
#pragma unroll
        for (int bj = 0; bj < 2; ++bj)
#pragma unroll
            for (int n = 0; n < 2; ++n) bv[bj][n] = bias ? *(const f32x4*)(bias + bcol0 + bj * HALF + 4 * n) : (f32x4){0.f, 0.f, 0.f, 0.f};
#pragma unroll
        for (int ai = 0; ai < 2; ++ai)
#pragma unroll
            for (int m = 0; m < 4; ++m) { bf16_t* rowp = base + (size_t)(row0 + ai * HALF + m * 16) * ldc + col0;
#pragma unroll
                for (int bj = 0; bj < 2; ++bj) { f32x4 v0 = acc[ai][bj][m][0] + bv[bj][0], v1 = acc[ai][bj][m][1] + bv[bj][1];
                    if (ACT == 1) { f32x2 a = gelu_pk((f32x2){v0[0], v0[1]}), b = gelu_pk((f32x2){v0[2], v0[3]}), c = gelu_pk((f32x2){v1[0], v1[1]}), d = gelu_pk((f32x2){v1[2], v1[3]});
                        v0 = (f32x4){a.x, a.y, b.x, b.y}; v1 = (f32x4){c.x, c.y, d.x, d.y}; }
                    v0 = v0 * sc; v1 = v1 * sc; u32x4 w; w.x = cvt_pk_bf16(v0[0], v0[1]); w.y = cvt_pk_bf16(v0[2], v0[3]); w.z = cvt_pk_bf16(v1[0], v1[1]); w.w = cvt_pk_bf16(v1[2], v1[3]);
                    *(u32x4*)(rowp + bj * HALF) = w; } }
    }
};

struct EpiResF32 {
    static constexpr bool PERM = false, AFTER_DRAIN = false;
    float* C; const float* R; int ldc;
    __device__ __forceinline__ void operator()(const f32x4 (&acc)[2][2][4][2], const Unit& u, int wr, int wc, int fr, int fq) const {
        const int row0 = u.pm * BM + wr * 64 + fr, col0 = u.pn * BM + wc * 32 + 4 * fq;
#pragma unroll
        for (int ai = 0; ai < 2; ++ai)
#pragma unroll
            for (int m = 0; m < 4; ++m) { const size_t off = (size_t)(row0 + ai * HALF + m * 16) * ldc + col0;
#pragma unroll
                for (int bj = 0; bj < 2; ++bj)
#pragma unroll
                    for (int n = 0; n < 2; ++n) { f32x4 r = (f32x4){0.f, 0.f, 0.f, 0.f}; if (R) r = *(const f32x4*)(R + off + bj * HALF + n * 16);
                        *(f32x4*)(C + off + bj * HALF + n * 16) = acc[ai][bj][m][n] + r; }
                asm volatile("" ::: "memory"); }
    }
};
template <class Epi, class Sched, bool ALIGN_EPI = false, bool SP2 = false>
__device__ __forceinline__ void gemm_phase(PG8_LAS unsigned char* lds, const Gemm g, const Sched& S, const Epi& E) {
    const int tid = threadIdx.x, wid = __builtin_amdgcn_readfirstlane(tid >> 6), lane = tid & 63, wr = wid >> 2, wc = wid & 3, fr = lane & 15, fq = lane >> 4;
    const int K = g.K, nt = K / BK;
    unsigned voffA[2], voffB[2];
#pragma unroll
    for (int i = 0; i < 2; ++i) { int R, C; stage_rc(tid * 16 + i * 8192, R, C); const int Rb = Epi::PERM ? ((R & ~31) + perm32(R & 31)) : R;
        voffA[i] = (unsigned)(R * K + C) * 2u; voffB[i] = (unsigned)(Rb * K + C) * 2u; }
    const size_t kstep = (size_t)(BK * 2);
    const size_t hstep = (size_t)HALF * K * 2;
    const size_t tstep = 2 * hstep;
    const unsigned ldsw = (unsigned)wid * 1024u;
    const int aoff = lds_byte(wr * 64 + fr, fq * 8), boff = lds_byte(wc * 32 + fr, fq * 8);
#define PG8_SA(b, h) (((b) * 2 + (h)) * HTB)
#define PG8_SB(b, h) ((4 + (b) * 2 + (h)) * HTB)
#define PG8_STAGE(bufoff, gbase, voff) do { _Pragma("unroll") for (int _i = 0; _i < 2; ++_i) \
        __builtin_amdgcn_global_load_lds((const unsigned*)((const char*)(gbase) + (voff)[_i]), (PG8_LAS unsigned*)(lds + (bufoff) + ldsw + _i * 8192), 16, 0, 0); } while (0)
#define PG8_LDA(dst, b, h) do { _Pragma("unroll") for (int m = 0; m < 4; ++m) _Pragma("unroll") for (int k = 0; k < 2; ++k) dst[m][k] = *(const PG8_LAS bf16x8*)(lds + PG8_SA(b, h) + aoff + m * 2048 + k * 1024); } while (0)
#define PG8_LDB(dst, b, h) do { _Pragma("unroll") for (int n = 0; n < 2; ++n) _Pragma("unroll") for (int k = 0; k < 2; ++k) dst[n][k] = *(const PG8_LAS bf16x8*)(lds + PG8_SB(b, h) + boff + n * 2048 + k * 1024); } while (0)
#define PG8_MMA(ai, bj, At, Bt) do { __builtin_amdgcn_s_setprio(1); _Pragma("unroll") for (int m = 0; m < 4; ++m) _Pragma("unroll") for (int n = 0; n < 2; ++n) _Pragma("unroll") for (int k = 0; k < 2; ++k) \
        acc[ai][bj][m][n] = __builtin_amdgcn_mfma_f32_16x16x32_bf16(Bt[n][k], At[m][k], acc[ai][bj][m][n], 0, 0, 0); __builtin_amdgcn_s_setprio(0); } while (0)
#define PG8_WAIT_V(n) asm volatile("s_waitcnt vmcnt(" #n ")" ::: "memory")
#define PG8_WAIT_L(n) asm volatile("s_waitcnt lgkmcnt(" #n ")" ::: "memory")
#define PG8_BAR __builtin_amdgcn_s_barrier()
#define PG8_SCHED __builtin_amdgcn_sched_barrier(0)
    Unit cur, nxt; int ui = 0;
    if (!S.next(0, cur)) return;
    f32x4 acc[2][2][4][2];
#pragma unroll
    for (int a = 0; a < 2; ++a)
#pragma unroll
        for (int b = 0; b < 2; ++b)
#pragma unroll
            for (int m = 0; m < 4; ++m)
#pragma unroll
                for (int n = 0; n < 2; ++n) acc[a][b][m][n] = (f32x4){0.f, 0.f, 0.f, 0.f};
    bf16x8 At[4][2], B0[2][2], B1[2][2];
    const char* cA = (const char*)g.A + (size_t)cur.pm * tstep; const char* cB = (const char*)g.Bt + (size_t)cur.pn * tstep;
    S.a_ready(cur);
    if constexpr (SP2) {
        PG8_STAGE(PG8_SB(0, 0), cB, voffB); PG8_STAGE(PG8_SB(0, 1), cB + hstep, voffB); PG8_STAGE(PG8_SA(0, 0), cA, voffA); PG8_STAGE(PG8_SA(0, 1), cA + hstep, voffA);
        if (wr == 1) PG8_BAR;
        PG8_WAIT_V(2); PG8_BAR;
        PG8_STAGE(PG8_SB(1, 0), cB + kstep, voffB); PG8_STAGE(PG8_SA(1, 0), cA + kstep, voffA); PG8_STAGE(PG8_SB(1, 1), cB + hstep + kstep, voffB);
        PG8_WAIT_V(6); PG8_BAR;
    } else {
        PG8_STAGE(PG8_SB(0, 0), cB, voffB); PG8_STAGE(PG8_SA(0, 0), cA, voffA); PG8_STAGE(PG8_SB(0, 1), cB + hstep, voffB); PG8_STAGE(PG8_SA(0, 1), cA + hstep, voffA);
        if (wr == 1) PG8_BAR;
        PG8_WAIT_V(4); PG8_BAR;
        PG8_STAGE(PG8_SB(1, 0), cB + kstep, voffB); PG8_STAGE(PG8_SA(1, 0), cA + kstep, voffA); PG8_STAGE(PG8_SB(1, 1), cB + hstep + kstep, voffB);
        PG8_WAIT_V(6); PG8_BAR;
    }
    for (;;) {
        const bool has_next = S.next(ui + 1, nxt);
        const char* nA = has_next ? (const char*)g.A + (size_t)nxt.pm * tstep : cA; const char* nB = has_next ? (const char*)g.Bt + (size_t)nxt.pn * tstep : cB;
        for (int t = 0; t < nt; t += 2) {
            const bool last = (t == nt - 2);
            const char* a1 = cA + (size_t)(t + 1) * kstep;
            const char* a2 = last ? nA : cA + (size_t)(t + 2) * kstep; const char* b2 = last ? nB : cB + (size_t)(t + 2) * kstep;
            const char* a3 = a2 + kstep; const char* b3 = b2 + kstep;
            if (last && has_next) S.a_ready(nxt);
            if constexpr (SP2) {
            PG8_LDB(B0, 0, 0); PG8_LDB(B1, 0, 1); PG8_SCHED; PG8_LDA(At, 0, 0); PG8_STAGE(PG8_SA(1, 1), a1 + hstep, voffA);
            PG8_WAIT_V(8); PG8_WAIT_L(0); PG8_BAR; PG8_MMA(0, 0, At, B0); PG8_MMA(0, 1, At, B1); PG8_BAR; PG8_SCHED;
            PG8_LDA(At, 0, 1); PG8_STAGE(PG8_SB(0, 0), b2, voffB); PG8_STAGE(PG8_SB(0, 1), b2 + hstep, voffB); PG8_STAGE(PG8_SA(0, 0), a2, voffA);
            PG8_WAIT_V(8); PG8_WAIT_L(0); PG8_BAR; PG8_MMA(1, 0, At, B0); PG8_MMA(1, 1, At, B1); PG8_BAR; PG8_SCHED;
            PG8_LDB(B0, 1, 0); PG8_LDB(B1, 1, 1); PG8_SCHED; PG8_LDA(At, 1, 0); PG8_STAGE(PG8_SA(0, 1), a2 + hstep, voffA);
            PG8_WAIT_V(8); PG8_WAIT_L(0); PG8_BAR; PG8_MMA(0, 0, At, B0); PG8_MMA(0, 1, At, B1); PG8_BAR; PG8_SCHED;
            PG8_LDA(At, 1, 1); PG8_STAGE(PG8_SB(1, 0), b3, voffB); PG8_STAGE(PG8_SB(1, 1), b3 + hstep, voffB); PG8_STAGE(PG8_SA(1, 0), a3, voffA);
            PG8_WAIT_V(8); PG8_WAIT_L(0); PG8_BAR; PG8_MMA(1, 0, At, B0); PG8_MMA(1, 1, At, B1); PG8_BAR; PG8_SCHED;
            } else {
            PG8_LDB(B0, 0, 0); PG8_SCHED; PG8_LDA(At, 0, 0); PG8_STAGE(PG8_SA(1, 1), a1 + hstep, voffA);
            PG8_WAIT_L(8); PG8_BAR; PG8_WAIT_L(0); PG8_MMA(0, 0, At, B0); PG8_BAR; PG8_SCHED;
            PG8_LDB(B1, 0, 1); PG8_STAGE(PG8_SB(0, 0), b2, voffB);
            PG8_BAR; PG8_WAIT_L(0); PG8_MMA(0, 1, At, B1); PG8_BAR;
            PG8_LDA(At, 0, 1); PG8_STAGE(PG8_SA(0, 0), a2, voffA);
            PG8_BAR; PG8_WAIT_L(0); PG8_MMA(1, 0, At, B0); PG8_BAR; PG8_SCHED;
            PG8_STAGE(PG8_SB(0, 1), b2 + hstep, voffB);
            PG8_WAIT_V(6); PG8_BAR; PG8_MMA(1, 1, At, B1); PG8_BAR;
            PG8_LDB(B0, 1, 0); PG8_SCHED; PG8_LDA(At, 1, 0); PG8_STAGE(PG8_SA(0, 1), a2 + hstep, voffA);
            PG8_WAIT_L(8); PG8_BAR; PG8_WAIT_L(0); PG8_MMA(0, 0, At, B0); PG8_BAR; PG8_SCHED;
            PG8_LDB(B1, 1, 1); PG8_STAGE(PG8_SB(1, 0), b3, voffB);
            PG8_BAR; PG8_WAIT_L(0); PG8_MMA(0, 1, At, B1); PG8_BAR;
            PG8_LDA(At, 1, 1); PG8_STAGE(PG8_SA(1, 0), a3, voffA);
            PG8_BAR; PG8_WAIT_L(0); PG8_MMA(1, 0, At, B0); PG8_BAR; PG8_SCHED;
            PG8_STAGE(PG8_SB(1, 1), b3 + hstep, voffB);
            PG8_WAIT_V(6); PG8_BAR; PG8_MMA(1, 1, At, B1); PG8_BAR;
            }
        }
        if constexpr (ALIGN_EPI) { if (wr == 0) PG8_BAR; }
        if constexpr (!Epi::AFTER_DRAIN) { E(acc, cur, wr, wc, fr, fq); S.done(cur); }
        if (!has_next) break;
#pragma unroll
        for (int a = 0; a < 2; ++a)
#pragma unroll
            for (int b = 0; b < 2; ++b)
#pragma unroll
                for (int m = 0; m < 4; ++m)
#pragma unroll
                    for (int n = 0; n < 2; ++n) acc[a][b][m][n] = (f32x4){0.f, 0.f, 0.f, 0.f};
        cur = nxt; cA = nA; cB = nB; ++ui;
        if constexpr (ALIGN_EPI) { if (wr == 1) PG8_BAR; }
    }
    PG8_WAIT_V(0);
    if constexpr (!ALIGN_EPI) { if (wr == 0) PG8_BAR; }
    PG8_BAR;
    if constexpr (Epi::AFTER_DRAIN) { E.fused(acc, cur, wr, wc, fr, fq, lds, wid, lane); S.done(cur); }
#undef PG8_SA
#undef PG8_SB
#undef PG8_STAGE
#undef PG8_LDA
#undef PG8_LDB
#undef PG8_MMA
#undef PG8_WAIT_V
#undef PG8_WAIT_L
#undef PG8_BAR
#undef PG8_SCHED
}
}
#ifndef PG8_SP2
#define PG8_SP2 true
#endif
#ifndef PG8_ALIGN
#define PG8_ALIGN true
#endif

constexpr int NWAVES = 8;
#ifndef MK_N_LAUNCHES
#define MK_N_LAUNCHES 9
#endif
constexpr int NPHASE = 9;
constexpr int N_LAUNCHES = MK_N_LAUNCHES;

constexpr int NB = 4, SEQ = 4096, M = NB * SEQ, D = 4096;
constexpr int D_SSD = 4096, D_CONV = 4096, D_MIX = 8192, NH = 64, HD = 64, NG = 8, NS = 128, D_XBC = 6144;
constexpr int NPROJ = 22592, NP = 22784;
constexpr int O_Z = 0, O_X = 4096, O_B = 8192, O_C = 9216, O_DT = 10240, O_SCB = 10304, O_SCC = 14400, O_SCH = 18496;
constexpr int PH = 8, PK = 128, PTOP = 16, PQ = 2048, NEXP = 16384, HK = 128;
constexpr float EPS = 1e-6f;

constexpr size_t MiB = 1u << 20;
constexpr size_t WS_CTL = 0, CTL_ZERO_BYTES = 1 * MiB;
constexpr size_t WS_XN = 1 * MiB;
constexpr size_t WS_WIN = 129 * MiB;
constexpr size_t WS_WOUT = 307 * MiB;
constexpr size_t WS_WQ = 371 * MiB;
constexpr size_t WS_Y = 387 * MiB;
constexpr size_t WS_PROJ = 643 * MiB;
constexpr size_t WS_U = 643 * MiB;
constexpr size_t WS_V = 771 * MiB;
constexpr size_t WS_Q = 899 * MiB;
constexpr size_t WS_SSQ = 1355 * MiB;
constexpr size_t WS_KH = 1359 * MiB;
constexpr size_t WS_IDX = 1360 * MiB;
constexpr size_t WS_GATE = 1368 * MiB;
constexpr size_t WS_END = 1376 * MiB;
static_assert(WS_WIN + (size_t)NP * D * 2 <= WS_WOUT && WS_Y + (size_t)M * D_MIX * 2 <= WS_PROJ && WS_PROJ + (size_t)M * NP * 2 <= WS_SSQ && WS_Q + (size_t)M * PQ * 4 <= WS_SSQ, "d_ws map");
constexpr int CW_TMO = 0, CW_CODE = 1;
constexpr int CW_BAR = 4096;

constexpr int RING_OFF = 0, RING_BYTES = 131072;
constexpr int LDSCTL_OFF = RING_BYTES, MISC_OFF = LDSCTL_OFF + 320;
constexpr int LDS_BYTES = 147456;
static_assert(MISC_OFF + 128 <= LDS_BYTES, "LDS map");

#define GAS __attribute__((address_space(1)))
#define LAS __attribute__((address_space(3)))
typedef unsigned short bf16;
typedef unsigned v4u __attribute__((ext_vector_type(4)));
typedef float f32x4 __attribute__((ext_vector_type(4)));
typedef short bf16x8 __attribute__((ext_vector_type(8)));
typedef GAS unsigned gu32;
typedef GAS unsigned long long gu64;
#define RLX_AGENT __ATOMIC_RELAXED, __HIP_MEMORY_SCOPE_AGENT
#define LDS_WAIT() asm volatile("s_waitcnt lgkmcnt(0)" ::: "memory")
#define VM_WAIT() asm volatile("s_waitcnt vmcnt(0)" ::: "memory")
__device__ __forceinline__ unsigned long long rt() { return __builtin_amdgcn_s_memrealtime(); }
__device__ __forceinline__ unsigned f2bf(float f) { unsigned u = __builtin_bit_cast(unsigned, f); return (u + 0x7fffu + ((u >> 16) & 1u)) >> 16; }
__device__ __forceinline__ unsigned pk2(float lo, float hi) { return f2bf(lo) | (f2bf(hi) << 16); }


#define XB_TMO      128
#define XB_XCNT(j)  (256  + 64 * (j))
#define XB_XSUB(j)  (1280 + 64 * (j))
#define XB_XGEN(j)  (2304 + 64 * (j))
#define XB_TOP      3328
#define XB_TOPGEN   3392
#define XCD_BAR_WORDS 3456
#define XB_SPIN_CAP (1u << 18)

__device__ __forceinline__ unsigned xb_ld(unsigned* p)              { return __hip_atomic_load(p, __ATOMIC_RELAXED, __HIP_MEMORY_SCOPE_AGENT); }
__device__ __forceinline__ unsigned xb_add(unsigned* p, unsigned v) { return __hip_atomic_fetch_add(p, v, __ATOMIC_RELAXED, __HIP_MEMORY_SCOPE_AGENT); }
__device__ __forceinline__ unsigned xb_xcc_id() { return (unsigned)__builtin_amdgcn_s_getreg((3 << 11) | 20) & 0xFu; }
#define XB_SPIN(cond, bar) do { unsigned _sp = 0; while (cond) { __builtin_amdgcn_s_sleep(1); \
    if ((++_sp & 255u) == 0u) { if (xb_ld(&(bar)[XB_TMO])) break; if (_sp > XB_SPIN_CAP) { atomicAdd(&(bar)[XB_TMO], 1u); break; } } } } while (0)

struct XcdBarrier {
    unsigned* bar; unsigned x;
    volatile LAS unsigned* st;
};

__device__ __forceinline__ XcdBarrier xcd_barrier_post(unsigned* bar, volatile LAS unsigned* st) {
    XcdBarrier b; b.bar = bar; b.x = xb_xcc_id(); b.st = st;
    if (threadIdx.x == 0) (void)xb_add(&bar[XB_XCNT(b.x)], 1u);
    return b;
}
__device__ __forceinline__ void xcd_barrier_complete(unsigned* bar, unsigned x, unsigned& nloc, unsigned& nx) {
    const unsigned G = gridDim.x * gridDim.y * gridDim.z;
    unsigned sum, cnt, mine, sp = 0u;
    for (;;) {
        sum = 0u; cnt = 0u; mine = 0u;
#pragma unroll
        for (unsigned j = 0; j < 16; ++j) { const unsigned c = xb_ld(&bar[XB_XCNT(j)]); sum += c; cnt += (c > 0u) ? 1u : 0u; mine = (j == x) ? c : mine; }
        if (sum == G) break;
        __builtin_amdgcn_s_sleep(1);
        if ((++sp & 255u) == 0u) { if (xb_ld(&bar[XB_TMO])) break; if (sp > XB_SPIN_CAP) { atomicAdd(&bar[XB_TMO], 1u); break; } }
    }
    nloc = mine > 0u ? mine : 1u; nx = cnt > 0u ? cnt : 1u;
}

__device__ __forceinline__ void xcd_barrier(const XcdBarrier& b) {
    asm volatile("s_waitcnt vmcnt(0)" ::: "memory");
    __syncthreads();
    if (threadIdx.x == 0) {
        unsigned* bar = b.bar;
        __builtin_amdgcn_s_waitcnt(0);
        unsigned nloc = b.st[0], nx = b.st[1];
        if (nloc == 0u) { xcd_barrier_complete(bar, b.x, nloc, nx); b.st[0] = nloc; b.st[1] = nx; }
        const unsigned old = xb_add(&bar[XB_XSUB(b.x)], 1u);
        const unsigned gen = old / nloc;
        if (old + 1u == (gen + 1u) * nloc) {
            __builtin_amdgcn_fence(__ATOMIC_RELEASE, "agent");
            asm volatile("s_waitcnt vmcnt(0)" ::: "memory");
            const unsigned og = xb_add(&bar[XB_TOP], 1u);
            const unsigned tg = og / nx;
            if (og + 1u == (tg + 1u) * nx) xb_add(&bar[XB_TOPGEN], 1u);
            else XB_SPIN(xb_ld(&bar[XB_TOPGEN]) == tg, bar);
            __builtin_amdgcn_fence(__ATOMIC_ACQUIRE, "agent");
            xb_add(&bar[XB_XGEN(b.x)], 1u);
            asm volatile("s_waitcnt vmcnt(0)" ::: "memory");
        } else {
            XB_SPIN(xb_ld(&bar[XB_XGEN(b.x)]) == gen, bar);
            __builtin_amdgcn_fence(__ATOMIC_ACQUIRE, "agent");
            asm volatile("s_waitcnt vmcnt(0)" ::: "memory");
        }
    }
    __syncthreads();
}


typedef unsigned u32x4 __attribute__((ext_vector_type(4)));
typedef unsigned u32x2 __attribute__((ext_vector_type(2)));
typedef float f32x2 __attribute__((ext_vector_type(2)));
typedef __bf16 bf2_t __attribute__((ext_vector_type(2)));

__device__ __forceinline__ float wave_sum(float v) {
#pragma unroll
    for (int o = 1; o < 64; o <<= 1) v += __shfl_xor(v, o);
    return v;
}
__device__ __forceinline__ unsigned cvtpk(float lo, float hi) { unsigned r; asm volatile("v_cvt_pk_bf16_f32 %0, %1, %2" : "=v"(r) : "v"(lo), "v"(hi)); return r; }
__device__ __forceinline__ float bflo(unsigned w) { return __uint_as_float(w << 16); }
__device__ __forceinline__ float bfhi(unsigned w) { return __uint_as_float(w & 0xffff0000u); }
__device__ __forceinline__ float siluf(float x) { return x / (1.0f + __expf(-x)); }
__device__ __forceinline__ float dot2bf(unsigned a, unsigned b, float c) { return __builtin_amdgcn_fdot2_f32_bf16(__builtin_bit_cast(bf2_t, a), __builtin_bit_cast(bf2_t, b), c, false); }

__device__ __forceinline__ void p0_transpose_item(const float* W, int K, int N, bf16* WT, LAS float* scr, int item, int lane) {
    const int nblk = N / 32, kb = item / nblk, nb = item % nblk, k0 = 64 * kb, n0 = 32 * nb;
#pragma unroll 8
    for (int i = 0; i < 32; ++i) { const int kk = 2 * i + (lane >> 5); scr[kk * 33 + (lane & 31)] = W[(size_t)(k0 + kk) * N + n0 + (lane & 31)]; }
    LDS_WAIT(); asm volatile("" ::: "memory");
    const int c = lane & 7;
#pragma unroll
    for (int j = 0; j < 4; ++j) { const int n = (lane >> 3) + 8 * j; const LAS float* s = scr + (8 * c) * 33 + n;
        v4u o; o.x = pk2(s[0 * 33], s[1 * 33]); o.y = pk2(s[2 * 33], s[3 * 33]); o.z = pk2(s[4 * 33], s[5 * 33]); o.w = pk2(s[6 * 33], s[7 * 33]);
        *(GAS v4u*)(WT + (size_t)(n0 + n) * K + k0 + 8 * c) = o; }
    LDS_WAIT(); asm volatile("" ::: "memory");
}
__device__ __forceinline__ void rms_row_to_bf16(const float* xrow, const float* w, bf16* orow, int lane) {
    const GAS f32x4* xr = (const GAS f32x4*)xrow + lane;
    f32x4 v[16]; float s = 0.f;
#pragma unroll
    for (int j = 0; j < 16; ++j) { v[j] = xr[64 * j]; s += (v[j].x * v[j].x + v[j].y * v[j].y) + (v[j].z * v[j].z + v[j].w * v[j].w); }
    const float rs = 1.0f / sqrtf(wave_sum(s) * (1.f / D) + EPS);
    const GAS f32x4* wr = (const GAS f32x4*)w + lane;
    GAS u32x2* o8 = (GAS u32x2*)orow + lane;
#pragma unroll
    for (int j = 0; j < 16; ++j) { const f32x4 g = wr[64 * j]; u32x2 o; o.x = cvtpk(v[j].x * rs * g.x, v[j].y * rs * g.y); o.y = cvtpk(v[j].z * rs * g.z, v[j].w * rs * g.w); o8[64 * j] = o; }
}

constexpr int TC = 64;
constexpr int SSD_XS = 0, SSD_BS = SSD_XS + TC * 64 * 4, SSD_CS = SSD_BS + TC * 128 * 4, SSD_YB = SSD_CS + TC * 128 * 4, SSD_DT = SSD_YB + TC * 64 * 4, SSD_DA = SSD_DT + TC * 4, SSD_END = SSD_DA + TC * 4;
static_assert(SSD_END <= RING_BYTES, "ssd lds");
__device__ __forceinline__ void ssd_unit(LAS unsigned char* lds, int b, int h, const bf16* PROJ, const float* conv_w, const float* conv_b, const float* dt_bias, const float* a_log, const float* ssd_d,
                                         bf16* Y, float* SSQ, int tid) {
    LAS float* xs = (LAS float*)(lds + SSD_XS); LAS float* Bs = (LAS float*)(lds + SSD_BS); LAS float* Cs = (LAS float*)(lds + SSD_CS);
    LAS float* yb = (LAS float*)(lds + SSD_YB); LAS float* dts = (LAS float*)(lds + SSD_DT); LAS float* dAs = (LAS float*)(lds + SSD_DA);
    const int g = h >> 3;
    const float a_neg = -__expf(a_log[h]), dtb = dt_bias[h], Dh = ssd_d[h];
    const int p = tid >> 3, nb = tid & 7, n0 = nb * 16;
    float hst[16];
#pragma unroll
    for (int j = 0; j < 16; ++j) hst[j] = 0.f;
    const size_t rowbase = (size_t)b * SEQ;
    for (int c = 0; c < SEQ / TC; ++c) {
        const int t0 = c * TC;
        __syncthreads();
        if (tid < 320) {
            const int cg = tid % 40, ts = tid / 40;
            int xbc_ch, pcol; LAS float* dst; int dpitch, dcol;
            if (cg < 8) { xbc_ch = h * 64 + cg * 8; pcol = O_X + xbc_ch; dst = xs; dpitch = 64; dcol = cg * 8; }
            else if (cg < 24) { xbc_ch = D_SSD + g * 128 + (cg - 8) * 8; pcol = O_X + xbc_ch; dst = Bs; dpitch = 128; dcol = (cg - 8) * 8; }
            else { xbc_ch = D_SSD + NG * NS + g * 128 + (cg - 24) * 8; pcol = O_X + xbc_ch; dst = Cs; dpitch = 128; dcol = (cg - 24) * 8; }
            float w[4][8], bias[8];
#pragma unroll
            for (int k = 0; k < 4; ++k)
#pragma unroll
                for (int j = 0; j < 8; ++j) w[k][j] = conv_w[(size_t)k * D_XBC + xbc_ch + j];
#pragma unroll
            for (int j = 0; j < 8; ++j) bias[j] = conv_b[xbc_ch + j];
            float win[3][8];
#pragma unroll
            for (int r = 0; r < 3; ++r) { const int t = t0 + ts * 8 - 3 + r; u32x4 v = (u32x4){0u, 0u, 0u, 0u}; if (t >= 0) v = *(const GAS u32x4*)(PROJ + (rowbase + t) * NP + pcol);
                win[r][0] = bflo(v.x); win[r][1] = bfhi(v.x); win[r][2] = bflo(v.y); win[r][3] = bfhi(v.y); win[r][4] = bflo(v.z); win[r][5] = bfhi(v.z); win[r][6] = bflo(v.w); win[r][7] = bfhi(v.w); }
#pragma unroll
            for (int r = 0; r < 8; ++r) { const int tl = ts * 8 + r; const u32x4 v = *(const GAS u32x4*)(PROJ + (rowbase + t0 + tl) * NP + pcol);
                float cur[8]; cur[0] = bflo(v.x); cur[1] = bfhi(v.x); cur[2] = bflo(v.y); cur[3] = bfhi(v.y); cur[4] = bflo(v.z); cur[5] = bfhi(v.z); cur[6] = bflo(v.w); cur[7] = bfhi(v.w);
                float o[8];
#pragma unroll
                for (int j = 0; j < 8; ++j) { const float s = bias[j] + w[0][j] * win[0][j] + w[1][j] * win[1][j] + w[2][j] * win[2][j] + w[3][j] * cur[j]; o[j] = siluf(s);
                    win[0][j] = win[1][j]; win[1][j] = win[2][j]; win[2][j] = cur[j]; }
                *(LAS f32x4*)(dst + tl * dpitch + dcol) = (f32x4){o[0], o[1], o[2], o[3]}; *(LAS f32x4*)(dst + tl * dpitch + dcol + 4) = (f32x4){o[4], o[5], o[6], o[7]}; }
        } else if (tid < 320 + TC) {
            const int tl = tid - 320; const float raw = __uint_as_float((unsigned)PROJ[(rowbase + t0 + tl) * NP + O_DT + h] << 16) + dtb;
            const float dt = raw > 20.f ? raw : log1pf(__expf(raw));
            dts[tl] = dt; dAs[tl] = __expf(dt * a_neg);
        }
        __syncthreads();
        for (int i = 0; i < TC; ++i) {
            const float dA = dAs[i], xv = xs[i * 64 + p] * dts[i];
            const LAS f32x4* Bp = (const LAS f32x4*)(Bs + i * 128 + n0); const LAS f32x4* Cp = (const LAS f32x4*)(Cs + i * 128 + n0);
            float acc = 0.f;
#pragma unroll
            for (int q = 0; q < 4; ++q) { const f32x4 bv = Bp[q], cv = Cp[q];
                hst[4 * q + 0] = hst[4 * q + 0] * dA + xv * bv.x; acc += hst[4 * q + 0] * cv.x;
                hst[4 * q + 1] = hst[4 * q + 1] * dA + xv * bv.y; acc += hst[4 * q + 1] * cv.y;
                hst[4 * q + 2] = hst[4 * q + 2] * dA + xv * bv.z; acc += hst[4 * q + 2] * cv.z;
                hst[4 * q + 3] = hst[4 * q + 3] * dA + xv * bv.w; acc += hst[4 * q + 3] * cv.w; }
            acc += __shfl_xor(acc, 1); acc += __shfl_xor(acc, 2); acc += __shfl_xor(acc, 4);
            if (nb == 0) yb[i * 64 + p] = acc;
        }
        __syncthreads();
        {
            const int tl = tid >> 3, p8 = (tid & 7) * 8; const size_t row = rowbase + t0 + tl;
            const u32x4 zv = *(const GAS u32x4*)(PROJ + row * NP + O_Z + h * 64 + p8);
            float z[8]; z[0] = bflo(zv.x); z[1] = bfhi(zv.x); z[2] = bflo(zv.y); z[3] = bfhi(zv.y); z[4] = bflo(zv.z); z[5] = bfhi(zv.z); z[6] = bflo(zv.w); z[7] = bfhi(zv.w);
            float y[8], sq = 0.f;
#pragma unroll
            for (int j = 0; j < 8; ++j) { y[j] = (yb[tl * 64 + p8 + j] + Dh * xs[tl * 64 + p8 + j]) * siluf(z[j]); sq += y[j] * y[j]; }
            u32x4 o; o.x = cvtpk(y[0], y[1]); o.y = cvtpk(y[2], y[3]); o.z = cvtpk(y[4], y[5]); o.w = cvtpk(y[6], y[7]);
            *(GAS u32x4*)(Y + row * D_MIX + h * 64 + p8) = o;
            sq += __shfl_xor(sq, 1); sq += __shfl_xor(sq, 2); sq += __shfl_xor(sq, 4);
            if ((tid & 7) == 0) SSQ[row * NH + h] = sq;
        }
    }
}

__device__ __forceinline__ void unpack8(const u32x4 v, float (&f)[8]) { f[0] = bflo(v.x); f[1] = bfhi(v.x); f[2] = bflo(v.y); f[3] = bfhi(v.y); f[4] = bflo(v.z); f[5] = bfhi(v.z); f[6] = bflo(v.w); f[7] = bfhi(v.w); }
__device__ __forceinline__ void p3_row(int row, const bf16* PROJ, const float* sc_w, const float* sc_nw, const float* ssd_nw, const float* SSQ, bf16* Y, LAS float* scr, int lane) {
    const int s = row & (SEQ - 1);
    const bf16* pr = PROJ + (size_t)row * NP + lane * 8;
    float ss = 0.f;
#pragma unroll 1
    for (int i = 0; i < 8; ++i) {
        const int c0 = (i * 64 + lane) * 8; const bf16* q = pr + i * 512;
        float u0[8], u1[8], u2[8], cb[8], tmpc[8], tmph[8];
        { const u32x4 cv = *(const GAS u32x4*)(q + O_SCC), hv = *(const GAS u32x4*)(q + O_SCH); unpack8(cv, tmpc); unpack8(hv, tmph);
#pragma unroll
          for (int j = 0; j < 8; ++j) u2[j] = tmpc[j] * tmph[j]; }
#pragma unroll
        for (int j = 0; j < 8; ++j) { u1[j] = 0.f; u0[j] = 0.f; }
        if (s >= 1) { const u32x4 cv = *(const GAS u32x4*)(q - NP + O_SCC), hv = *(const GAS u32x4*)(q - NP + O_SCH); unpack8(cv, tmpc); unpack8(hv, tmph);
#pragma unroll
          for (int j = 0; j < 8; ++j) u1[j] = tmpc[j] * tmph[j]; }
        if (s >= 2) { const u32x4 cv = *(const GAS u32x4*)(q - 2 * NP + O_SCC), hv = *(const GAS u32x4*)(q - 2 * NP + O_SCH); unpack8(cv, tmpc); unpack8(hv, tmph);
#pragma unroll
          for (int j = 0; j < 8; ++j) u0[j] = tmpc[j] * tmph[j]; }
        { const u32x4 bv = *(const GAS u32x4*)(q + O_SCB); unpack8(bv, cb); }
        const f32x4 w0a = *(const GAS f32x4*)(sc_w + c0), w0b = *(const GAS f32x4*)(sc_w + c0 + 4), w1a = *(const GAS f32x4*)(sc_w + D_CONV + c0), w1b = *(const GAS f32x4*)(sc_w + D_CONV + c0 + 4),
                    w2a = *(const GAS f32x4*)(sc_w + 2 * D_CONV + c0), w2b = *(const GAS f32x4*)(sc_w + 2 * D_CONV + c0 + 4);
        const float w0[8] = {w0a.x, w0a.y, w0a.z, w0a.w, w0b.x, w0b.y, w0b.z, w0b.w}, w1[8] = {w1a.x, w1a.y, w1a.z, w1a.w, w1b.x, w1b.y, w1b.z, w1b.w}, w2[8] = {w2a.x, w2a.y, w2a.z, w2a.w, w2b.x, w2b.y, w2b.z, w2b.w};
        float y[8];
#pragma unroll
        for (int j = 0; j < 8; ++j) { y[j] = cb[j] * (w2[j] * u2[j] + w0[j] * u0[j] + w1[j] * u1[j]); ss += y[j] * y[j]; }
        *(LAS f32x4*)(scr + c0) = (f32x4){y[0], y[1], y[2], y[3]}; *(LAS f32x4*)(scr + c0 + 4) = (f32x4){y[4], y[5], y[6], y[7]};
    }
    const float rs = 1.0f / sqrtf(wave_sum(ss) * (1.f / D_CONV) + EPS);
    bf16* yrow = Y + (size_t)row * D_MIX + lane * 8;
#pragma unroll 1
    for (int i = 0; i < 8; ++i) { const int c0 = (i * 64 + lane) * 8;
        const f32x4 ya = *(const LAS f32x4*)(scr + c0), yb2 = *(const LAS f32x4*)(scr + c0 + 4);
        const f32x4 ga = *(const GAS f32x4*)(sc_nw + c0), gb = *(const GAS f32x4*)(sc_nw + c0 + 4);
        u32x4 o; o.x = cvtpk(ya.x * rs * ga.x, ya.y * rs * ga.y); o.y = cvtpk(ya.z * rs * ga.z, ya.w * rs * ga.w); o.z = cvtpk(yb2.x * rs * gb.x, yb2.y * rs * gb.y); o.w = cvtpk(yb2.z * rs * gb.z, yb2.w * rs * gb.w);
        *(GAS u32x4*)(yrow + D_SSD + i * 512) = o; }
    const float myssq = SSQ[(size_t)row * NH + lane];
    float gs = myssq; gs += __shfl_xor(gs, 1); gs += __shfl_xor(gs, 2); gs += __shfl_xor(gs, 4);
#pragma unroll 1
    for (int i = 0; i < 8; ++i) { const int c0 = (i * 64 + lane) * 8;
        const float rg = 1.0f / sqrtf(__shfl(gs, i * 8) * (1.f / 512.f) + EPS);
        const u32x4 yv8 = *(const GAS u32x4*)(yrow + i * 512); float f[8]; unpack8(yv8, f);
        const f32x4 ga = *(const GAS f32x4*)(ssd_nw + c0), gb = *(const GAS f32x4*)(ssd_nw + c0 + 4);
        u32x4 o; o.x = cvtpk(f[0] * rg * ga.x, f[1] * rg * ga.y); o.y = cvtpk(f[2] * rg * ga.z, f[3] * rg * ga.w); o.z = cvtpk(f[4] * rg * gb.x, f[5] * rg * gb.y); o.w = cvtpk(f[6] * rg * gb.z, f[7] * rg * gb.w);
        *(GAS u32x4*)(yrow + i * 512) = o; }
}

constexpr int KROW = 272;
constexpr int RT_KH = 0, RT_KL = 128 * KROW, RT_LST = 2 * 128 * KROW, RT_END = RT_LST + 2 * 128 * 16 * 4;
static_assert(RT_END <= RING_BYTES, "route lds");
__device__ __forceinline__ unsigned ord_enc(float s) { const unsigned b = __float_as_uint(s); return (b & 0x80000000u) ? ~b : (b | 0x80000000u); }
__device__ __forceinline__ float ord_dec(unsigned p) { const unsigned o = p & ~127u; return __uint_as_float((o & 0x80000000u) ? (o & 0x7fffffffu) : ~o); }
__device__ __forceinline__ void route_unit(LAS unsigned char* lds, int tile, int h, const float* Q, const bf16* KHI, const bf16* KLO, int* IDX, float* GATE, int tid, int wave, int lane) {
    LAS unsigned* lst = (LAS unsigned*)(lds + RT_LST);
    const int tok0 = tile * 128, kq = lane >> 4, lr = lane & 15;
    for (int c = 0; c < 2; ++c) {
        __syncthreads();
#pragma unroll
        for (int i = 0; i < 4; ++i) { const int q = tid + 512 * i, row = q >> 4, c8 = q & 15; const size_t src = ((size_t)((h * 2 + c) * 128 + row)) * 128 + c8 * 8;
            *(LAS u32x4*)(lds + RT_KH + row * KROW + c8 * 16) = *(const GAS u32x4*)(KHI + src);
            *(LAS u32x4*)(lds + RT_KL + row * KROW + c8 * 16) = *(const GAS u32x4*)(KLO + src); }
        __syncthreads();
        const float* qp = Q + (size_t)(tok0 + wave * 16 + lr) * PQ + h * 256 + c * 128 + kq * 8;
        bf16x8 qh[4], ql[4];
#pragma unroll
        for (int ks = 0; ks < 4; ++ks) { const f32x4 a = *(const GAS f32x4*)(qp + 32 * ks), b = *(const GAS f32x4*)(qp + 32 * ks + 4);
            const float f[8] = {a.x, a.y, a.z, a.w, b.x, b.y, b.z, b.w}; unsigned hi[4], lo[4];
#pragma unroll
            for (int j = 0; j < 4; ++j) { hi[j] = cvtpk(f[2 * j], f[2 * j + 1]); lo[j] = cvtpk(f[2 * j] - bflo(hi[j]), f[2 * j + 1] - bfhi(hi[j])); }
            qh[ks] = __builtin_bit_cast(bf16x8, (u32x4){hi[0], hi[1], hi[2], hi[3]}); ql[ks] = __builtin_bit_cast(bf16x8, (u32x4){lo[0], lo[1], lo[2], lo[3]}); }
        f32x4 acc[8];
#pragma unroll
        for (int t = 0; t < 8; ++t) { acc[t] = (f32x4){0.f, 0.f, 0.f, 0.f};
#pragma unroll
            for (int ks = 0; ks < 4; ++ks) { const int off = (t * 16 + lr) * KROW + (ks * 32 + kq * 8) * 2;
                const bf16x8 ah = *(const LAS bf16x8*)(lds + RT_KH + off), al = *(const LAS bf16x8*)(lds + RT_KL + off);
                acc[t] = __builtin_amdgcn_mfma_f32_16x16x32_bf16(ah, qh[ks], acc[t], 0, 0, 0);
                acc[t] = __builtin_amdgcn_mfma_f32_16x16x32_bf16(al, qh[ks], acc[t], 0, 0, 0);
                acc[t] = __builtin_amdgcn_mfma_f32_16x16x32_bf16(ah, ql[ks], acc[t], 0, 0, 0); } }
        unsigned L[16];
#pragma unroll
        for (int j = 0; j < 16; ++j) L[j] = 0u;
#pragma unroll
        for (int t = 0; t < 8; ++t)
#pragma unroll
            for (int r = 0; r < 4; ++r) { unsigned x = (ord_enc(acc[t][r]) & ~127u) | (unsigned)(127 - (16 * t + 4 * kq + r));
#pragma unroll
                for (int j = 0; j < 16; ++j) { const unsigned hi = L[j] > x ? L[j] : x; x = L[j] > x ? x : L[j]; L[j] = hi; } }
#pragma unroll
        for (int rd = 0; rd < 16; ++rd) { unsigned m = L[0]; { const unsigned o = (unsigned)__shfl_xor((int)m, 16); m = m > o ? m : o; } { const unsigned o = (unsigned)__shfl_xor((int)m, 32); m = m > o ? m : o; }
            const bool pop = (L[0] == m);
#pragma unroll
            for (int j = 0; j < 15; ++j) L[j] = pop ? L[j + 1] : L[j];
            L[15] = pop ? 0u : L[15];
            if (kq == 0) lst[(c * 128 + wave * 16 + lr) * 16 + rd] = m; }
    }
    __syncthreads();
    if (tid < 128) {
        const LAS unsigned* l0 = lst + (0 * 128 + tid) * 16; const LAS unsigned* l1 = lst + (1 * 128 + tid) * 16;
        float fr[16]; const float s10 = ord_dec(l1[0]);
#pragma unroll
        for (int a = 0; a < 16; ++a) fr[a] = ord_dec(l0[a]) + s10;
        unsigned long long P = 0ull; float bs[16]; int be[16];
#pragma unroll
        for (int k = 0; k < 16; ++k) {
            float best = fr[0]; int ba = 0;
#pragma unroll
            for (int a = 1; a < 16; ++a) { const bool gt = fr[a] > best; best = gt ? fr[a] : best; ba = gt ? a : ba; }
            const int pb = (int)((P >> (4 * ba)) & 15ull);
            const unsigned p0 = l0[ba], p1 = l1[pb];
            bs[k] = best; be[k] = (127 - (int)(p0 & 127u)) * PK + (127 - (int)(p1 & 127u));
            const int nb2 = pb + 1; float nf = -3.0e38f;
            if (nb2 < 16) { P += 1ull << (4 * ba); nf = ord_dec(p0) + ord_dec(l1[nb2]); }
#pragma unroll
            for (int a = 0; a < 16; ++a) fr[a] = (a == ba) ? nf : fr[a];
        }
        float e[16], sum = 0.f;
#pragma unroll
        for (int k = 0; k < 16; ++k) { e[k] = __expf(bs[k] - bs[0]); sum += e[k]; }
        const float inv = 1.0f / sum;
        int* ip = IDX + (size_t)(tok0 + tid) * HK + h * 16; float* gp = GATE + (size_t)(tok0 + tid) * HK + h * 16;
#pragma unroll
        for (int k = 0; k < 16; ++k) { ip[k] = be[k]; gp[k] = e[k] * inv; }
    }
}

__device__ __forceinline__ float gelu_erf(float v) { return 0.5f * v * (1.0f + erff(v * 0.70710678118654752f)); }
__device__ __forceinline__ void gather_token(LAS unsigned char* lds, int token, const bf16* XN, const bf16* U, const bf16* V, const int* IDX, const float* GATE, float* HO, const float* wfin, int tid, int wave, int lane) {
    LAS float* red = (LAS float*)lds;
    LAS float* part = (LAS float*)(lds + LDSCTL_OFF + 64);
    u32x4 xv[8];
    { const GAS u32x4* xr = (const GAS u32x4*)(XN + (size_t)token * D) + lane;
#pragma unroll
      for (int i = 0; i < 8; ++i) xv[i] = xr[64 * i]; }
    int myidx = 0; float mygate = 0.f;
    if (lane < 16) { myidx = IDX[(size_t)token * HK + wave * 16 + lane]; mygate = GATE[(size_t)token * HK + wave * 16 + lane]; }
    float myact = 0.f;
#pragma unroll 2
    for (int k = 0; k < 16; ++k) {
        const int e = __builtin_amdgcn_readlane(myidx, k);
        const GAS u32x4* ur = (const GAS u32x4*)(U + (size_t)e * D) + lane;
        float d = 0.f;
#pragma unroll
        for (int i = 0; i < 8; ++i) { const u32x4 uv = ur[64 * i]; d = dot2bf(uv.x, xv[i].x, d); d = dot2bf(uv.y, xv[i].y, d); d = dot2bf(uv.z, xv[i].z, d); d = dot2bf(uv.w, xv[i].w, d); }
        d = wave_sum(d);
        const float gl = gelu_erf(d);
        if (lane == k) myact = gl * mygate;
    }
    float o[64];
#pragma unroll
    for (int j = 0; j < 64; ++j) o[j] = 0.f;
#pragma unroll 2
    for (int k = 0; k < 16; ++k) {
        const int e = __builtin_amdgcn_readlane(myidx, k);
        const float a = __uint_as_float((unsigned)__builtin_amdgcn_readlane((int)__float_as_uint(myact), k));
        const GAS u32x4* vr = (const GAS u32x4*)(V + (size_t)e * D) + lane;
#pragma unroll
        for (int i = 0; i < 8; ++i) { const u32x4 vv = vr[64 * i];
            o[8 * i + 0] += a * bflo(vv.x); o[8 * i + 1] += a * bfhi(vv.x); o[8 * i + 2] += a * bflo(vv.y); o[8 * i + 3] += a * bfhi(vv.y);
            o[8 * i + 4] += a * bflo(vv.z); o[8 * i + 5] += a * bfhi(vv.z); o[8 * i + 6] += a * bflo(vv.w); o[8 * i + 7] += a * bfhi(vv.w); }
    }
#pragma unroll
    for (int i = 0; i < 8; ++i) { LAS f32x4* w = (LAS f32x4*)(red + wave * D + (i * 64 + lane) * 8); w[0] = (f32x4){o[8 * i], o[8 * i + 1], o[8 * i + 2], o[8 * i + 3]}; w[1] = (f32x4){o[8 * i + 4], o[8 * i + 5], o[8 * i + 6], o[8 * i + 7]}; }
    __syncthreads();
    float h2[8];
    { const GAS f32x4* hp = (const GAS f32x4*)(HO + (size_t)token * D + tid * 8); const f32x4 a = hp[0], b = hp[1];
      h2[0] = a.x; h2[1] = a.y; h2[2] = a.z; h2[3] = a.w; h2[4] = b.x; h2[5] = b.y; h2[6] = b.z; h2[7] = b.w; }
#pragma unroll
    for (int w = 0; w < 8; ++w) { const LAS f32x4* r = (const LAS f32x4*)(red + w * D + tid * 8); const f32x4 a = r[0], b = r[1];
        h2[0] += a.x; h2[1] += a.y; h2[2] += a.z; h2[3] += a.w; h2[4] += b.x; h2[5] += b.y; h2[6] += b.z; h2[7] += b.w; }
    float ss = 0.f;
#pragma unroll
    for (int j = 0; j < 8; ++j) ss += h2[j] * h2[j];
    ss = wave_sum(ss);
    if (lane == 0) part[wave] = ss;
    __syncthreads();
    float tot = 0.f;
#pragma unroll
    for (int w = 0; w < 8; ++w) tot += part[w];
    const float rs = 1.0f / sqrtf(tot * (1.f / D) + EPS);
    { const GAS f32x4* gp = (const GAS f32x4*)(wfin + tid * 8); const f32x4 ga = gp[0], gb = gp[1];
      GAS f32x4* op = (GAS f32x4*)(HO + (size_t)token * D + tid * 8);
      op[0] = (f32x4){h2[0] * rs * ga.x, h2[1] * rs * ga.y, h2[2] * rs * ga.z, h2[3] * rs * ga.w}; op[1] = (f32x4){h2[4] * rs * gb.x, h2[5] * rs * gb.y, h2[6] * rs * gb.z, h2[7] * rs * gb.w}; }
    __syncthreads();
}

struct Args { const float* in[18]; float* out; unsigned char* ws; int ph_lo, ph_hi, li, pad; };
__global__ void __launch_bounds__(NWAVES * 64, 2) mk_fwd(Args args) {
    extern __shared__ __attribute__((aligned(16))) unsigned char lds_raw[];
    LAS unsigned char* lds = (LAS unsigned char*)lds_raw;
    volatile LAS unsigned* MISC = (volatile LAS unsigned*)(lds + MISC_OFF);
    const int tid = threadIdx.x, lane = tid & 63, wave = __builtin_amdgcn_readfirstlane(tid >> 6);
    const int G = gridDim.x, bid = blockIdx.x;
    const int vcu = (G % 8 == 0) ? (bid % 8) * (G / 8) + bid / 8 : bid;
    unsigned char* ws = args.ws;
    gu32* ctl = (gu32*)(ws + WS_CTL);
    const float* x = args.in[0]; const float* w_in = args.in[1]; const float* ssd_conv_w = args.in[2]; const float* ssd_conv_b = args.in[3]; const float* ssd_dt_bias = args.in[4];
    const float* ssd_a_log = args.in[5]; const float* ssd_d = args.in[6]; const float* ssd_norm_w = args.in[7]; const float* sc_conv_w = args.in[8]; const float* sc_norm_w = args.in[9];
    const float* w_out = args.in[10]; const float* norm_mix_w = args.in[11]; const float* norm_ffn_w = args.in[12]; const float* w_query = args.in[13]; const float* sub_keys = args.in[14];
    const float* peer_u = args.in[15]; const float* peer_v = args.in[16]; const float* norm_final_w = args.in[17];
    float* out = args.out;
    bf16* XN = (bf16*)(ws + WS_XN); bf16* WIN = (bf16*)(ws + WS_WIN); bf16* WOUT = (bf16*)(ws + WS_WOUT); bf16* WQ = (bf16*)(ws + WS_WQ); bf16* Y = (bf16*)(ws + WS_Y); bf16* PROJ = (bf16*)(ws + WS_PROJ);
    bf16* UB = (bf16*)(ws + WS_U); bf16* VB = (bf16*)(ws + WS_V); float* QF = (float*)(ws + WS_Q); float* SSQ = (float*)(ws + WS_SSQ); bf16* KHI = (bf16*)(ws + WS_KH); bf16* KLO = KHI + 8 * 2 * 128 * 128;
    int* IDX = (int*)(ws + WS_IDX); float* GATE = (float*)(ws + WS_GATE);

    for (int u = tid; u < (LDS_BYTES - LDSCTL_OFF) / 4; u += NWAVES * 64) ((LAS unsigned*)(lds + LDSCTL_OFF))[u] = 0u;
    __syncthreads();
    XcdBarrier bar; bar.bar = (unsigned*)(ctl + CW_BAR); bar.x = 0; bar.st = nullptr;
    if (N_LAUNCHES == 1) bar = xcd_barrier_post((unsigned*)(ctl + CW_BAR), MISC + 8);
#define GRID_BAR() do { if (N_LAUNCHES == 1) xcd_barrier(bar); } while (0)
    const int lo = args.ph_lo, hi = args.ph_hi;
#ifndef PH_MASK
#define PH_MASK 0x1ff
#endif
#define PH_EN(k) (((PH_MASK) >> (k)) & 1)
#define IN(k) (lo <= (k) && (k) < hi)
#define BOTH(k) (IN(k) && IN((k) + 1))
    const int gw = vcu * NWAVES + wave, NGW = G * NWAVES;

    if (PH_EN(0) && IN(0)) {
        LAS float* scr = (LAS float*)(lds + RING_OFF + wave * 16384);
        constexpr int I_IN = (D / 64) * (NPROJ / 32), I_OUT = (D_MIX / 64) * (D / 32), I_Q = (D / 64) * (PQ / 32);
        for (int it = gw; it < I_IN + I_OUT + I_Q; it += NGW) {
            int r = it;
            if (r < I_IN) { p0_transpose_item(w_in, D, NPROJ, WIN, scr, r, lane); continue; } r -= I_IN;
            if (r < I_OUT) { p0_transpose_item(w_out, D_MIX, D, WOUT, scr, r, lane); continue; } r -= I_OUT;
            p0_transpose_item(w_query, D, PQ, WQ, scr, r, lane);
        }
        { GAS v4u* z = (GAS v4u*)(WIN + (size_t)NPROJ * D); const size_t n16 = (size_t)(NP - NPROJ) * D * 2 / 16;
          for (size_t i = (size_t)bid * 512 + tid; i < n16; i += (size_t)G * 512) z[i] = (v4u){0u, 0u, 0u, 0u}; }
        for (int i = bid * 512 + tid; i < 8 * 2 * 128 * 128 / 2; i += G * 512) { const float a = sub_keys[2 * i], b = sub_keys[2 * i + 1]; const unsigned hi2 = cvtpk(a, b); const unsigned lo2 = cvtpk(a - bflo(hi2), b - bfhi(hi2));
            ((GAS unsigned*)KHI)[i] = hi2; ((GAS unsigned*)KLO)[i] = lo2; }
        for (int m = gw; m < M; m += NGW) rms_row_to_bf16(x + (size_t)m * D, norm_mix_w, XN + (size_t)m * D, lane);
        if (BOTH(0)) GRID_BAR();
    }
    if (PH_EN(1) && IN(1)) {
        pg8::Gemm g{XN, WIN, M, NP, D}; pg8::StaticOrder S; S.init(M, NP, G, bid);
        pg8::EpiBf16<0> E{PROJ, NP, nullptr, 0, 0, 1.f};
        pg8::gemm_phase<pg8::EpiBf16<0>, pg8::StaticOrder, PG8_ALIGN, PG8_SP2>(lds + RING_OFF, g, S, E);
        if (BOTH(1)) GRID_BAR();
    }
    if (PH_EN(2) && IN(2)) {
        for (int u = bid; u < NB * NH; u += G) {
            const int xc = u & 7, j = u >> 3, bg = xc * 4 + (j >> 3), hh = j & 7, b = bg >> 3, gq = bg & 7, h = gq * 8 + hh;
            ssd_unit(lds + RING_OFF, b, h, PROJ, ssd_conv_w, ssd_conv_b, ssd_dt_bias, ssd_a_log, ssd_d, Y, SSQ, tid);
        }
        if (BOTH(2)) GRID_BAR();
    }
    if (PH_EN(3) && IN(3)) {
        for (int m = gw; m < M; m += NGW) p3_row(m, PROJ, sc_conv_w, sc_norm_w, ssd_norm_w, SSQ, Y, (LAS float*)(lds + RING_OFF + wave * 16384), lane);
        if (BOTH(3)) GRID_BAR();
    }
    if (PH_EN(4) && IN(4)) {
        pg8::Gemm g{Y, WOUT, M, D, D_MIX}; pg8::StaticOrder S; S.init(M, D, G, bid);
        pg8::EpiResF32 E{out, x, D};
        pg8::gemm_phase<pg8::EpiResF32, pg8::StaticOrder, PG8_ALIGN, PG8_SP2>(lds + RING_OFF, g, S, E);
        if (BOTH(4)) GRID_BAR();
    }
    if (PH_EN(5) && IN(5)) {
        for (int m = gw; m < M; m += NGW) rms_row_to_bf16(out + (size_t)m * D, norm_ffn_w, XN + (size_t)m * D, lane);
        const size_t n8 = (size_t)NEXP * D / 8;
        for (size_t i = (size_t)bid * 512 + tid; i < 2 * n8; i += (size_t)G * 512) {
            const bool second = i >= n8; const size_t k = second ? i - n8 : i; const float* src = (second ? peer_v : peer_u) + k * 8; bf16* dst = (second ? VB : UB) + k * 8;
            const f32x4 a = *(const GAS f32x4*)src, b = *(const GAS f32x4*)(src + 4);
            u32x4 o; o.x = cvtpk(a.x, a.y); o.y = cvtpk(a.z, a.w); o.z = cvtpk(b.x, b.y); o.w = cvtpk(b.z, b.w);
            *(GAS u32x4*)dst = o; }
        if (BOTH(5)) GRID_BAR();
    }
    if (PH_EN(6) && IN(6)) {
        pg8::Gemm g{XN, WQ, M, PQ, D}; pg8::StaticOrder S; S.init(M, PQ, G, bid);
        pg8::EpiResF32 E{QF, nullptr, PQ};
        pg8::gemm_phase<pg8::EpiResF32, pg8::StaticOrder, PG8_ALIGN, PG8_SP2>(lds + RING_OFF, g, S, E);
        if (BOTH(6)) GRID_BAR();
    }
    if (PH_EN(7) && IN(7)) {
        for (int u = bid; u < (M / 128) * PH; u += G) route_unit(lds + RING_OFF, u >> 3, u & 7, QF, KHI, KLO, IDX, GATE, tid, wave, lane);
        if (BOTH(7)) GRID_BAR();
    }
    if (PH_EN(8) && IN(8)) {
        for (int t = bid; t < M; t += G) gather_token(lds, t, XN, UB, VB, IDX, GATE, out, norm_final_w, tid, wave, lane);
    }
#undef IN
#undef BOTH
#undef GRID_BAR
}

extern "C" void kernel_launch(void* const* d_in, const int* in_sizes, int n_in, void* d_out, int out_size, void* d_ws, size_t ws_size, hipStream_t stream) {
    static int grid = 0;
    if (grid == 0) {
        if (n_in != 18 || in_sizes[0] != M * D || out_size != M * D || ws_size < WS_END) { fprintf(stderr, "kernel_launch: unexpected shapes / workspace: n_in %d in0 %d out %d ws %zu (need %zu)\n", n_in, n_in > 0 ? in_sizes[0] : -1, out_size, ws_size, (size_t)WS_END); grid = -1; return; }
        int dev = 0, cus = 0, per_cu = 0;
        if (hipGetDevice(&dev) != hipSuccess || hipDeviceGetAttribute(&cus, hipDeviceAttributeMultiprocessorCount, dev) != hipSuccess) { fprintf(stderr, "kernel_launch: device query failed\n"); grid = -1; return; }
        if (hipFuncSetAttribute((const void*)mk_fwd, hipFuncAttributeMaxDynamicSharedMemorySize, LDS_BYTES) != hipSuccess) { fprintf(stderr, "kernel_launch: hipFuncSetAttribute failed\n"); grid = -1; return; }
        if (hipOccupancyMaxActiveBlocksPerMultiprocessor(&per_cu, (const void*)mk_fwd, NWAVES * 64, LDS_BYTES) != hipSuccess || per_cu < 1)
            fprintf(stderr, "kernel_launch: note: occupancy query reports %d workgroups per CU\n", per_cu);
        (void)hipGetLastError();
        grid = cus;
    }
    if (grid < 0) return;
    if (hipMemsetAsync((char*)d_ws + WS_CTL, 0, CTL_ZERO_BYTES, stream) != hipSuccess) { fprintf(stderr, "kernel_launch: memset failed\n"); return; }
    Args a{};
    for (int i = 0; i < 18; ++i) a.in[i] = (const float*)d_in[i];
    a.out = (float*)d_out; a.ws = (unsigned char*)d_ws;
    for (int li = 0; li < N_LAUNCHES; ++li) {
        a.ph_lo = (N_LAUNCHES == 1) ? 0 : li; a.ph_hi = (N_LAUNCHES == 1) ? NPHASE : li + 1; a.li = li; a.pad = 0;
        hipLaunchKernelGGL(mk_fwd, dim3(grid), dim3(NWAVES * 64), LDS_BYTES, stream, a);
        const hipError_t le = hipPeekAtLastError();
        if (le != hipSuccess) { fprintf(stderr, "kernel_launch: launch %d failed: %s\n", li, hipGetErrorName(le)); break; }
    }
}
```

```cpp
#include <hip/hip_runtime.h>
#include <cstdio>
#include <cstdint>
namespace pg8 {
#define PG8_LAS __attribute__((address_space(3)))
typedef unsigned short bf16_t;
typedef short bf16x8 __attribute__((ext_vector_type(8)));
typedef float f32x4 __attribute__((ext_vector_type(4)));
typedef unsigned u32x4 __attribute__((ext_vector_type(4)));
constexpr int BM = 256, BK = 64, HALF = 128, HTB = HALF * BK * 2  , STAGE_BYTES = 8 * HTB, NXCD = 8, WGM = 8;

__host__ __device__ __forceinline__ int lds_byte(int r, int c) { const int st = (r >> 4) * 2 + (c >> 5), rr = r & 15, cc = c & 31, ob = rr * 64 + cc * 2; return st * 1024 + (ob ^ (((ob >> 9) & 1) << 5)); }
__host__ __device__ __forceinline__ void stage_rc(int b, int& R, int& C) { const int st = b / 1024, sb = b % 1024, swz = sb ^ (((sb >> 9) & 1) << 5); R = (st >> 1) * 16 + swz / 64; C = (st & 1) * 32 + (swz % 64) / 2; }
__host__ __device__ __forceinline__ int perm32(int rho) { const int n = rho >> 4, i = rho & 15; return 8 * (i >> 2) + 4 * n + (i & 3); }

struct Unit { int pm, pn; };
struct Gemm { const bf16_t* A; const bf16_t* Bt; int M, N, K; };

struct StaticOrder {
    int nM, nN, nwg, G, c;
    __host__ __device__ void init(int M, int N, int G_, int c_) { nM = M / BM; nN = N / BM; nwg = nM * nN; G = G_; c = c_; }
    __host__ __device__ bool next(int i, Unit& u) const {
        const long L = (long)i * G + c; if (L >= nwg) return false;
        int wgid = (int)L; { const int q = nwg / NXCD, r = nwg % NXCD, xcd = wgid % NXCD, off = wgid / NXCD; wgid = (xcd < r ? xcd * (q + 1) : r * (q + 1) + (xcd - r) * q) + off; }
        const int nig = WGM * nN, gid = wgid / nig, fm = gid * WGM, gsz = (nM - fm) < WGM ? (nM - fm) : WGM;
        u.pm = fm + ((wgid % nig) % gsz); u.pn = (wgid % nig) / gsz; return true;
    }
    __device__ __forceinline__ void a_ready(const Unit&) const {}
    __device__ __forceinline__ void done(const Unit&) const {}
};

__device__ __forceinline__ unsigned cvt_pk_bf16(float lo, float hi) { unsigned r; asm volatile("v_cvt_pk_bf16_f32 %0, %1, %2" : "=v"(r) : "v"(lo), "v"(hi)); return r; }
typedef float f32x2 __attribute__((ext_vector_type(2)));
__device__ __forceinline__ f32x2 gelu_pk(f32x2 v) {
    const f32x2 av = __builtin_elementwise_abs(v), d = av * 0.2316418882f + 1.0f;
    f32x2 t; t.x = __builtin_amdgcn_rcpf(d.x); t.y = __builtin_amdgcn_rcpf(d.y);
    f32x2 q = t * 0.5307027145f + (-0.7265760135f); q = q * t + 0.7107068705f; q = q * t + (-0.142248368f); q = q * t + 0.127414796f; q = q * t;
    const f32x2 s = (v * v) * (-0.72134752044f);
    f32x2 e; e.x = __builtin_amdgcn_exp2f(s.x); e.y = __builtin_amdgcn_exp2f(s.y);
    const f32x2 m = v * (q * e), r = v - m;
    f32x2 o; o.x = v.x < 0.f ? m.x : r.x; o.y = v.y < 0.f ? m.y : r.y; return o;
}

template <int ACT  > struct EpiBf16 {
    static constexpr bool PERM = true, AFTER_DRAIN = false; static_assert(ACT == 0 || ACT == 1, "EpiBf16: ACT is 0 (none) or 1 (gelu_pk)");
    bf16_t* O; int ldc; const float* bias; int split_cols; size_t split_stride; float scale0;
    __device__ __forceinline__ void operator()(const f32x4 (&acc)[2][2][4][2], const Unit& u, int wr, int wc, int fr, int fq) const {
        const int row0 = u.pm * BM + wr * 64 + fr; int colt = u.pn * BM; bf16_t* base = O;
        float sc = 1.f; if (split_cols) { const int t = colt / split_cols; base += (size_t)t * split_stride; colt -= t * split_cols; if (t == 0) sc = scale0; }
        const int col0 = colt + wc * 32 + 8 * fq, bcol0 = u.pn * BM + wc * 32 + 8 * fq;
        f32x4 bv[2][2];
#pragma unroll
        for (int bj = 0; bj < 2; ++bj)
#pragma unroll
            for (int n = 0; n < 2; ++n) bv[bj][n] = bias ? *(const f32x4*)(bias + bcol0 + bj * HALF + 4 * n) : (f32x4){0.f, 0.f, 0.f, 0.f};
#pragma unroll
        for (int ai = 0; ai < 2; ++ai)
#pragma unroll
            for (int m = 0; m < 4; ++m) { bf16_t* rowp = base + (size_t)(row0 + ai * HALF + m * 16) * ldc + col0;
#pragma unroll
                for (int bj = 0; bj < 2; ++bj) { f32x4 v0 = acc[ai][bj][m][0] + bv[bj][0], v1 = acc[ai][bj][m][1] + bv[bj][1];
                    if (ACT == 1) { f32x2 a = gelu_pk((f32x2){v0[0], v0[1]}), b = gelu_pk((f32x2){v0[2], v0[3]}), c = gelu_pk((f32x2){v1[0], v1[1]}), d = gelu_pk((f32x2){v1[2], v1[3]});
                        v0 = (f32x4){a.x, a.y, b.x, b.y}; v1 = (f32x4){c.x, c.y, d.x, d.y}; }
                    v0 = v0 * sc; v1 = v1 * sc; u32x4 w; w.x = cvt_pk_bf16(v0[0], v0[1]); w.y = cvt_pk_bf16(v0[2], v0[3]); w.z = cvt_pk_bf16(v1[0], v1[1]); w.w = cvt_pk_bf16(v1[2], v1[3]);
                    __builtin_nontemporal_store(w, (u32x4*)(rowp + bj * HALF)); } }
    }
};

struct EpiResF32 {
    static constexpr bool PERM = false, AFTER_DRAIN = false;
    float* C; const float* R; int ldc;
    __device__ __forceinline__ void operator()(const f32x4 (&acc)[2][2][4][2], const Unit& u, int wr, int wc, int fr, int fq) const {
        const int row0 = u.pm * BM + wr * 64 + fr, col0 = u.pn * BM + wc * 32 + 4 * fq;
#pragma unroll
        for (int ai = 0; ai < 2; ++ai)
#pragma unroll
            for (int m = 0; m < 4; ++m) { const size_t off = (size_t)(row0 + ai * HALF + m * 16) * ldc + col0;
#pragma unroll
                for (int bj = 0; bj < 2; ++bj)
#pragma unroll
                    for (int n = 0; n < 2; ++n) { f32x4 r = (f32x4){0.f, 0.f, 0.f, 0.f}; if (R) r = *(const f32x4*)(R + off + bj * HALF + n * 16);
                        __builtin_nontemporal_store(acc[ai][bj][m][n] + r, (f32x4*)(C + off + bj * HALF + n * 16)); }
                asm volatile("" ::: "memory"); }
    }
};
struct EpiResBf16 {
    static constexpr bool PERM = true, AFTER_DRAIN = false;
    bf16_t* O; const float* R; int ldc;
    __device__ __forceinline__ void operator()(const f32x4 (&acc)[2][2][4][2], const Unit& u, int wr, int wc, int fr, int fq) const {
        const int row0 = u.pm * BM + wr * 64 + fr, col0 = u.pn * BM + wc * 32 + 8 * fq;
#pragma unroll
        for (int ai = 0; ai < 2; ++ai)
#pragma unroll
            for (int m = 0; m < 4; ++m) { const size_t off = (size_t)(row0 + ai * HALF + m * 16) * ldc + col0;
#pragma unroll
                for (int bj = 0; bj < 2; ++bj) { const f32x4 r0 = __builtin_nontemporal_load((const f32x4*)(R + off + bj * HALF)), r1 = __builtin_nontemporal_load((const f32x4*)(R + off + bj * HALF + 4));
                    const f32x4 v0 = acc[ai][bj][m][0] + r0, v1 = acc[ai][bj][m][1] + r1;
                    u32x4 w; w.x = cvt_pk_bf16(v0[0], v0[1]); w.y = cvt_pk_bf16(v0[2], v0[3]); w.z = cvt_pk_bf16(v1[0], v1[1]); w.w = cvt_pk_bf16(v1[2], v1[3]);
                    __builtin_nontemporal_store(w, (u32x4*)(O + off + bj * HALF)); }
                asm volatile("" ::: "memory"); }
    }
};
struct EpiProj {
    static constexpr bool PERM = true, AFTER_DRAIN = false;
    bf16_t* O; int ldc, ch_tile0, ch_tiles, u_col0;
    __device__ __forceinline__ void operator()(const f32x4 (&acc)[2][2][4][2], const Unit& u, int wr, int wc, int fr, int fq) const {
        const int row0 = u.pm * BM + wr * 64 + fr, cin = wc * 32 + 8 * fq;
        const bool chv = u.pn >= ch_tile0 && u.pn < ch_tile0 + ch_tiles;
        if (chv) { const int col0 = u_col0 + (u.pn - ch_tile0) * HALF + cin;
#pragma unroll
            for (int ai = 0; ai < 2; ++ai)
#pragma unroll
                for (int m = 0; m < 4; ++m) { const f32x4 v0 = acc[ai][0][m][0] * acc[ai][1][m][0], v1 = acc[ai][0][m][1] * acc[ai][1][m][1];
                    u32x4 w; w.x = cvt_pk_bf16(v0[0], v0[1]); w.y = cvt_pk_bf16(v0[2], v0[3]); w.z = cvt_pk_bf16(v1[0], v1[1]); w.w = cvt_pk_bf16(v1[2], v1[3]);
                    __builtin_nontemporal_store(w, (u32x4*)(O + (size_t)(row0 + ai * HALF + m * 16) * ldc + col0)); }
        } else { const int col0 = (u.pn >= ch_tile0 + ch_tiles ? u.pn - ch_tiles / 2 : u.pn) * BM + cin;
#pragma unroll
            for (int ai = 0; ai < 2; ++ai)
#pragma unroll
                for (int m = 0; m < 4; ++m) { bf16_t* rowp = O + (size_t)(row0 + ai * HALF + m * 16) * ldc + col0;
#pragma unroll
                    for (int bj = 0; bj < 2; ++bj) { const f32x4 v0 = acc[ai][bj][m][0], v1 = acc[ai][bj][m][1];
                        u32x4 w; w.x = cvt_pk_bf16(v0[0], v0[1]); w.y = cvt_pk_bf16(v0[2], v0[3]); w.z = cvt_pk_bf16(v1[0], v1[1]); w.w = cvt_pk_bf16(v1[2], v1[3]);
                        __builtin_nontemporal_store(w, (u32x4*)(rowp + bj * HALF)); } }
        }
    }
};
struct EpiRowScaleF32 {
    static constexpr bool PERM = false, AFTER_DRAIN = false;
    float* C; const float* rowscale; int ldc;
    __device__ __forceinline__ void operator()(const f32x4 (&acc)[2][2][4][2], const Unit& u, int wr, int wc, int fr, int fq) const {
        const int row0 = u.pm * BM + wr * 64 + fr, col0 = u.pn * BM + wc * 32 + 4 * fq;
#pragma unroll
        for (int ai = 0; ai < 2; ++ai)
#pragma unroll
            for (int m = 0; m < 4; ++m) { const int row = row0 + ai * HALF + m * 16; const float rsv = rowscale[row]; const size_t off = (size_t)row * ldc + col0;
#pragma unroll
                for (int bj = 0; bj < 2; ++bj)
#pragma unroll
                    for (int n = 0; n < 2; ++n) __builtin_nontemporal_store(acc[ai][bj][m][n] * rsv, (f32x4*)(C + off + bj * HALF + n * 16)); }
    }
};
template <class Epi, class Sched, bool ALIGN_EPI = false, bool SP2 = false>
__device__ __forceinline__ void gemm_phase(PG8_LAS unsigned char* lds, const Gemm g, const Sched& S, const Epi& E) {
    const int tid = threadIdx.x, wid = __builtin_amdgcn_readfirstlane(tid >> 6), lane = tid & 63, wr = wid >> 2, wc = wid & 3, fr = lane & 15, fq = lane >> 4;
    const int K = g.K, nt = K / BK;
    unsigned voffA[2], voffB[2];
#pragma unroll
    for (int i = 0; i < 2; ++i) { int R, C; stage_rc(tid * 16 + i * 8192, R, C); const int Rb = Epi::PERM ? ((R & ~31) + perm32(R & 31)) : R;
        voffA[i] = (unsigned)(R * K + C) * 2u; voffB[i] = (unsigned)(Rb * K + C) * 2u; }
    const size_t kstep = (size_t)(BK * 2);
    const size_t hstep = (size_t)HALF * K * 2;
    const size_t tstep = 2 * hstep;
    const unsigned ldsw = (unsigned)wid * 1024u;
    const int aoff = lds_byte(wr * 64 + fr, fq * 8), boff = lds_byte(wc * 32 + fr, fq * 8);
#define PG8_SA(b, h) (((b) * 2 + (h)) * HTB)
#define PG8_SB(b, h) ((4 + (b) * 2 + (h)) * HTB)
#define PG8_STAGE(bufoff, gbase, voff) do { _Pragma("unroll") for (int _i = 0; _i < 2; ++_i) \
        __builtin_amdgcn_global_load_lds((const unsigned*)((const char*)(gbase) + (voff)[_i]), (PG8_LAS unsigned*)(lds + (bufoff) + ldsw + _i * 8192), 16, 0, 0); } while (0)
#define PG8_LDA(dst, b, h) do { _Pragma("unroll") for (int m = 0; m < 4; ++m) _Pragma("unroll") for (int k = 0; k < 2; ++k) dst[m][k] = *(const PG8_LAS bf16x8*)(lds + PG8_SA(b, h) + aoff + m * 2048 + k * 1024); } while (0)
#define PG8_LDB(dst, b, h) do { _Pragma("unroll") for (int n = 0; n < 2; ++n) _Pragma("unroll") for (int k = 0; k < 2; ++k) dst[n][k] = *(const PG8_LAS bf16x8*)(lds + PG8_SB(b, h) + boff + n * 2048 + k * 1024); } while (0)
#define PG8_MMA(ai, bj, At, Bt) do { __builtin_amdgcn_s_setprio(1); _Pragma("unroll") for (int m = 0; m < 4; ++m) _Pragma("unroll") for (int n = 0; n < 2; ++n) _Pragma("unroll") for (int k = 0; k < 2; ++k) \
        acc[ai][bj][m][n] = __builtin_amdgcn_mfma_f32_16x16x32_bf16(Bt[n][k], At[m][k], acc[ai][bj][m][n], 0, 0, 0); __builtin_amdgcn_s_setprio(0); } while (0)
#define PG8_WAIT_V(n) asm volatile("s_waitcnt vmcnt(" #n ")" ::: "memory")
#define PG8_WAIT_L(n) asm volatile("s_waitcnt lgkmcnt(" #n ")" ::: "memory")
#define PG8_BAR __builtin_amdgcn_s_barrier()
#define PG8_SCHED __builtin_amdgcn_sched_barrier(0)
    Unit cur, nxt; int ui = 0;
    if (!S.next(0, cur)) return;
    f32x4 acc[2][2][4][2];
#pragma unroll
    for (int a = 0; a < 2; ++a)
#pragma unroll
        for (int b = 0; b < 2; ++b)
#pragma unroll
            for (int m = 0; m < 4; ++m)
#pragma unroll
                for (int n = 0; n < 2; ++n) acc[a][b][m][n] = (f32x4){0.f, 0.f, 0.f, 0.f};
    bf16x8 At[4][2], B0[2][2], B1[2][2];
    const char* cA = (const char*)g.A + (size_t)cur.pm * tstep; const char* cB = (const char*)g.Bt + (size_t)cur.pn * tstep;
    S.a_ready(cur);
    if constexpr (SP2) {
        PG8_STAGE(PG8_SB(0, 0), cB, voffB); PG8_STAGE(PG8_SB(0, 1), cB + hstep, voffB); PG8_STAGE(PG8_SA(0, 0), cA, voffA); PG8_STAGE(PG8_SA(0, 1), cA + hstep, voffA);
        if (wr == 1) PG8_BAR;
        PG8_WAIT_V(2); PG8_BAR;
        PG8_STAGE(PG8_SB(1, 0), cB + kstep, voffB); PG8_STAGE(PG8_SA(1, 0), cA + kstep, voffA); PG8_STAGE(PG8_SB(1, 1), cB + hstep + kstep, voffB);
        PG8_WAIT_V(6); PG8_BAR;
    } else {
        PG8_STAGE(PG8_SB(0, 0), cB, voffB); PG8_STAGE(PG8_SA(0, 0), cA, voffA); PG8_STAGE(PG8_SB(0, 1), cB + hstep, voffB); PG8_STAGE(PG8_SA(0, 1), cA + hstep, voffA);
        if (wr == 1) PG8_BAR;
        PG8_WAIT_V(4); PG8_BAR;
        PG8_STAGE(PG8_SB(1, 0), cB + kstep, voffB); PG8_STAGE(PG8_SA(1, 0), cA + kstep, voffA); PG8_STAGE(PG8_SB(1, 1), cB + hstep + kstep, voffB);
        PG8_WAIT_V(6); PG8_BAR;
    }
    for (;;) {
        const bool has_next = S.next(ui + 1, nxt);
        const char* nA = has_next ? (const char*)g.A + (size_t)nxt.pm * tstep : cA; const char* nB = has_next ? (const char*)g.Bt + (size_t)nxt.pn * tstep : cB;
        for (int t = 0; t < nt; t += 2) {
            const bool last = (t == nt - 2);
            const char* a1 = cA + (size_t)(t + 1) * kstep;
            const char* a2 = last ? nA : cA + (size_t)(t + 2) * kstep; const char* b2 = last ? nB : cB + (size_t)(t + 2) * kstep;
            const char* a3 = a2 + kstep; const char* b3 = b2 + kstep;
            if (last && has_next) S.a_ready(nxt);
            if constexpr (SP2) {
            PG8_LDB(B0, 0, 0); PG8_LDB(B1, 0, 1); PG8_SCHED; PG8_LDA(At, 0, 0); PG8_STAGE(PG8_SA(1, 1), a1 + hstep, voffA);
            PG8_WAIT_V(8); PG8_WAIT_L(0); PG8_BAR; PG8_MMA(0, 0, At, B0); PG8_MMA(0, 1, At, B1); PG8_BAR; PG8_SCHED;
            PG8_LDA(At, 0, 1); PG8_STAGE(PG8_SB(0, 0), b2, voffB); PG8_STAGE(PG8_SB(0, 1), b2 + hstep, voffB); PG8_STAGE(PG8_SA(0, 0), a2, voffA);
            PG8_WAIT_V(8); PG8_WAIT_L(0); PG8_BAR; PG8_MMA(1, 0, At, B0); PG8_MMA(1, 1, At, B1); PG8_BAR; PG8_SCHED;
            PG8_LDB(B0, 1, 0); PG8_LDB(B1, 1, 1); PG8_SCHED; PG8_LDA(At, 1, 0); PG8_STAGE(PG8_SA(0, 1), a2 + hstep, voffA);
            PG8_WAIT_V(8); PG8_WAIT_L(0); PG8_BAR; PG8_MMA(0, 0, At, B0); PG8_MMA(0, 1, At, B1); PG8_BAR; PG8_SCHED;
            PG8_LDA(At, 1, 1); PG8_STAGE(PG8_SB(1, 0), b3, voffB); PG8_STAGE(PG8_SB(1, 1), b3 + hstep, voffB); PG8_STAGE(PG8_SA(1, 0), a3, voffA);
            PG8_WAIT_V(8); PG8_WAIT_L(0); PG8_BAR; PG8_MMA(1, 0, At, B0); PG8_MMA(1, 1, At, B1); PG8_BAR; PG8_SCHED;
            } else {
            PG8_LDB(B0, 0, 0); PG8_SCHED; PG8_LDA(At, 0, 0); PG8_STAGE(PG8_SA(1, 1), a1 + hstep, voffA);
            PG8_WAIT_L(8); PG8_BAR; PG8_WAIT_L(0); PG8_MMA(0, 0, At, B0); PG8_BAR; PG8_SCHED;
            PG8_LDB(B1, 0, 1); PG8_STAGE(PG8_SB(0, 0), b2, voffB);
            PG8_BAR; PG8_WAIT_L(0); PG8_MMA(0, 1, At, B1); PG8_BAR;
            PG8_LDA(At, 0, 1); PG8_STAGE(PG8_SA(0, 0), a2, voffA);
            PG8_BAR; PG8_WAIT_L(0); PG8_MMA(1, 0, At, B0); PG8_BAR; PG8_SCHED;
            PG8_STAGE(PG8_SB(0, 1), b2 + hstep, voffB);
            PG8_WAIT_V(6); PG8_BAR; PG8_MMA(1, 1, At, B1); PG8_BAR;
            PG8_LDB(B0, 1, 0); PG8_SCHED; PG8_LDA(At, 1, 0); PG8_STAGE(PG8_SA(0, 1), a2 + hstep, voffA);
            PG8_WAIT_L(8); PG8_BAR; PG8_WAIT_L(0); PG8_MMA(0, 0, At, B0); PG8_BAR; PG8_SCHED;
            PG8_LDB(B1, 1, 1); PG8_STAGE(PG8_SB(1, 0), b3, voffB);
            PG8_BAR; PG8_WAIT_L(0); PG8_MMA(0, 1, At, B1); PG8_BAR;
            PG8_LDA(At, 1, 1); PG8_STAGE(PG8_SA(1, 0), a3, voffA);
            PG8_BAR; PG8_WAIT_L(0); PG8_MMA(1, 0, At, B0); PG8_BAR; PG8_SCHED;
            PG8_STAGE(PG8_SB(1, 1), b3 + hstep, voffB);
            PG8_WAIT_V(6); PG8_BAR; PG8_MMA(1, 1, At, B1); PG8_BAR;
            }
        }
        if constexpr (ALIGN_EPI) { if (wr == 0) PG8_BAR; }
        if constexpr (!Epi::AFTER_DRAIN) { E(acc, cur, wr, wc, fr, fq); S.done(cur); }
        if (!has_next) break;
#pragma unroll
        for (int a = 0; a < 2; ++a)
#pragma unroll
            for (int b = 0; b < 2; ++b)
#pragma unroll
                for (int m = 0; m < 4; ++m)
#pragma unroll
                    for (int n = 0; n < 2; ++n) acc[a][b][m][n] = (f32x4){0.f, 0.f, 0.f, 0.f};
        cur = nxt; cA = nA; cB = nB; ++ui;
        if constexpr (ALIGN_EPI) { if (wr == 1) PG8_BAR; }
    }
    PG8_WAIT_V(0);
    if constexpr (!ALIGN_EPI) { if (wr == 0) PG8_BAR; }
    PG8_BAR;
    if constexpr (Epi::AFTER_DRAIN) { E.fused(acc, cur, wr, wc, fr, fq, lds, wid, lane); S.done(cur); }
#undef PG8_SA
#undef PG8_SB
#undef PG8_STAGE
#undef PG8_LDA
#undef PG8_LDB
#undef PG8_MMA
#undef PG8_WAIT_V
#undef PG8_WAIT_L
#undef PG8_BAR
#undef PG8_SCHED
}
}
#ifndef PG8_SP2
#define PG8_SP2 true
#endif
#ifndef PG8_ALIGN
#define PG8_ALIGN true
#endif

constexpr int NWAVES = 8;
#ifndef MK_N_LAUNCHES
#define MK_N_LAUNCHES 1
#endif
constexpr int NPHASE = 9;
constexpr int N_LAUNCHES = MK_N_LAUNCHES;

constexpr int NB = 4, SEQ = 4096, M = NB * SEQ, D = 4096;
constexpr int D_SSD = 4096, D_CONV = 4096, D_MIX = 8192, NH = 64, HD = 64, NG = 8, NS = 128, D_XBC = 6144;
constexpr int NPROJ = 22592, NP = 22784, PP = NP - 4096;
constexpr int O_Z = 0, O_X = 4096, O_B = 8192, O_C = 9216, O_CH = 10240, O_U = 10240, R_SCB = 18432, R_DT = 22528, O_SCB = R_SCB - 4096, O_DT = R_DT - 4096, CH_TILE0 = O_CH / 256, CH_TILES = 32;
constexpr int SRC_DT = 10240, SRC_SCB = 10304, SRC_SCC = 14400, SRC_SCH = 18496;
__host__ __device__ constexpr int win_row_of_src_col(int n) {
    return n < SRC_DT ? n : n < SRC_SCB ? R_DT + (n - SRC_DT) : n < SRC_SCC ? R_SCB + (n - SRC_SCB)
         : n < SRC_SCH ? O_CH + ((n - SRC_SCC) >> 7) * 256 + ((n - SRC_SCC) & 127) : O_CH + ((n - SRC_SCH) >> 7) * 256 + 128 + ((n - SRC_SCH) & 127); }
constexpr int PH = 8, PK = 128, PTOP = 16, PQ = 2048, NEXP = 16384, HK = 128;
constexpr float EPS = 1e-6f;

constexpr size_t MiB = 1u << 20;
constexpr size_t WS_CTL = 0, CTL_ZERO_BYTES = 1 * MiB;
constexpr size_t WS_XN = 1 * MiB;
constexpr size_t WS_WIN = 129 * MiB;
constexpr size_t WS_WOUT = 307 * MiB;
constexpr size_t WS_WQ = 371 * MiB;
constexpr size_t WS_CONV = 1 * MiB;
constexpr size_t WS_Y = 387 * MiB;
constexpr size_t WS_PROJ = 643 * MiB;
constexpr size_t WS_U8 = 1227 * MiB;
constexpr size_t WS_V8 = 1291 * MiB;
constexpr size_t WS_SU = 1376 * MiB, WS_SV = 1376 * MiB + 65536;
constexpr size_t WS_XQ = 772 * MiB, WS_XS = 836 * MiB;
constexpr size_t WS_Q = 899 * MiB;
constexpr size_t WS_HB = 1027 * MiB;
constexpr size_t WS_SSQ = 1355 * MiB;
constexpr size_t WS_KH = 1359 * MiB;
constexpr size_t WS_IDX = 1360 * MiB;
constexpr size_t WS_GATE = 1368 * MiB;
constexpr size_t WS_END = 1377 * MiB;
static_assert(WS_WIN + (size_t)NP * D * 2 <= WS_WOUT && WS_Y + (size_t)M * D_MIX * 2 <= WS_PROJ && WS_PROJ + (size_t)M * PP * 2 <= WS_U8 && WS_V8 + (size_t)NEXP * D <= WS_SSQ && WS_Q + (size_t)M * PQ * 4 <= WS_SSQ, "d_ws map");
constexpr int CW_TMO = 0, CW_CODE = 1, CW_TICKET = 64;
constexpr int CW_BAR = 4096;

constexpr int RING_OFF = 0, RING_BYTES = 131072;
constexpr int LDSCTL_OFF = RING_BYTES, MISC_OFF = LDSCTL_OFF + 320;
constexpr int LDS_BYTES = 147456;
static_assert(MISC_OFF + 128 <= LDS_BYTES, "LDS map");

#define GAS __attribute__((address_space(1)))
#define LAS __attribute__((address_space(3)))
typedef unsigned short bf16;
typedef unsigned v4u __attribute__((ext_vector_type(4)));
typedef float f32x4 __attribute__((ext_vector_type(4)));
typedef short bf16x8 __attribute__((ext_vector_type(8)));
typedef GAS unsigned gu32;
typedef GAS unsigned long long gu64;
#define RLX_AGENT __ATOMIC_RELAXED, __HIP_MEMORY_SCOPE_AGENT
#define LDS_WAIT() asm volatile("s_waitcnt lgkmcnt(0)" ::: "memory")
#define VM_WAIT() asm volatile("s_waitcnt vmcnt(0)" ::: "memory")
__device__ __forceinline__ unsigned long long rt() { return __builtin_amdgcn_s_memrealtime(); }
__device__ __forceinline__ unsigned f2bf(float f) { unsigned u = __builtin_bit_cast(unsigned, f); return (u + 0x7fffu + ((u >> 16) & 1u)) >> 16; }
__device__ __forceinline__ unsigned pk2(float lo, float hi) { return f2bf(lo) | (f2bf(hi) << 16); }


#define XB_TMO      128
#define XB_XCNT(j)  (256  + 64 * (j))
#define XB_XSUB(j)  (1280 + 64 * (j))
#define XB_XGEN(j)  (2304 + 64 * (j))
#define XB_TOP      3328
#define XB_TOPGEN   3392
#define XCD_BAR_WORDS 3456
#define XB_SPIN_CAP (1u << 18)

__device__ __forceinline__ unsigned xb_ld(unsigned* p)              { return __hip_atomic_load(p, __ATOMIC_RELAXED, __HIP_MEMORY_SCOPE_AGENT); }
__device__ __forceinline__ unsigned xb_add(unsigned* p, unsigned v) { return __hip_atomic_fetch_add(p, v, __ATOMIC_RELAXED, __HIP_MEMORY_SCOPE_AGENT); }
__device__ __forceinline__ unsigned xb_xcc_id() { return (unsigned)__builtin_amdgcn_s_getreg((3 << 11) | 20) & 0xFu; }
#define XB_SPIN(cond, bar) do { unsigned _sp = 0; while (cond) { __builtin_amdgcn_s_sleep(1); \
    if ((++_sp & 255u) == 0u) { if (xb_ld(&(bar)[XB_TMO])) break; if (_sp > XB_SPIN_CAP) { atomicAdd(&(bar)[XB_TMO], 1u); break; } } } } while (0)

struct XcdBarrier {
    unsigned* bar; unsigned x;
    volatile LAS unsigned* st;
};

__device__ __forceinline__ XcdBarrier xcd_barrier_post(unsigned* bar, volatile LAS unsigned* st) {
    XcdBarrier b; b.bar = bar; b.x = xb_xcc_id(); b.st = st;
    if (threadIdx.x == 0) (void)xb_add(&bar[XB_XCNT(b.x)], 1u);
    return b;
}
__device__ __forceinline__ void xcd_barrier_complete(unsigned* bar, unsigned x, unsigned& nloc, unsigned& nx) {
    const unsigned G = gridDim.x * gridDim.y * gridDim.z;
    unsigned sum, cnt, mine, sp = 0u;
    for (;;) {
        sum = 0u; cnt = 0u; mine = 0u;
#pragma unroll
        for (unsigned j = 0; j < 16; ++j) { const unsigned c = xb_ld(&bar[XB_XCNT(j)]); sum += c; cnt += (c > 0u) ? 1u : 0u; mine = (j == x) ? c : mine; }
        if (sum == G) break;
        __builtin_amdgcn_s_sleep(1);
        if ((++sp & 255u) == 0u) { if (xb_ld(&bar[XB_TMO])) break; if (sp > XB_SPIN_CAP) { atomicAdd(&bar[XB_TMO], 1u); break; } }
    }
    nloc = mine > 0u ? mine : 1u; nx = cnt > 0u ? cnt : 1u;
}

__device__ __forceinline__ void xcd_barrier(const XcdBarrier& b) {
    asm volatile("s_waitcnt vmcnt(0)" ::: "memory");
    __syncthreads();
    if (threadIdx.x == 0) {
        unsigned* bar = b.bar;
        __builtin_amdgcn_s_waitcnt(0);
        unsigned nloc = b.st[0], nx = b.st[1];
        if (nloc == 0u) { xcd_barrier_complete(bar, b.x, nloc, nx); b.st[0] = nloc; b.st[1] = nx; }
        const unsigned old = xb_add(&bar[XB_XSUB(b.x)], 1u);
        const unsigned gen = old / nloc;
        if (old + 1u == (gen + 1u) * nloc) {
            __builtin_amdgcn_fence(__ATOMIC_RELEASE, "agent");
            asm volatile("s_waitcnt vmcnt(0)" ::: "memory");
            const unsigned og = xb_add(&bar[XB_TOP], 1u);
            const unsigned tg = og / nx;
            if (og + 1u == (tg + 1u) * nx) xb_add(&bar[XB_TOPGEN], 1u);
            else XB_SPIN(xb_ld(&bar[XB_TOPGEN]) == tg, bar);
            __builtin_amdgcn_fence(__ATOMIC_ACQUIRE, "agent");
            xb_add(&bar[XB_XGEN(b.x)], 1u);
            asm volatile("s_waitcnt vmcnt(0)" ::: "memory");
        } else {
            XB_SPIN(xb_ld(&bar[XB_XGEN(b.x)]) == gen, bar);
            __builtin_amdgcn_fence(__ATOMIC_ACQUIRE, "agent");
            asm volatile("s_waitcnt vmcnt(0)" ::: "memory");
        }
    }
    __syncthreads();
}


#ifndef PROBE_REP
#define PROBE_REP 0
#endif
#define NREP(k) (1 + (((PROBE_REP) >> (k)) & 1))
typedef unsigned u32x4 __attribute__((ext_vector_type(4)));
typedef unsigned u32x2 __attribute__((ext_vector_type(2)));
typedef float f32x2 __attribute__((ext_vector_type(2)));
typedef __bf16 bf2_t __attribute__((ext_vector_type(2)));

__device__ __forceinline__ float wave_sum(float v) {
#pragma unroll
    for (int o = 1; o < 64; o <<= 1) v += __shfl_xor(v, o);
    return v;
}
__device__ __forceinline__ unsigned cvtpk(float lo, float hi) { unsigned r; asm volatile("v_cvt_pk_bf16_f32 %0, %1, %2" : "=v"(r) : "v"(lo), "v"(hi)); return r; }
__device__ __forceinline__ float bflo(unsigned w) { return __uint_as_float(w << 16); }
__device__ __forceinline__ float bfhi(unsigned w) { return __uint_as_float(w & 0xffff0000u); }
__device__ __forceinline__ float siluf(float x) { return x * __builtin_amdgcn_rcpf(1.0f + __expf(-x)); }
__device__ __forceinline__ float dot2bf(unsigned a, unsigned b, float c) { return __builtin_amdgcn_fdot2_f32_bf16(__builtin_bit_cast(bf2_t, a), __builtin_bit_cast(bf2_t, b), c, false); }

__device__ __forceinline__ void p0_transpose_item(const float* W, int K, int N, bf16* WT, bool remap, const float* kgain, LAS float* scr, int item, int lane) {
    const int nblk = N / 32, kb = item / nblk, nb = item % nblk, k0 = 64 * kb, n0 = 32 * nb, d0 = remap ? win_row_of_src_col(n0) : n0;
#pragma unroll 8
    for (int i = 0; i < 32; ++i) { const int kk = 2 * i + (lane >> 5); scr[kk * 33 + (lane & 31)] = __builtin_nontemporal_load((const GAS float*)W + ((size_t)(k0 + kk) * N + n0 + (lane & 31))) * (kgain ? kgain[k0 + kk] : 1.0f); }
    LDS_WAIT(); asm volatile("" ::: "memory");
    const int c = lane & 7;
#pragma unroll
    for (int j = 0; j < 4; ++j) { const int n = (lane >> 3) + 8 * j; const LAS float* s = scr + (8 * c) * 33 + n;
        v4u o; o.x = pk2(s[0 * 33], s[1 * 33]); o.y = pk2(s[2 * 33], s[3 * 33]); o.z = pk2(s[4 * 33], s[5 * 33]); o.w = pk2(s[6 * 33], s[7 * 33]);
        *(GAS v4u*)(WT + (size_t)(d0 + n) * K + k0 + 8 * c) = o; }
    LDS_WAIT(); asm volatile("" ::: "memory");
}
__device__ __forceinline__ void rms_row_to_bf16(const float* xrow, const float* w, bf16* orow, int lane) {
    const GAS f32x4* xr = (const GAS f32x4*)xrow + lane;
    f32x4 v[16]; float s = 0.f;
#pragma unroll
    for (int j = 0; j < 16; ++j) { v[j] = __builtin_nontemporal_load(xr + 64 * j); s += (v[j].x * v[j].x + v[j].y * v[j].y) + (v[j].z * v[j].z + v[j].w * v[j].w); }
    const float rs = 1.0f / sqrtf(wave_sum(s) * (1.f / D) + EPS);
    const GAS f32x4* wr = (const GAS f32x4*)w + lane;
    GAS u32x2* o8 = (GAS u32x2*)orow + lane;
#pragma unroll
    for (int j = 0; j < 16; ++j) { const f32x4 g = wr[64 * j]; u32x2 o; o.x = cvtpk(v[j].x * rs * g.x, v[j].y * rs * g.y); o.y = cvtpk(v[j].z * rs * g.z, v[j].w * rs * g.w); o8[64 * j] = o; }
}

__device__ __forceinline__ void unpack8(const u32x4 v, float (&f)[8]) { f[0] = bflo(v.x); f[1] = bfhi(v.x); f[2] = bflo(v.y); f[3] = bfhi(v.y); f[4] = bflo(v.z); f[5] = bfhi(v.z); f[6] = bflo(v.w); f[7] = bfhi(v.w); }
__device__ __forceinline__ unsigned pack_i8x4(float a, float b, float c, float d) {
    const int ia = __float2int_rn(a), ib = __float2int_rn(b), ic = __float2int_rn(c), id = __float2int_rn(d);
    return ((unsigned)ia & 0xffu) | (((unsigned)ib & 0xffu) << 8) | (((unsigned)ic & 0xffu) << 16) | ((unsigned)id << 24);
}
__device__ __forceinline__ void rms_row_to_bf16_i8(const bf16* hrow, const float* w, float* rsout, unsigned char* qrow, float* qscale, int lane) {
    const GAS u32x4* hr = (const GAS u32x4*)hrow + lane;
    float v[8][8]; float s = 0.f;
#pragma unroll
    for (int j = 0; j < 8; ++j) { const u32x4 t = hr[64 * j]; v[j][0] = bflo(t.x); v[j][1] = bfhi(t.x); v[j][2] = bflo(t.y); v[j][3] = bfhi(t.y); v[j][4] = bflo(t.z); v[j][5] = bfhi(t.z); v[j][6] = bflo(t.w); v[j][7] = bfhi(t.w);
#pragma unroll
        for (int k = 0; k < 8; ++k) s += v[j][k] * v[j][k]; }
    const float rs = 1.0f / sqrtf(wave_sum(s) * (1.f / D) + EPS);
    float am = 0.f; if (lane == 0) *rsout = rs;
#pragma unroll
    for (int j = 0; j < 8; ++j) { const GAS f32x4* wp = (const GAS f32x4*)(w + (j * 64 + lane) * 8); const f32x4 ga = wp[0], gb = wp[1]; const float g[8] = {ga.x, ga.y, ga.z, ga.w, gb.x, gb.y, gb.z, gb.w};
#pragma unroll
        for (int k = 0; k < 8; ++k) { v[j][k] *= rs * g[k]; am = fmaxf(am, fabsf(v[j][k])); }
        }
#pragma unroll
    for (int o = 1; o < 64; o <<= 1) am = fmaxf(am, __shfl_xor(am, o));
    const float sc = am > 0.f ? am * (1.0f / 127.0f) : 1.0f, inv = 1.0f / sc;
    GAS u32x2* q8 = (GAS u32x2*)qrow + lane;
#pragma unroll
    for (int j = 0; j < 8; ++j) { u32x2 p; p.x = pack_i8x4(v[j][0] * inv, v[j][1] * inv, v[j][2] * inv, v[j][3] * inv); p.y = pack_i8x4(v[j][4] * inv, v[j][5] * inv, v[j][6] * inv, v[j][7] * inv); q8[64 * j] = p; }
    if (lane == 0) *qscale = sc;
}

__device__ __forceinline__ u32x4 pack8(const float (&f)[8]) { u32x4 o; o.x = cvtpk(f[0], f[1]); o.y = cvtpk(f[2], f[3]); o.z = cvtpk(f[4], f[5]); o.w = cvtpk(f[6], f[7]); return o; }
__device__ __forceinline__ void conv_prepass(const bf16* PROJ, const float* conv_w, const float* conv_b, bf16* CONV, int gtid, int gthreads) {
    constexpr int NCG = D_XBC / 8, NSEG = SEQ / 16, NIT = NB * NSEG * NCG;
    int it = gtid; if (it >= NIT) return;
#define CP_ITEM(IT, CG, ROW, Z) do { const int _bs = (IT) / NCG; CG = (IT) % NCG; const int _seg = _bs % NSEG, _b = _bs / NSEG; Z = (_seg == 0); ROW = _b * SEQ + _seg * 16; } while (0)
#define CP_SRC(ROW, CG) (PROJ + (size_t)(ROW) * PP + O_X + (CG) * 8)
    int cg, row; bool z0; CP_ITEM(it, cg, row, z0); const bf16* src = CP_SRC(row, cg);
    u32x4 raw[19];
#pragma unroll
    for (int rr = 0; rr < 19; ++rr) raw[rr] = __builtin_nontemporal_load((const GAS u32x4*)(src + (ptrdiff_t)((rr >= 3 || !z0) ? rr - 3 : 0) * PP));
    for (;;) {
        const int itn = it + gthreads; const bool has_next = itn < NIT;
        int cgn = cg, rown = row; bool zn = z0; if (has_next) CP_ITEM(itn, cgn, rown, zn); const bf16* srcn = CP_SRC(rown, cgn);
        const int ch = cg * 8;
        float w[4][8], bias[8];
#pragma unroll
        for (int k = 0; k < 4; ++k) { const f32x4 wa = *(const GAS f32x4*)(conv_w + (size_t)k * D_XBC + ch), wb = *(const GAS f32x4*)(conv_w + (size_t)k * D_XBC + ch + 4);
            w[k][0] = wa.x; w[k][1] = wa.y; w[k][2] = wa.z; w[k][3] = wa.w; w[k][4] = wb.x; w[k][5] = wb.y; w[k][6] = wb.z; w[k][7] = wb.w; }
        { const f32x4 ba = *(const GAS f32x4*)(conv_b + ch), bb = *(const GAS f32x4*)(conv_b + ch + 4); bias[0] = ba.x; bias[1] = ba.y; bias[2] = ba.z; bias[3] = ba.w; bias[4] = bb.x; bias[5] = bb.y; bias[6] = bb.z; bias[7] = bb.w; }
        float win[3][8];
#pragma unroll
        for (int rr = 0; rr < 3; ++rr) { const u32x4 v = z0 ? (u32x4){0u, 0u, 0u, 0u} : raw[rr]; unpack8(v, win[rr]);
            if (has_next) raw[rr] = __builtin_nontemporal_load((const GAS u32x4*)(srcn + (ptrdiff_t)(zn ? 0 : rr - 3) * PP)); }
        bf16* dst = CONV + (size_t)row * D_XBC + ch;
#pragma unroll
        for (int i = 0; i < 16; ++i) { float cur[8], o[8]; unpack8(raw[3 + i], cur);
            if (has_next) raw[3 + i] = __builtin_nontemporal_load((const GAS u32x4*)(srcn + (ptrdiff_t)i * PP));
#pragma unroll
            for (int j = 0; j < 8; ++j) { o[j] = siluf(bias[j] + w[0][j] * win[0][j] + w[1][j] * win[1][j] + w[2][j] * win[2][j] + w[3][j] * cur[j]); win[0][j] = win[1][j]; win[1][j] = win[2][j]; win[2][j] = cur[j]; }
            *(GAS u32x4*)(dst + (size_t)i * D_XBC) = pack8(o); }
        if (!has_next) break;
        it = itn; cg = cgn; row = rown; src = srcn; z0 = zn;
    }
#undef CP_ITEM
#undef CP_SRC
}
constexpr int C_CM = 0, C_BM = 32768, C_BTW = 65536, C_XDT = 98304, C_XB = 114688, C_SM = LDSCTL_OFF + 512;
static_assert(C_XB + 16384 <= RING_BYTES && C_SM + 2 * 2048 + 2048 <= LDS_BYTES, "ssd lds");
__device__ __forceinline__ int sw256(int r, int c) { return r * 256 + ((c ^ (r & 15)) << 4); }
__device__ __forceinline__ int sw128(int r, int c) { return r * 128 + ((c ^ (r & 7)) << 4); }
__device__ __forceinline__ int swT(int r, int c) { return r * 256 + ((c ^ (((r >> 3) ^ r) & 15)) << 4); }
__device__ __forceinline__ float wave_incl_scan(float x) {
    x += __builtin_bit_cast(float, __builtin_amdgcn_update_dpp(0, __builtin_bit_cast(int, x), 0x111, 0xf, 0xf, true));
    x += __builtin_bit_cast(float, __builtin_amdgcn_update_dpp(0, __builtin_bit_cast(int, x), 0x112, 0xf, 0xf, true));
    x += __builtin_bit_cast(float, __builtin_amdgcn_update_dpp(0, __builtin_bit_cast(int, x), 0x114, 0xf, 0xf, true));
    x += __builtin_bit_cast(float, __builtin_amdgcn_update_dpp(0, __builtin_bit_cast(int, x), 0x118, 0xf, 0xf, true));
    x += __builtin_bit_cast(float, __builtin_amdgcn_update_dpp(0, __builtin_bit_cast(int, x), 0x142, 0xa, 0xf, true));
    x += __builtin_bit_cast(float, __builtin_amdgcn_update_dpp(0, __builtin_bit_cast(int, x), 0x143, 0xc, 0xf, true));
    return x;
}
__device__ __forceinline__ void ssd_dt_scan(LAS float* sm, float r0, float r1, float a_neg, int lane) {
    const float d0 = r0 > 20.f ? r0 : __logf(1.0f + __expf(r0)), d1 = r1 > 20.f ? r1 : __logf(1.0f + __expf(r1));
    const float v0 = wave_incl_scan(d0 * a_neg); float v1 = wave_incl_scan(d1 * a_neg);
    v1 += __shfl(v0, 63);
    const float aend = __shfl(v1, 63);
    sm[lane] = d0; sm[64 + lane] = d1; sm[128 + lane] = v0; sm[192 + lane] = v1;
    sm[256 + lane] = __expf(aend - v0); sm[320 + lane] = __expf(aend - v1); sm[384 + lane] = __expf(v0); sm[448 + lane] = __expf(v1);
}
__device__ __forceinline__ void ssd_unit(LAS unsigned char* lds, int b, int h, const bf16* PROJ, const bf16* CONV, const float* dt_bias, const float* a_log, const float* ssd_d,
                                         bf16* Y, float* SSQ, int tid, int wave, int lane) {
    LAS float* smb = (LAS float*)(lds + C_SM); LAS float* ssqp = smb + 1024;
    const int g = h >> 3, pb = wave & 3, th = wave >> 2;
    const float a_neg = -__expf(a_log[h]), dtb = dt_bias[h], Dh = ssd_d[h];
    const size_t rowbase = (size_t)b * SEQ;
    const GAS unsigned char* convb = (const GAS unsigned char*)CONV; const GAS unsigned char* projb = (const GAS unsigned char*)PROJ; GAS unsigned char* yb = (GAS unsigned char*)Y; GAS unsigned char* ssqb = (GAS unsigned char*)SSQ;
#define SSD_ROLES(TT, LL) \
    const bool xitem = (TT) < 128, bitem = (TT) >= 128 && (TT) < 384; \
    const int icg = xitem ? ((TT) & 7) : (((TT) - 128) & 15), its = xitem ? ((TT) >> 3) : (((TT) - 128) >> 4); \
    const unsigned toff = (unsigned)(((rowbase + its * 8) * D_XBC + (xitem ? h * 64 + icg * 8 : D_SSD + g * 128 + icg * 8)) * 2); \
    const unsigned coff = (unsigned)(((rowbase + ((TT) >> 4)) * D_XBC + D_SSD + NG * NS + g * 128 + ((TT) & 15) * 8) * 2); \
    const unsigned doff = (unsigned)(((rowbase + (LL)) * PP + O_DT + h) * 2); \
    const int r = (LL) & 15, q = (LL) >> 4;
    f32x4 ST[8];
#pragma unroll
    for (int i = 0; i < 8; ++i) ST[i] = (f32x4){0.f, 0.f, 0.f, 0.f};
    u32x4 pft[8], pfc[4]; float dr0 = 0.f, dr1 = 0.f;
#define SSD_LBAR() do { asm volatile("s_waitcnt lgkmcnt(0)" ::: "memory"); __builtin_amdgcn_s_barrier(); asm volatile("" ::: "memory"); } while (0)
#define SSD_PREFETCH(cc) do { const unsigned _ro = (unsigned)(cc) * (128u * D_XBC * 2u); \
        if (xitem || bitem) { _Pragma("unroll") for (int _i = 0; _i < 8; ++_i) pft[_i] = *(const GAS u32x4*)(convb + (toff + _ro + (unsigned)_i * (D_XBC * 2u))); } \
        _Pragma("unroll") for (int _k = 0; _k < 4; ++_k) pfc[_k] = *(const GAS u32x4*)(convb + (coff + _ro + (unsigned)_k * (32u * D_XBC * 2u))); } while (0)
#define SSD_DTLOAD(cc) do { if (wave == 0) { const unsigned _o = doff + (unsigned)(cc) * (128u * PP * 2u); \
        dr0 = __uint_as_float((unsigned)*(const GAS unsigned short*)(projb + _o) << 16) + dtb; dr1 = __uint_as_float((unsigned)*(const GAS unsigned short*)(projb + (_o + 64u * PP * 2u)) << 16) + dtb; } } while (0)
    { SSD_ROLES(tid, lane) SSD_DTLOAD(0); SSD_PREFETCH(0); (void)r; (void)q; }
    if (wave == 0) ssd_dt_scan(smb, dr0, dr1, a_neg, lane);
    for (int c = 0; c < SEQ / 128; ++c) {
        const int t0 = c * 128, cn = c + 1 < SEQ / 128 ? c + 1 : c;
        int tt = tid, ll = lane; asm volatile("" : "+v"(tt), "+v"(ll));
        SSD_ROLES(tt, ll)
        LAS float* dtv = smb + (c & 1) * 512; LAS float* acum = dtv + 128; LAS float* wend = dtv + 256; LAS float* eac = dtv + 384;
        SSD_LBAR();
        if (c > 0 && tt < 128) *(GAS float*)(ssqb + (unsigned)(((rowbase + t0 - 128 + tt) * NH + h) * 4)) = (ssqp[tt] + ssqp[128 + tt]) + (ssqp[256 + tt] + ssqp[384 + tt]);
#pragma unroll
        for (int k = 0; k < 4; ++k) *(LAS u32x4*)(lds + C_CM + sw256((tt >> 4) + 32 * k, tt & 15)) = pfc[k];
        if (xitem || bitem) {
            const LAS float* sc = xitem ? dtv : wend; const f32x4 sa = *(const LAS f32x4*)(sc + its * 8), sb2 = *(const LAS f32x4*)(sc + its * 8 + 4); const float s8[8] = {sa.x, sa.y, sa.z, sa.w, sb2.x, sb2.y, sb2.z, sb2.w};
            float o[8][8];
#pragma unroll
            for (int i = 0; i < 8; ++i) { unpack8(pft[i], o[i]);
                if (xitem) *(LAS u32x4*)(lds + C_XB + sw128(its * 8 + i, icg)) = pft[i]; else *(LAS u32x4*)(lds + C_BM + sw256(its * 8 + i, icg)) = pft[i]; }
#pragma unroll
            for (int j = 0; j < 8; ++j) { const float f[8] = {o[0][j] * s8[0], o[1][j] * s8[1], o[2][j] * s8[2], o[3][j] * s8[3], o[4][j] * s8[4], o[5][j] * s8[5], o[6][j] * s8[6], o[7][j] * s8[7]};
                *(LAS u32x4*)(lds + (xitem ? C_XDT : C_BTW) + swT(icg * 8 + j, its)) = pack8(f); }
        }
        SSD_DTLOAD(cn);
        SSD_LBAR();
        if (wave == 0) ssd_dt_scan(smb + ((c + 1) & 1) * 512, dr0, dr1, a_neg, ll);
        f32x4 cb[8];
        {   bf16x8 cfr[4];
#pragma unroll
            for (int ks = 0; ks < 4; ++ks) cfr[ks] = *(const LAS bf16x8*)(lds + C_CM + sw256(16 * wave + r, 4 * ks + q));
#pragma unroll
            for (int sp = 0; sp < 4; ++sp) { cb[2 * sp] = (f32x4){0.f, 0.f, 0.f, 0.f}; cb[2 * sp + 1] = (f32x4){0.f, 0.f, 0.f, 0.f};
                if (2 * sp <= wave) {
                    bf16x8 a0[4], a1[4];
#pragma unroll
                    for (int ks = 0; ks < 4; ++ks) { a0[ks] = *(const LAS bf16x8*)(lds + C_BM + sw256(32 * sp + r, 4 * ks + q)); a1[ks] = *(const LAS bf16x8*)(lds + C_BM + sw256(32 * sp + 16 + r, 4 * ks + q)); }
                    __builtin_amdgcn_sched_barrier(0);
#pragma unroll
                    for (int ks = 0; ks < 4; ++ks) { cb[2 * sp] = __builtin_amdgcn_mfma_f32_16x16x32_bf16(a0[ks], cfr[ks], cb[2 * sp], 0, 0, 0); cb[2 * sp + 1] = __builtin_amdgcn_mfma_f32_16x16x32_bf16(a1[ks], cfr[ks], cb[2 * sp + 1], 0, 0, 0); }
                    __builtin_amdgcn_sched_barrier(0); } } }
        SSD_LBAR();
        {   const float ac_t = acum[16 * wave + r]; const int row = 16 * wave + r;
#pragma unroll
            for (int sb = 0; sb < 8; ++sb) {
                if (sb <= wave) { const f32x4 as4 = *(const LAS f32x4*)(acum + 16 * sb + 4 * q); float m[4];
#pragma unroll
                    for (int j = 0; j < 4; ++j) { const float e = __expf(fminf(ac_t - as4[j], 0.f)); m[j] = (sb == wave && 4 * q + j > r) ? 0.f : cb[sb][j] * e; }
                    u32x2 pk; pk.x = cvtpk(m[0], m[1]); pk.y = cvtpk(m[2], m[3]);
                    *(LAS u32x2*)(lds + C_BM + row * 256 + (((2 * sb + (q >> 1)) ^ (row & 15)) << 4) + (q & 1) * 8) = pk;
                } else if (sb == wave + 1 && !(wave & 1)) {
                    *(LAS u32x2*)(lds + C_BM + row * 256 + (((2 * sb + (q >> 1)) ^ (row & 15)) << 4) + (q & 1) * 8) = (u32x2){0u, 0u}; } } }
        u32x2 zv[4];
#pragma unroll
        for (int j = 0; j < 4; ++j) zv[j] = *(const GAS u32x2*)(projb + (unsigned)(((rowbase + t0 + 16 * (4 * th + j) + r) * PP + O_Z + h * 64 + 16 * pb + 4 * q) * 2));
        SSD_PREFETCH(cn);
        SSD_LBAR();
        bf16x8 xfr[4], sfr[4];
#pragma unroll
        for (int ks = 0; ks < 4; ++ks) { xfr[ks] = *(const LAS bf16x8*)(lds + C_XDT + swT(16 * pb + r, 4 * ks + q));
            sfr[ks] = __builtin_bit_cast(bf16x8, (u32x4){cvtpk(ST[2 * ks][0], ST[2 * ks][1]), cvtpk(ST[2 * ks][2], ST[2 * ks][3]), cvtpk(ST[2 * ks + 1][0], ST[2 * ks + 1][1]), cvtpk(ST[2 * ks + 1][2], ST[2 * ks + 1][3])}); }
#pragma unroll
        for (int j = 0; j < 4; ++j) {
            const int tb = 4 * th + j, trow = 16 * tb + r; const size_t grow = rowbase + t0 + trow; const int p0 = 16 * pb + 4 * q;
            f32x4 ad = (f32x4){0.f, 0.f, 0.f, 0.f}, ao = (f32x4){0.f, 0.f, 0.f, 0.f};
            bf16x8 mmf[4]; u32x2 clo[4], chi[4];
            {   const int cbase = C_CM + trow * 256 + (q & 1) * 8;
#pragma unroll
                for (int ks = 0; ks < 4; ++ks) { mmf[ks] = *(const LAS bf16x8*)(lds + C_BM + sw256(trow, 4 * ks + q));
                    clo[ks] = *(const LAS u32x2*)(lds + cbase + (((4 * ks + (q >> 1)) ^ (trow & 15)) << 4)); chi[ks] = *(const LAS u32x2*)(lds + cbase + (((4 * ks + 2 + (q >> 1)) ^ (trow & 15)) << 4)); } }
            __builtin_amdgcn_sched_barrier(0);
#pragma unroll
            for (int ks = 0; ks < 4; ++ks) { if (2 * ks <= tb) ad = __builtin_amdgcn_mfma_f32_16x16x32_bf16(xfr[ks], mmf[ks], ad, 0, 0, 0);
                ao = __builtin_amdgcn_mfma_f32_16x16x32_bf16(sfr[ks], __builtin_bit_cast(bf16x8, (u32x4){clo[ks].x, clo[ks].y, chi[ks].x, chi[ks].y}), ao, 0, 0, 0); }
            __builtin_amdgcn_sched_barrier(0);
            const float ea = eac[trow];
            const u32x2 xv = *(const LAS u32x2*)(lds + C_XB + trow * 128 + (((2 * pb + (q >> 1)) ^ (trow & 7)) << 4) + (q & 1) * 8);
            const float xx[4] = {bflo(xv.x), bfhi(xv.x), bflo(xv.y), bfhi(xv.y)}, zz[4] = {bflo(zv[j].x), bfhi(zv[j].x), bflo(zv[j].y), bfhi(zv[j].y)};
            float y[4], sq = 0.f;
#pragma unroll
            for (int k = 0; k < 4; ++k) { y[k] = (ad[k] + ea * ao[k] + Dh * xx[k]) * siluf(zz[k]); sq += y[k] * y[k]; }
            u32x2 ov; ov.x = cvtpk(y[0], y[1]); ov.y = cvtpk(y[2], y[3]);
            *(GAS u32x2*)(yb + (unsigned)((grow * D_MIX + h * 64 + p0) * 2)) = ov;
            sq += __shfl_xor(sq, 16); sq += __shfl_xor(sq, 32);
            if (q == 0) ssqp[pb * 128 + trow] = sq;
            __builtin_amdgcn_sched_barrier(0);
        }
        {   const float dend = __expf(acum[127]);
#pragma unroll
            for (int np = 0; np < 4; ++np) { ST[2 * np] = ST[2 * np] * dend; ST[2 * np + 1] = ST[2 * np + 1] * dend;
                bf16x8 a0[4], a1[4];
#pragma unroll
                for (int ks = 0; ks < 4; ++ks) { a0[ks] = *(const LAS bf16x8*)(lds + C_BTW + swT(32 * np + r, 4 * ks + q)); a1[ks] = *(const LAS bf16x8*)(lds + C_BTW + swT(32 * np + 16 + r, 4 * ks + q)); }
                __builtin_amdgcn_sched_barrier(0);
#pragma unroll
                for (int ks = 0; ks < 4; ++ks) { ST[2 * np] = __builtin_amdgcn_mfma_f32_16x16x32_bf16(a0[ks], xfr[ks], ST[2 * np], 0, 0, 0); ST[2 * np + 1] = __builtin_amdgcn_mfma_f32_16x16x32_bf16(a1[ks], xfr[ks], ST[2 * np + 1], 0, 0, 0); }
                __builtin_amdgcn_sched_barrier(0); } }
    }
#undef SSD_ROLES
#undef SSD_LBAR
#undef SSD_PREFETCH
#undef SSD_DTLOAD
    __syncthreads();
    if (tid < 128) *(GAS float*)(ssqb + (unsigned)(((rowbase + SEQ - 128 + tid) * NH + h) * 4)) = (ssqp[tid] + ssqp[128 + tid]) + (ssqp[256 + tid] + ssqp[384 + tid]);
}

__device__ __forceinline__ void p3_rows2(int row0, const bf16* PROJ, const float* sc_w, const float* sc_nw, const float* ssd_nw, const float* SSQ, bf16* Y, LAS unsigned char* scr, int lane) {
    const int s0 = row0 & (SEQ - 1); const bool halo = s0 >= 2;
    const bf16* pr = PROJ + (size_t)row0 * PP + lane * 8;
    float ss0 = 0.f, ss1 = 0.f;
#pragma unroll 2
    for (int i = 0; i < 8; ++i) {
        const int c0 = (i * 64 + lane) * 8; const bf16* q = pr + i * 512; const bf16* qh = halo ? q : q + 2 * PP;
        const u32x4 um2v = *(const GAS u32x4*)(qh - 2 * PP + O_U), um1v = *(const GAS u32x4*)(qh - PP + O_U), u0v = *(const GAS u32x4*)(q + O_U), u1v = *(const GAS u32x4*)(q + PP + O_U);
        const u32x4 b0v = *(const GAS u32x4*)(q + O_SCB), b1v = *(const GAS u32x4*)(q + PP + O_SCB);
        const f32x4 w0a = *(const GAS f32x4*)(sc_w + c0), w0b = *(const GAS f32x4*)(sc_w + c0 + 4), w1a = *(const GAS f32x4*)(sc_w + D_CONV + c0), w1b = *(const GAS f32x4*)(sc_w + D_CONV + c0 + 4),
                    w2a = *(const GAS f32x4*)(sc_w + 2 * D_CONV + c0), w2b = *(const GAS f32x4*)(sc_w + 2 * D_CONV + c0 + 4);
        const float w0[8] = {w0a.x, w0a.y, w0a.z, w0a.w, w0b.x, w0b.y, w0b.z, w0b.w}, w1[8] = {w1a.x, w1a.y, w1a.z, w1a.w, w1b.x, w1b.y, w1b.z, w1b.w}, w2[8] = {w2a.x, w2a.y, w2a.z, w2a.w, w2b.x, w2b.y, w2b.z, w2b.w};
        float um2[8], um1[8], u0[8], u1[8], b0[8], b1[8];
        unpack8(um2v, um2); unpack8(um1v, um1); unpack8(u0v, u0); unpack8(u1v, u1);
#pragma unroll
        for (int j = 0; j < 8; ++j) { um2[j] = halo ? um2[j] : 0.f; um1[j] = halo ? um1[j] : 0.f; }
        unpack8(b0v, b0); unpack8(b1v, b1);
        float y0[8], y1[8];
#pragma unroll
        for (int j = 0; j < 8; ++j) { y0[j] = b0[j] * (w2[j] * u0[j] + w0[j] * um2[j] + w1[j] * um1[j]); y1[j] = b1[j] * (w2[j] * u1[j] + w0[j] * um1[j] + w1[j] * u0[j]); ss0 += y0[j] * y0[j]; ss1 += y1[j] * y1[j]; }
        *(LAS u32x4*)(scr + c0 * 2) = pack8(y0); *(LAS u32x4*)(scr + 8192 + c0 * 2) = pack8(y1);
    }
    const float rs0 = 1.0f / sqrtf(wave_sum(ss0) * (1.f / D_CONV) + EPS), rs1 = 1.0f / sqrtf(wave_sum(ss1) * (1.f / D_CONV) + EPS);
    bf16* yrow = Y + (size_t)row0 * D_MIX + lane * 8;
#pragma unroll 2
    for (int i = 0; i < 8; ++i) { const int c0 = (i * 64 + lane) * 8;
        float f0[8], f1[8]; unpack8(*(const LAS u32x4*)(scr + c0 * 2), f0); unpack8(*(const LAS u32x4*)(scr + 8192 + c0 * 2), f1);
        const f32x4 ga = *(const GAS f32x4*)(sc_nw + c0), gb = *(const GAS f32x4*)(sc_nw + c0 + 4); const float g[8] = {ga.x, ga.y, ga.z, ga.w, gb.x, gb.y, gb.z, gb.w};
#pragma unroll
        for (int j = 0; j < 8; ++j) { f0[j] *= rs0 * g[j]; f1[j] *= rs1 * g[j]; }
        *(GAS u32x4*)(yrow + D_SSD + i * 512) = pack8(f0); *(GAS u32x4*)(yrow + D_MIX + D_SSD + i * 512) = pack8(f1); }
    float gs0 = SSQ[(size_t)row0 * NH + lane], gs1 = SSQ[(size_t)(row0 + 1) * NH + lane];
    gs0 += __shfl_xor(gs0, 1); gs0 += __shfl_xor(gs0, 2); gs0 += __shfl_xor(gs0, 4); gs1 += __shfl_xor(gs1, 1); gs1 += __shfl_xor(gs1, 2); gs1 += __shfl_xor(gs1, 4);
#pragma unroll 2
    for (int i = 0; i < 8; ++i) { const int c0 = (i * 64 + lane) * 8;
        const float rg0 = 1.0f / sqrtf(__shfl(gs0, i * 8) * (1.f / 512.f) + EPS), rg1 = 1.0f / sqrtf(__shfl(gs1, i * 8) * (1.f / 512.f) + EPS);
        float f0[8], f1[8]; unpack8(*(const GAS u32x4*)(yrow + i * 512), f0); unpack8(*(const GAS u32x4*)(yrow + D_MIX + i * 512), f1);
        const f32x4 ga = *(const GAS f32x4*)(ssd_nw + c0), gb = *(const GAS f32x4*)(ssd_nw + c0 + 4); const float g[8] = {ga.x, ga.y, ga.z, ga.w, gb.x, gb.y, gb.z, gb.w};
#pragma unroll
        for (int j = 0; j < 8; ++j) { f0[j] *= rg0 * g[j]; f1[j] *= rg1 * g[j]; }
        *(GAS u32x4*)(yrow + i * 512) = pack8(f0); *(GAS u32x4*)(yrow + D_MIX + i * 512) = pack8(f1); }
}

constexpr int KROW = 272;
constexpr int RT_KH = 0, RT_KL = 128 * KROW, RT_LST = 2 * 128 * KROW, RT_END = RT_LST + 2 * 128 * 16 * 4;
static_assert(RT_END <= RING_BYTES, "route lds");
__device__ __forceinline__ unsigned ord_enc(float s) { const unsigned b = __float_as_uint(s); return (b & 0x80000000u) ? ~b : (b | 0x80000000u); }
__device__ __forceinline__ float ord_dec(unsigned p) { const unsigned o = p & ~127u; return __uint_as_float((o & 0x80000000u) ? (o & 0x7fffffffu) : ~o); }
__device__ __forceinline__ void cex_desc(unsigned& a, unsigned& b) { const unsigned hi = a > b ? a : b, lo = a > b ? b : a; a = hi; b = lo; }
__device__ __forceinline__ void bitonic_merge16_desc(unsigned (&v)[16]) {
#pragma unroll
    for (int j = 8; j > 0; j >>= 1)
#pragma unroll
        for (int i = 0; i < 16; ++i) if ((i & j) == 0) cex_desc(v[i], v[i | j]);
}
__device__ __forceinline__ void bitonic_sort16_desc(unsigned (&v)[16]) {
#pragma unroll
    for (int k = 2; k <= 16; k <<= 1)
#pragma unroll
        for (int j = k >> 1; j > 0; j >>= 1)
#pragma unroll
            for (int i = 0; i < 16; ++i) if ((i & j) == 0) { if ((i & k) == 0) cex_desc(v[i], v[i | j]); else cex_desc(v[i | j], v[i]); }
}
__device__ __forceinline__ void top16_merge_desc(unsigned (&a)[16], const unsigned (&b)[16]) {
#pragma unroll
    for (int j = 0; j < 16; ++j) a[j] = a[j] > b[15 - j] ? a[j] : b[15 - j];
    bitonic_merge16_desc(a);
}
__device__ __forceinline__ void route_wg(LAS unsigned char* lds, int nun, int pm0, int ph0, int pm1, int ph1, const float* Q, int* IDX, float* GATE, int tid, int wave, int lane) {
    LAS unsigned* lst = (LAS unsigned*)lds;
    const int kq = lane >> 4, lr = lane & 15;
    __syncthreads();
#pragma unroll 1
    for (int ps = 0; ps < 2 * nun; ++ps) { const int un = ps >> 1, pm = un ? pm1 : pm0, h = un ? ph1 : ph0, ltok = ps * 128 + wave * 16 + lr;
        const float* qp = Q + (size_t)(pm * 256 + (ps & 1) * 128 + wave * 16 + lr) * PQ + h * 256 + kq * 4;
        f32x4 sc[2][8];
#pragma unroll
        for (int c = 0; c < 2; ++c)
#pragma unroll
            for (int t = 0; t < 8; ++t) sc[c][t] = *(const GAS f32x4*)(qp + c * 128 + 16 * t);
#pragma unroll
        for (int c = 0; c < 2; ++c) {
            unsigned L[16], Hh[16];
#pragma unroll
            for (int t = 0; t < 4; ++t)
#pragma unroll
                for (int r = 0; r < 4; ++r) { L[4 * t + r] = (ord_enc(sc[c][t][r]) & ~127u) | (unsigned)(127 - (16 * t + 4 * kq + r)); Hh[4 * t + r] = (ord_enc(sc[c][t + 4][r]) & ~127u) | (unsigned)(127 - (16 * (t + 4) + 4 * kq + r)); }
            bitonic_sort16_desc(L); bitonic_sort16_desc(Hh);
            top16_merge_desc(L, Hh);
#pragma unroll
            for (int sh = 16; sh <= 32; sh <<= 1) { unsigned P[16];
#pragma unroll
                for (int j = 0; j < 16; ++j) P[j] = (unsigned)__shfl_xor((int)L[j], sh);
                top16_merge_desc(L, P); }
            if (kq == 0) { LAS u32x4* lp = (LAS u32x4*)(lst + (c * 512 + ltok) * 16);
                lp[0] = (u32x4){L[0], L[1], L[2], L[3]}; lp[1] = (u32x4){L[4], L[5], L[6], L[7]}; lp[2] = (u32x4){L[8], L[9], L[10], L[11]}; lp[3] = (u32x4){L[12], L[13], L[14], L[15]}; }
        }
    }
    __syncthreads();
    if (tid < 256 * nun) { const int un = tid >> 8, h = un ? ph1 : ph0; const size_t gtok = (size_t)((un ? pm1 : pm0) * 256 + (tid & 255));
        const LAS unsigned* l0 = lst + (0 * 512 + tid) * 16; const LAS unsigned* l1 = lst + (1 * 512 + tid) * 16;
        float fr[16]; const float s10 = ord_dec(l1[0]);
#pragma unroll
        for (int a = 0; a < 16; ++a) fr[a] = ord_dec(l0[a]) + s10;
        unsigned long long P = 0ull; float bs[16]; int be[16];
#pragma unroll
        for (int k = 0; k < 16; ++k) {
            float best = fr[0]; int ba = 0;
#pragma unroll
            for (int a = 1; a < 16; ++a) { const bool gt = fr[a] > best; best = gt ? fr[a] : best; ba = gt ? a : ba; }
            const int pb = (int)((P >> (4 * ba)) & 15ull);
            const unsigned p0 = l0[ba], p1 = l1[pb];
            bs[k] = best; be[k] = (127 - (int)(p0 & 127u)) * PK + (127 - (int)(p1 & 127u));
            const int nb2 = pb + 1; float nf = -3.0e38f;
            if (nb2 < 16) { P += 1ull << (4 * ba); nf = ord_dec(p0) + ord_dec(l1[nb2]); }
#pragma unroll
            for (int a = 0; a < 16; ++a) fr[a] = (a == ba) ? nf : fr[a];
        }
        float e[16], sum = 0.f;
#pragma unroll
        for (int k = 0; k < 16; ++k) { e[k] = __expf(bs[k] - bs[0]); sum += e[k]; }
        const float inv = 1.0f / sum;
        int* ip = IDX + gtok * HK + h * 16; float* gp = GATE + gtok * HK + h * 16;
#pragma unroll
        for (int k = 0; k < 16; ++k) { ip[k] = be[k]; gp[k] = e[k] * inv; }
    }
}

__device__ __forceinline__ float gelu_erf(float v) { return 0.5f * v * (1.0f + erff(v * 0.70710678118654752f)); }
constexpr size_t SLICE_BYTES = (size_t)NEXP * 128;
__device__ __forceinline__ void quant_row_fp8(const float* src, unsigned char* dst, float* scale, int lane) {
    const GAS f32x4* xr = (const GAS f32x4*)src + lane;
    f32x4 v[16]; float am = 0.f;
#pragma unroll
    for (int j = 0; j < 16; ++j) { v[j] = __builtin_nontemporal_load(xr + 64 * j); am = fmaxf(am, fmaxf(fmaxf(fabsf(v[j].x), fabsf(v[j].y)), fmaxf(fabsf(v[j].z), fabsf(v[j].w)))); }
#pragma unroll
    for (int o = 1; o < 64; o <<= 1) am = fmaxf(am, __shfl_xor(am, o));
    const float sc = am > 0.f ? am * (1.0f / 224.0f) : 1.0f, inv = 1.0f / sc;
    GAS unsigned char* o1 = (GAS unsigned char*)dst + (size_t)(lane >> 5) * SLICE_BYTES + (lane & 31) * 4;
#pragma unroll
    for (int j = 0; j < 16; ++j) { int p = __builtin_amdgcn_cvt_pk_fp8_f32(v[j].x * inv, v[j].y * inv, 0, false); p = __builtin_amdgcn_cvt_pk_fp8_f32(v[j].z * inv, v[j].w * inv, p, true); *(GAS unsigned*)(o1 + (size_t)(2 * j) * SLICE_BYTES) = (unsigned)p; }
    if (lane == 0) *scale = sc;
}
__device__ __forceinline__ void quant_row_i8(const float* src, unsigned char* dst, float* scale, int lane) {
    const GAS f32x4* xr = (const GAS f32x4*)src + lane;
    f32x4 v[16]; float am = 0.f;
#pragma unroll
    for (int j = 0; j < 16; ++j) { v[j] = __builtin_nontemporal_load(xr + 64 * j); am = fmaxf(am, fmaxf(fmaxf(fabsf(v[j].x), fabsf(v[j].y)), fmaxf(fabsf(v[j].z), fabsf(v[j].w)))); }
#pragma unroll
    for (int o = 1; o < 64; o <<= 1) am = fmaxf(am, __shfl_xor(am, o));
    const float sc = am > 0.f ? am * (1.0f / 127.0f) : 1.0f, inv = 1.0f / sc;
    GAS unsigned char* o1 = (GAS unsigned char*)dst + (size_t)(lane >> 5) * SLICE_BYTES + (lane & 31) * 4;
#pragma unroll
    for (int j = 0; j < 16; ++j) *(GAS unsigned*)(o1 + (size_t)(2 * j) * SLICE_BYTES) = pack_i8x4(v[j].x * inv, v[j].y * inv, v[j].z * inv, v[j].w * inv);
    if (lane == 0) *scale = sc;
}
__device__ __forceinline__ void rs16(const float (&d)[16], int bit, int sh1, int sh2, int sh3, float (&out)[2]) {
    float n8[8], n4[4];
#pragma unroll
    for (int m = 0; m < 8; ++m) { const bool up = (bit & sh1) != 0; const float mine = up ? d[8 + m] : d[m], theirs = up ? d[m] : d[8 + m]; n8[m] = mine + __shfl_xor(theirs, sh1); }
#pragma unroll
    for (int m = 0; m < 4; ++m) { const bool up = (bit & sh2) != 0; const float mine = up ? n8[4 + m] : n8[m], theirs = up ? n8[m] : n8[4 + m]; n4[m] = mine + __shfl_xor(theirs, sh2); }
#pragma unroll
    for (int m = 0; m < 2; ++m) { const bool up = (bit & sh3) != 0; const float mine = up ? n4[2 + m] : n4[m], theirs = up ? n4[m] : n4[2 + m]; out[m] = mine + __shfl_xor(theirs, sh3); }
}
__device__ __forceinline__ void peer_block(LAS unsigned char* wl, int tok0, const unsigned char* XQ, const float* XS, const unsigned char* U8, const unsigned char* V8, const float* SU, const float* SV, const int* IDX, const float* GATE, const bf16* HB, float* HO, bf16* X2, const float* wfin, int lane) {
    const int rg = lane >> 3, c = lane & 7; const unsigned cofs = (unsigned)c * 16u;
    LAS unsigned short* idxL = (LAS unsigned short*)wl; LAS float* actL = (LAS float*)(wl + 2048); LAS float* ssqL = (LAS float*)(wl + 6144);
#pragma unroll
    for (int j = 0; j < 8; ++j) {
#pragma unroll
        for (int hh = 0; hh < 2; ++hh) { const int k = hh * 64 + lane; idxL[(j * 8 + (k & 7)) * 16 + (k >> 3)] = (unsigned short)IDX[(size_t)(tok0 + j) * HK + k]; }
        *(LAS f32x2*)(actL + j * 128 + lane * 2) = (f32x2){0.f, 0.f}; ssqL[j * 64 + lane] = 0.f; }
    LDS_WAIT();
    for (int urep = 0; urep < NREP(8); ++urep) {
    if (urep) { for (int j = 0; j < 8; ++j) *(LAS f32x2*)(actL + j * 128 + lane * 2) = (f32x2){0.f, 0.f}; LDS_WAIT(); }
#define PB_LOAD(buf, tab, it) do { const int _s = (it) >> 3, _j = (it) & 7; const GAS unsigned char* _base = (const GAS unsigned char*)(tab) + (size_t)_s * SLICE_BYTES; \
        const u32x4 _ia = *(const LAS u32x4*)(idxL + (_j * 8 + rg) * 16), _ib = *(const LAS u32x4*)(idxL + (_j * 8 + rg) * 16 + 8); const unsigned _iw[8] = {_ia.x, _ia.y, _ia.z, _ia.w, _ib.x, _ib.y, _ib.z, _ib.w}; \
        _Pragma("unroll") for (int _i = 0; _i < 16; ++_i) { const unsigned _e = (_iw[_i >> 1] >> (16 * (_i & 1))) & 0xffffu; buf[_i] = *(const GAS u32x4*)(_base + (_e * 128u + cofs)); } } while (0)
#define PB_XLOAD(xa, it) do { xa = __builtin_nontemporal_load((const GAS u32x4*)(XQ + (size_t)(tok0 + ((it) & 7)) * D + ((it) >> 3) * 128 + c * 16)); } while (0)
#define PB_UCOMP(buf, xa, it) do { const int _j = (it) & 7; float _d[16]; \
        _Pragma("unroll") for (int _i = 0; _i < 16; ++_i) { int _a = __builtin_amdgcn_sdot4((int)buf[_i].x, (int)xa.x, 0, false); _a = __builtin_amdgcn_sdot4((int)buf[_i].y, (int)xa.y, _a, false); \
            _a = __builtin_amdgcn_sdot4((int)buf[_i].z, (int)xa.z, _a, false); _a = __builtin_amdgcn_sdot4((int)buf[_i].w, (int)xa.w, _a, false); _d[_i] = (float)_a; } \
        float _n2[2]; rs16(_d, c, 4, 2, 1, _n2); \
        LAS f32x2* _pp = (LAS f32x2*)(actL + _j * 128 + lane * 2); f32x2 _p = *_pp; _p.x += _n2[0]; _p.y += _n2[1]; *_pp = _p; } while (0)
    {   u32x4 bufA[16], bufB[16], xaA, xaB;
        PB_XLOAD(xaA, 0); PB_LOAD(bufA, U8, 0);
#pragma unroll 1
        for (int it = 0; it < 256; it += 2) {
            PB_XLOAD(xaB, it + 1); PB_LOAD(bufB, U8, it + 1);
            __builtin_amdgcn_sched_barrier(0);
            PB_UCOMP(bufA, xaA, it);
            __builtin_amdgcn_sched_barrier(0);
            PB_XLOAD(xaA, (it + 2) & 255); PB_LOAD(bufA, U8, (it + 2) & 255);
            __builtin_amdgcn_sched_barrier(0);
            PB_UCOMP(bufB, xaB, it + 1);
            __builtin_amdgcn_sched_barrier(0);
        }
    }
    }
#pragma unroll 1
    for (int j = 0; j < 8; ++j) { const int tok = tok0 + j, k0 = 16 * c + rg, k1 = k0 + 8;
        LAS f32x2* pp = (LAS f32x2*)(actL + j * 128 + lane * 2); const f32x2 p = *pp;
        const unsigned ew = *(const LAS unsigned*)(idxL + (j * 8 + rg) * 16 + 2 * c); const int e0 = (int)(ew & 0xffffu), e1 = (int)(ew >> 16);
        const float g0 = GATE[(size_t)tok * HK + k0], g1 = GATE[(size_t)tok * HK + k1];
        const float xs = XS[tok]; const float a0 = gelu_erf(p.x * xs * SU[e0]) * g0 * SV[e0], a1 = gelu_erf(p.y * xs * SU[e1]) * g1 * SV[e1];
        *pp = (f32x2){a0, a1}; }
    LDS_WAIT();
    for (int vrep = 0; vrep < NREP(9); ++vrep) {
    if (vrep) { for (int j = 0; j < 8; ++j) ssqL[j * 64 + lane] = 0.f; LDS_WAIT(); }
#define PB_HOFF(it) ((size_t)(tok0 + ((it) & 7)) * D + ((it) >> 3) * 128 + 16 * c + 2 * rg)
#define PB_HPTR(it) ((const GAS unsigned*)(HB + PB_HOFF(it)))
#define PB_VCOMP(buf, hv, it) do { const int _j = (it) & 7; \
        const LAS f32x4* _ap = (const LAS f32x4*)(actL + (_j * 8 + rg) * 16); const f32x4 _a0 = _ap[0], _a1 = _ap[1], _a2 = _ap[2], _a3 = _ap[3]; \
        const float _av[16] = {_a0.x, _a0.y, _a0.z, _a0.w, _a1.x, _a1.y, _a1.z, _a1.w, _a2.x, _a2.y, _a2.z, _a2.w, _a3.x, _a3.y, _a3.z, _a3.w}; \
        f32x2 _o[8]; _Pragma("unroll") for (int _m = 0; _m < 8; ++_m) _o[_m] = (f32x2){0.f, 0.f}; \
        _Pragma("unroll") for (int _i = 0; _i < 16; ++_i) { const f32x2 _a2v = (f32x2){_av[_i], _av[_i]}; const unsigned _w[4] = {buf[_i].x, buf[_i].y, buf[_i].z, buf[_i].w}; \
            _Pragma("unroll") for (int _q = 0; _q < 4; ++_q) { const f32x2 _lo = __builtin_amdgcn_cvt_pk_f32_fp8((int)_w[_q], false), _hi = __builtin_amdgcn_cvt_pk_f32_fp8((int)_w[_q], true); _o[2 * _q] += _a2v * _lo; _o[2 * _q + 1] += _a2v * _hi; } } \
        const float _ov[16] = {_o[0].x, _o[0].y, _o[1].x, _o[1].y, _o[2].x, _o[2].y, _o[3].x, _o[3].y, _o[4].x, _o[4].y, _o[5].x, _o[5].y, _o[6].x, _o[6].y, _o[7].x, _o[7].y}; \
        float _n2[2]; rs16(_ov, lane, 32, 16, 8, _n2); \
        f32x2 _h = (f32x2){bflo(hv), bfhi(hv)}; _h.x += _n2[0]; _h.y += _n2[1]; __builtin_nontemporal_store(cvtpk(_h.x, _h.y), (GAS unsigned*)(X2 + PB_HOFF(it))); ssqL[_j * 64 + lane] += _h.x * _h.x + _h.y * _h.y; } while (0)
    {   u32x4 bufA[16], bufB[16]; unsigned hvA, hvB;
        PB_LOAD(bufA, V8, 0); hvA = __builtin_nontemporal_load(PB_HPTR(0));
#pragma unroll 1
        for (int it = 0; it < 256; it += 2) {
            PB_LOAD(bufB, V8, it + 1); hvB = __builtin_nontemporal_load(PB_HPTR(it + 1));
            __builtin_amdgcn_sched_barrier(0);
            PB_VCOMP(bufA, hvA, it);
            __builtin_amdgcn_sched_barrier(0);
            if (it + 2 < 256) { PB_LOAD(bufA, V8, it + 2); hvA = __builtin_nontemporal_load(PB_HPTR(it + 2)); }
            __builtin_amdgcn_sched_barrier(0);
            PB_VCOMP(bufB, hvB, it + 1);
            __builtin_amdgcn_sched_barrier(0);
        }
    }
    }
#undef PB_LOAD
#undef PB_XLOAD
#undef PB_UCOMP
#undef PB_HPTR
#undef PB_HOFF
#undef PB_VCOMP
    LDS_WAIT();
#pragma unroll 1
    for (int j = 0; j < 8; ++j) { const float rs = 1.0f / sqrtf(wave_sum(ssqL[j * 64 + lane]) * (1.f / D) + EPS);
        const GAS u32x2* sp = (const GAS u32x2*)(X2 + (size_t)(tok0 + j) * D) + lane; GAS f32x4* rp = (GAS f32x4*)(HO + (size_t)(tok0 + j) * D) + lane; const GAS f32x4* gp = (const GAS f32x4*)wfin + lane;
#pragma unroll 4
        for (int q = 0; q < 16; ++q) { const u32x2 v = __builtin_nontemporal_load(sp + 64 * q); const f32x4 g = gp[64 * q]; rp[64 * q] = (f32x4){bflo(v.x) * rs * g.x, bfhi(v.x) * rs * g.y, bflo(v.y) * rs * g.z, bfhi(v.y) * rs * g.w}; } }
}

struct Args { const float* in[18]; float* out; unsigned char* ws; int ph_lo, ph_hi, li, pad; };
__global__ void __launch_bounds__(NWAVES * 64, 2) mk_fwd(Args args) {
    extern __shared__ __attribute__((aligned(16))) unsigned char lds_raw[];
    LAS unsigned char* lds = (LAS unsigned char*)lds_raw;
    volatile LAS unsigned* MISC = (volatile LAS unsigned*)(lds + MISC_OFF);
    const int tid = threadIdx.x, lane = tid & 63, wave = __builtin_amdgcn_readfirstlane(tid >> 6);
    const int G = gridDim.x, bid = blockIdx.x;
    const int vcu = (G % 8 == 0) ? (bid % 8) * (G / 8) + bid / 8 : bid;
    unsigned char* ws = args.ws;
    gu32* ctl = (gu32*)(ws + WS_CTL);
    const float* x = args.in[0]; const float* w_in = args.in[1]; const float* ssd_conv_w = args.in[2]; const float* ssd_conv_b = args.in[3]; const float* ssd_dt_bias = args.in[4];
    const float* ssd_a_log = args.in[5]; const float* ssd_d = args.in[6]; const float* ssd_norm_w = args.in[7]; const float* sc_conv_w = args.in[8]; const float* sc_norm_w = args.in[9];
    const float* w_out = args.in[10]; const float* norm_mix_w = args.in[11]; const float* norm_ffn_w = args.in[12]; const float* w_query = args.in[13]; const float* sub_keys = args.in[14];
    const float* peer_u = args.in[15]; const float* peer_v = args.in[16]; const float* norm_final_w = args.in[17];
    float* out = args.out;
    bf16* XN = (bf16*)(ws + WS_XN); bf16* WIN = (bf16*)(ws + WS_WIN); bf16* WOUT = (bf16*)(ws + WS_WOUT); bf16* WQ = (bf16*)(ws + WS_WQ); bf16* Y = (bf16*)(ws + WS_Y); bf16* PROJ = (bf16*)(ws + WS_PROJ);
    unsigned char* U8 = ws + WS_U8; unsigned char* V8 = ws + WS_V8; float* SU = (float*)(ws + WS_SU); float* SV = (float*)(ws + WS_SV); unsigned char* XQ = ws + WS_XQ; float* XS = (float*)(ws + WS_XS); float* RS = XS + 16384; float* QF = (float*)(ws + WS_Q); float* SSQ = (float*)(ws + WS_SSQ); bf16* HB = (bf16*)(ws + WS_HB); bf16* KHI = (bf16*)(ws + WS_KH); bf16* KLO = KHI + 8 * 2 * 128 * 128;
    int* IDX = (int*)(ws + WS_IDX); float* GATE = (float*)(ws + WS_GATE);

    for (int u = tid; u < (LDS_BYTES - LDSCTL_OFF) / 4; u += NWAVES * 64) ((LAS unsigned*)(lds + LDSCTL_OFF))[u] = 0u;
    __syncthreads();
    XcdBarrier bar; bar.bar = (unsigned*)(ctl + CW_BAR); bar.x = 0; bar.st = nullptr;
    if (N_LAUNCHES == 1) bar = xcd_barrier_post((unsigned*)(ctl + CW_BAR), MISC + 8);
#define GRID_BAR() do { if (N_LAUNCHES == 1) xcd_barrier(bar); } while (0)
    const int lo = args.ph_lo, hi = args.ph_hi;
#ifndef PH_MASK
#define PH_MASK 0x1ff
#endif
#define PH_EN(k) (((PH_MASK) >> (k)) & 1)

#define IN(k) (lo <= (k) && (k) < hi)
#define BOTH(k) (IN(k) && IN((k) + 1 + ((k) == 6)))
    const int gw = vcu * NWAVES + wave, NGW = G * NWAVES;

    if (PH_EN(0) && IN(0)) { for (int rep = 0; rep < NREP(0); ++rep) {
        LAS float* scr = (LAS float*)(lds + RING_OFF + wave * 16384);
        constexpr int I_IN = (D / 64) * (NPROJ / 32);
        for (int it = gw; it < I_IN; it += NGW) p0_transpose_item(w_in, D, NPROJ, WIN, true, nullptr, scr, it, lane);
        { GAS v4u* z = (GAS v4u*)(WIN + (size_t)NPROJ * D); const size_t n16 = (size_t)(NP - NPROJ) * D * 2 / 16;
          for (size_t i = (size_t)bid * 512 + tid; i < n16; i += (size_t)G * 512) z[i] = (v4u){0u, 0u, 0u, 0u}; }
        for (int m = gw; m < M; m += NGW) rms_row_to_bf16(x + (size_t)m * D, norm_mix_w, XN + (size_t)m * D, lane);
        __syncthreads(); }
        if (BOTH(0)) GRID_BAR();
    }
    if (PH_EN(1) && IN(1)) {
        pg8::Gemm g{XN, WIN, M, NP, D}; pg8::StaticOrder S; S.init(M, NP, G, bid);
        pg8::EpiProj E{PROJ, PP, CH_TILE0, CH_TILES, O_U};
        pg8::gemm_phase<pg8::EpiProj, pg8::StaticOrder, PG8_ALIGN, PG8_SP2>(lds + RING_OFF, g, S, E);
        if (NREP(1) == 2) { __syncthreads(); pg8::gemm_phase<pg8::EpiProj, pg8::StaticOrder, PG8_ALIGN, PG8_SP2>(lds + RING_OFF, g, S, E); }
        {
            const int nwg = (M / 256) * (NP / 256), rem = nwg % G, first = rem ? rem : 0, nb = G - first;
            if (bid >= first) {
                __syncthreads();
                LAS float* scr = (LAS float*)(lds + RING_OFF + wave * 16384);
                const int fi0 = bid - first;
                for (int wt = fi0; wt < 16 * (D / 512); wt += nb) { const int kb = wt >> 3, d = (wt & 7) * 512 + tid;
                    LAS float* kl = (LAS float*)(lds + RING_OFF);
                    for (int i = tid; i < 128 * 128 / 4; i += 512) ((LAS f32x4*)kl)[i] = ((const GAS f32x4*)(sub_keys + (size_t)kb * 16384))[i];
                    float wq[128]; const float gd = norm_ffn_w[d];
#pragma unroll
                    for (int jj = 0; jj < 32; ++jj) { const f32x4 t = *(const GAS f32x4*)(w_query + (size_t)d * PQ + kb * 128 + 4 * jj); wq[4 * jj] = t.x * gd; wq[4 * jj + 1] = t.y * gd; wq[4 * jj + 2] = t.z * gd; wq[4 * jj + 3] = t.w * gd; }
                    __syncthreads();
#pragma unroll 1
                    for (int k = 0; k < 128; ++k) { float a0 = 0.f, a1 = 0.f;
#pragma unroll
                        for (int jj = 0; jj < 32; ++jj) { const f32x4 kk = *(const LAS f32x4*)(kl + k * 128 + 4 * jj); a0 += wq[4 * jj] * kk.x + wq[4 * jj + 2] * kk.z; a1 += wq[4 * jj + 1] * kk.y + wq[4 * jj + 3] * kk.w; }
                        ((GAS unsigned short*)WQ)[(size_t)(kb * 128 + k) * D + d] = (unsigned short)(cvtpk(a0 + a1, 0.f) & 0xffffu); }
                    __syncthreads(); }
                constexpr int I_OUT = (D_MIX / 64) * (D / 32);
                const int gwt = (bid - first) * NWAVES + wave, ngwt = nb * NWAVES;
                for (int it = gwt; it < I_OUT; it += ngwt) p0_transpose_item(w_out, D_MIX, D, WOUT, false, nullptr, scr, it, lane);
            }
        }
        {
            unsigned* tk = (unsigned*)(ctl + CW_TICKET);
            for (;;) { unsigned t0 = 0; if (lane == 0) t0 = xb_add(tk, 1u); t0 = __builtin_amdgcn_readfirstlane(t0); if (t0 >= 2u * NEXP / 4u) break;
#pragma unroll 1
                for (int k = 0; k < 4; ++k) { const int r = (int)t0 * 4 + k; const bool second = r >= NEXP; const int e = second ? r - NEXP : r;
                    if (second) quant_row_fp8(peer_v + (size_t)e * D, V8 + (size_t)e * 128, SV + e, lane); else quant_row_i8(peer_u + (size_t)e * D, U8 + (size_t)e * 128, SU + e, lane); } }
        }
        if (BOTH(1)) GRID_BAR();
    }
    if (PH_EN(2) && IN(2)) {
        bf16* CONV = (bf16*)(ws + WS_CONV);
        for (int rep = 0; rep < NREP(2); ++rep) {
        for (int prep = 0; prep < NREP(10); ++prep) conv_prepass(PROJ, ssd_conv_w, ssd_conv_b, CONV, vcu * 512 + tid, G * 512);
        GRID_BAR();
        for (int u = bid; u < NB * NH; u += G) {
            const int xc = u & 7, j = u >> 3, bg = xc * 4 + (j >> 3), hh = j & 7, b = bg >> 3, gq = bg & 7, h = gq * 8 + hh;
            ssd_unit(lds, b, h, PROJ, CONV, ssd_dt_bias, ssd_a_log, ssd_d, Y, SSQ, tid, wave, lane);
        }
        }
        if (BOTH(2)) GRID_BAR();
    }
    if (PH_EN(3) && IN(3)) {
        for (int m2 = gw; m2 < M / 2; m2 += NGW) p3_rows2(2 * m2, PROJ, sc_conv_w, sc_norm_w, ssd_norm_w, SSQ, Y, lds + RING_OFF + wave * 16384, lane);
        if (BOTH(3)) GRID_BAR();
    }
    if (PH_EN(4) && IN(4)) {
        pg8::Gemm g{Y, WOUT, M, D, D_MIX}; pg8::StaticOrder S; S.init(M, D, G, bid);
        pg8::EpiResBf16 E{HB, x, D};
        pg8::gemm_phase<pg8::EpiResBf16, pg8::StaticOrder, PG8_ALIGN, PG8_SP2>(lds + RING_OFF, g, S, E);
        if (NREP(4) == 2) { __syncthreads(); pg8::gemm_phase<pg8::EpiResBf16, pg8::StaticOrder, PG8_ALIGN, PG8_SP2>(lds + RING_OFF, g, S, E); }
        if (BOTH(4)) GRID_BAR();
    }
    if (PH_EN(5) && IN(5)) { for (int rep = 0; rep < NREP(5); ++rep) {
        for (int m = gw; m < M; m += NGW) rms_row_to_bf16_i8(HB + (size_t)m * D, norm_ffn_w, RS + m, XQ + (size_t)m * D, XS + m, lane);
        }
        if (BOTH(5)) GRID_BAR();
    }
    if (PH_EN(6) && IN(6)) {
        pg8::Gemm g{HB, WQ, M, PQ, D}; pg8::StaticOrder S; S.init(M, PQ, G, bid);
        pg8::EpiRowScaleF32 E{QF, RS, PQ};
        pg8::gemm_phase<pg8::EpiRowScaleF32, pg8::StaticOrder, PG8_ALIGN, PG8_SP2>(lds + RING_OFF, g, S, E);
        if (NREP(6) == 2) { __syncthreads(); pg8::gemm_phase<pg8::EpiRowScaleF32, pg8::StaticOrder, PG8_ALIGN, PG8_SP2>(lds + RING_OFF, g, S, E); }
        asm volatile("s_waitcnt vmcnt(0)" ::: "memory"); __syncthreads();
        for (int i = 0; ; i += 2) { pg8::Unit u0, u1; if (!S.next(i, u0)) break; const bool two = S.next(i + 1, u1);
            route_wg(lds + RING_OFF, two ? 2 : 1, u0.pm, u0.pn, two ? u1.pm : u0.pm, two ? u1.pn : u0.pn, QF, IDX, GATE, tid, wave, lane); }
        if (BOTH(6)) GRID_BAR();
    }
    if (PH_EN(8) && IN(8)) {
        for (int t8 = bid * NWAVES + wave; t8 < M / 8; t8 += G * NWAVES) peer_block(lds + wave * 8192, t8 * 8, XQ, XS, U8, V8, SU, SV, IDX, GATE, HB, out, (bf16*)(ws + WS_Y), norm_final_w, lane);
    }
#undef IN
#undef BOTH
#undef GRID_BAR
}

extern "C" void kernel_launch(void* const* d_in, const int* in_sizes, int n_in, void* d_out, int out_size, void* d_ws, size_t ws_size, hipStream_t stream) {
    static int grid = 0;
    if (grid == 0) {
        if (n_in != 18 || in_sizes[0] != M * D || out_size != M * D || ws_size < WS_END) { fprintf(stderr, "kernel_launch: unexpected shapes / workspace: n_in %d in0 %d out %d ws %zu (need %zu)\n", n_in, n_in > 0 ? in_sizes[0] : -1, out_size, ws_size, (size_t)WS_END); grid = -1; return; }
        int dev = 0, cus = 0, per_cu = 0;
        if (hipGetDevice(&dev) != hipSuccess || hipDeviceGetAttribute(&cus, hipDeviceAttributeMultiprocessorCount, dev) != hipSuccess) { fprintf(stderr, "kernel_launch: device query failed\n"); grid = -1; return; }
        if (hipFuncSetAttribute((const void*)mk_fwd, hipFuncAttributeMaxDynamicSharedMemorySize, LDS_BYTES) != hipSuccess) { fprintf(stderr, "kernel_launch: hipFuncSetAttribute failed\n"); grid = -1; return; }
        if (hipOccupancyMaxActiveBlocksPerMultiprocessor(&per_cu, (const void*)mk_fwd, NWAVES * 64, LDS_BYTES) != hipSuccess || per_cu < 1)
            fprintf(stderr, "kernel_launch: note: occupancy query reports %d workgroups per CU\n", per_cu);
        (void)hipGetLastError();
        grid = cus;
    }
    if (grid < 0) return;
    if (hipMemsetAsync((char*)d_ws + WS_CTL, 0, CTL_ZERO_BYTES, stream) != hipSuccess) { fprintf(stderr, "kernel_launch: memset failed\n"); return; }
    Args a{};
    for (int i = 0; i < 18; ++i) a.in[i] = (const float*)d_in[i];
    a.out = (float*)d_out; a.ws = (unsigned char*)d_ws;
    for (int li = 0; li < N_LAUNCHES; ++li) {
        a.ph_lo = (N_LAUNCHES == 1) ? 0 : li; a.ph_hi = (N_LAUNCHES == 1) ? NPHASE : li + 1; a.li = li; a.pad = 0;
        hipLaunchKernelGGL(mk_fwd, dim3(grid), dim3(NWAVES * 64), LDS_BYTES, stream, a);
        const hipError_t le = hipPeekAtLastError();
        if (le != hipSuccess) { fprintf(stderr, "kernel_launch: launch %d failed: %s\n", li, hipGetErrorName(le)); break; }
    }
}
```

```cpp
#include <hip/hip_runtime.h>
#include <cstdio>
#include <cstdint>
namespace pg8 {
#define PG8_LAS __attribute__((address_space(3)))
typedef unsigned short bf16_t;
typedef short bf16x8 __attribute__((ext_vector_type(8)));
typedef float f32x4 __attribute__((ext_vector_type(4)));
typedef unsigned u32x4 __attribute__((ext_vector_type(4)));
constexpr int BM = 256, BK = 64, HALF = 128, HTB = HALF * BK * 2  , STAGE_BYTES = 8 * HTB, NXCD = 8, WGM = 8;

__host__ __device__ __forceinline__ int lds_byte(int r, int c) { const int st = (r >> 4) * 2 + (c >> 5), rr = r & 15, cc = c & 31, ob = rr * 64 + cc * 2; return st * 1024 + (ob ^ (((ob >> 9) & 1) << 5)); }
__host__ __device__ __forceinline__ void stage_rc(int b, int& R, int& C) { const int st = b / 1024, sb = b % 1024, swz = sb ^ (((sb >> 9) & 1) << 5); R = (st >> 1) * 16 + swz / 64; C = (st & 1) * 32 + (swz % 64) / 2; }
__host__ __device__ __forceinline__ int perm32(int rho) { const int n = rho >> 4, i = rho & 15; return 8 * (i >> 2) + 4 * n + (i & 3); }

struct Unit { int pm, pn; };
struct Gemm { const bf16_t* A; const bf16_t* Bt; int M, N, K; };

struct StaticOrder {
    int nM, nN, nwg, G, c;
    __host__ __device__ void init(int M, int N, int G_, int c_) { nM = M / BM; nN = N / BM; nwg = nM * nN; G = G_; c = c_; }
    __host__ __device__ bool next(int i, Unit& u) const {
        const long L = (long)i * G + c; if (L >= nwg) return false;
        int wgid = (int)L; { const int q = nwg / NXCD, r = nwg % NXCD, xcd = wgid % NXCD, off = wgid / NXCD; wgid = (xcd < r ? xcd * (q + 1) : r * (q + 1) + (xcd - r) * q) + off; }
        const int nig = WGM * nN, gid = wgid / nig, fm = gid * WGM, gsz = (nM - fm) < WGM ? (nM - fm) : WGM;
        u.pm = fm + ((wgid % nig) % gsz); u.pn = (wgid % nig) / gsz; return true;
    }
    __device__ __forceinline__ void a_ready(const Unit&) const {}
    __device__ __forceinline__ void done(const Unit&) const {}
};

__device__ __forceinline__ unsigned cvt_pk_bf16(float lo, float hi) { unsigned r; asm volatile("v_cvt_pk_bf16_f32 %0, %1, %2" : "=v"(r) : "v"(lo), "v"(hi)); return r; }
typedef float f32x2 __attribute__((ext_vector_type(2)));
__device__ __forceinline__ f32x2 gelu_pk(f32x2 v) {
    const f32x2 av = __builtin_elementwise_abs(v), d = av * 0.2316418882f + 1.0f;
    f32x2 t; t.x = __builtin_amdgcn_rcpf(d.x); t.y = __builtin_amdgcn_rcpf(d.y);
    f32x2 q = t * 0.5307027145f + (-0.7265760135f); q = q * t + 0.7107068705f; q = q * t + (-0.142248368f); q = q * t + 0.127414796f; q = q * t;
    const f32x2 s = (v * v) * (-0.72134752044f);
    f32x2 e; e.x = __builtin_amdgcn_exp2f(s.x); e.y = __builtin_amdgcn_exp2f(s.y);
    const f32x2 m = v * (q * e), r = v - m;
    f32x2 o; o.x = v.x < 0.f ? m.x : r.x; o.y = v.y < 0.f ? m.y : r.y; return o;
}

template <int ACT  > struct EpiBf16 {
    static constexpr bool PERM = true, AFTER_DRAIN = false; static_assert(ACT == 0 || ACT == 1, "EpiBf16: ACT is 0 (none) or 1 (gelu_pk)");
    bf16_t* O; int ldc; const float* bias; int split_cols; size_t split_stride; float scale0;
    __device__ __forceinline__ void operator()(const f32x4 (&acc)[2][2][4][2], const Unit& u, int wr, int wc, int fr, int fq) const {
        const int row0 = u.pm * BM + wr * 64 + fr; int colt = u.pn * BM; bf16_t* base = O;
        float sc = 1.f; if (split_cols) { const int t = colt / split_cols; base += (size_t)t * split_stride; colt -= t * split_cols; if (t == 0) sc = scale0; }
        const int col0 = colt + wc * 32 + 8 * fq, bcol0 = u.pn * BM + wc * 32 + 8 * fq;
        f32x4 bv[2][2];
#pragma unroll
        for (int bj = 0; bj < 2; ++bj)
#pragma unroll
            for (int n = 0; n < 2; ++n) bv[bj][n] = bias ? *(const f32x4*)(bias + bcol0 + bj * HALF + 4 * n) : (f32x4){0.f, 0.f, 0.f, 0.f};
#pragma unroll
        for (int ai = 0; ai < 2; ++ai)
#pragma unroll
            for (int m = 0; m < 4; ++m) { bf16_t* rowp = base + (size_t)(row0 + ai * HALF + m * 16) * ldc + col0;
#pragma unroll
                for (int bj = 0; bj < 2; ++bj) { f32x4 v0 = acc[ai][bj][m][0] + bv[bj][0], v1 = acc[ai][bj][m][1] + bv[bj][1];
                    if (ACT == 1) { f32x2 a = gelu_pk((f32x2){v0[0], v0[1]}), b = gelu_pk((f32x2){v0[2], v0[3]}), c = gelu_pk((f32x2){v1[0], v1[1]}), d = gelu_pk((f32x2){v1[2], v1[3]});
                        v0 = (f32x4){a.x, a.y, b.x, b.y}; v1 = (f32x4){c.x, c.y, d.x, d.y}; }
                    v0 = v0 * sc; v1 = v1 * sc; u32x4 w; w.x = cvt_pk_bf16(v0[0], v0[1]); w.y = cvt_pk_bf16(v0[2], v0[3]); w.z = cvt_pk_bf16(v1[0], v1[1]); w.w = cvt_pk_bf16(v1[2], v1[3]);
                    __builtin_nontemporal_store(w, (u32x4*)(rowp + bj * HALF)); } }
    }
};

struct EpiResF32 {
    static constexpr bool PERM = false, AFTER_DRAIN = false;
    float* C; const float* R; int ldc;
    __device__ __forceinline__ void operator()(const f32x4 (&acc)[2][2][4][2], const Unit& u, int wr, int wc, int fr, int fq) const {
        const int row0 = u.pm * BM + wr * 64 + fr, col0 = u.pn * BM + wc * 32 + 4 * fq;
#pragma unroll
        for (int ai = 0; ai < 2; ++ai)
#pragma unroll
            for (int m = 0; m < 4; ++m) { const size_t off = (size_t)(row0 + ai * HALF + m * 16) * ldc + col0;
#pragma unroll
                for (int bj = 0; bj < 2; ++bj)
#pragma unroll
                    for (int n = 0; n < 2; ++n) { f32x4 r = (f32x4){0.f, 0.f, 0.f, 0.f}; if (R) r = *(const f32x4*)(R + off + bj * HALF + n * 16);
                        __builtin_nontemporal_store(acc[ai][bj][m][n] + r, (f32x4*)(C + off + bj * HALF + n * 16)); }
                asm volatile("" ::: "memory"); }
    }
};
struct EpiResBf16 {
    static constexpr bool PERM = true, AFTER_DRAIN = false;
    bf16_t* O; const float* R; int ldc;
    __device__ __forceinline__ void operator()(const f32x4 (&acc)[2][2][4][2], const Unit& u, int wr, int wc, int fr, int fq) const {
        const int row0 = u.pm * BM + wr * 64 + fr, col0 = u.pn * BM + wc * 32 + 8 * fq;
#pragma unroll
        for (int ai = 0; ai < 2; ++ai)
#pragma unroll
            for (int m = 0; m < 4; ++m) { const size_t off = (size_t)(row0 + ai * HALF + m * 16) * ldc + col0;
#pragma unroll
                for (int bj = 0; bj < 2; ++bj) { const f32x4 r0 = __builtin_nontemporal_load((const f32x4*)(R + off + bj * HALF)), r1 = __builtin_nontemporal_load((const f32x4*)(R + off + bj * HALF + 4));
                    const f32x4 v0 = acc[ai][bj][m][0] + r0, v1 = acc[ai][bj][m][1] + r1;
                    u32x4 w; w.x = cvt_pk_bf16(v0[0], v0[1]); w.y = cvt_pk_bf16(v0[2], v0[3]); w.z = cvt_pk_bf16(v1[0], v1[1]); w.w = cvt_pk_bf16(v1[2], v1[3]);
                    __builtin_nontemporal_store(w, (u32x4*)(O + off + bj * HALF)); }
                asm volatile("" ::: "memory"); }
    }
};
struct EpiProj {
    static constexpr bool PERM = true, AFTER_DRAIN = false;
    bf16_t* O; int ldc, ch_tile0, ch_tiles, u_col0;
    __device__ __forceinline__ void operator()(const f32x4 (&acc)[2][2][4][2], const Unit& u, int wr, int wc, int fr, int fq) const {
        const int row0 = u.pm * BM + wr * 64 + fr, cin = wc * 32 + 8 * fq;
        const bool chv = u.pn >= ch_tile0 && u.pn < ch_tile0 + ch_tiles;
        if (chv) { const int col0 = u_col0 + (u.pn - ch_tile0) * HALF + cin;
#pragma unroll
            for (int ai = 0; ai < 2; ++ai)
#pragma unroll
                for (int m = 0; m < 4; ++m) { const f32x4 v0 = acc[ai][0][m][0] * acc[ai][1][m][0], v1 = acc[ai][0][m][1] * acc[ai][1][m][1];
                    u32x4 w; w.x = cvt_pk_bf16(v0[0], v0[1]); w.y = cvt_pk_bf16(v0[2], v0[3]); w.z = cvt_pk_bf16(v1[0], v1[1]); w.w = cvt_pk_bf16(v1[2], v1[3]);
                    __builtin_nontemporal_store(w, (u32x4*)(O + (size_t)(row0 + ai * HALF + m * 16) * ldc + col0)); }
        } else { const int col0 = (u.pn >= ch_tile0 + ch_tiles ? u.pn - ch_tiles / 2 : u.pn) * BM + cin;
#pragma unroll
            for (int ai = 0; ai < 2; ++ai)
#pragma unroll
                for (int m = 0; m < 4; ++m) { bf16_t* rowp = O + (size_t)(row0 + ai * HALF + m * 16) * ldc + col0;
#pragma unroll
                    for (int bj = 0; bj < 2; ++bj) { const f32x4 v0 = acc[ai][bj][m][0], v1 = acc[ai][bj][m][1];
                        u32x4 w; w.x = cvt_pk_bf16(v0[0], v0[1]); w.y = cvt_pk_bf16(v0[2], v0[3]); w.z = cvt_pk_bf16(v1[0], v1[1]); w.w = cvt_pk_bf16(v1[2], v1[3]);
                        __builtin_nontemporal_store(w, (u32x4*)(rowp + bj * HALF)); } }
        }
    }
};
struct EpiRowScaleF32 {
    static constexpr bool PERM = false, AFTER_DRAIN = false;
    float* C; const float* rowscale; int ldc;
    __device__ __forceinline__ void operator()(const f32x4 (&acc)[2][2][4][2], const Unit& u, int wr, int wc, int fr, int fq) const {
        const int row0 = u.pm * BM + wr * 64 + fr, col0 = u.pn * BM + wc * 32 + 4 * fq;
#pragma unroll
        for (int ai = 0; ai < 2; ++ai)
#pragma unroll
            for (int m = 0; m < 4; ++m) { const int row = row0 + ai * HALF + m * 16; const float rsv = rowscale[row]; const size_t off = (size_t)row * ldc + col0;
#pragma unroll
                for (int bj = 0; bj < 2; ++bj)
#pragma unroll
                    for (int n = 0; n < 2; ++n) __builtin_nontemporal_store(acc[ai][bj][m][n] * rsv, (f32x4*)(C + off + bj * HALF + n * 16)); }
    }
};
template <class Epi, class Sched, bool ALIGN_EPI = false, bool SP2 = false>
__device__ __forceinline__ void gemm_phase(PG8_LAS unsigned char* lds, const Gemm g, const Sched& S, const Epi& E) {
    const int tid = threadIdx.x, wid = __builtin_amdgcn_readfirstlane(tid >> 6), lane = tid & 63, wr = wid >> 2, wc = wid & 3, fr = lane & 15, fq = lane >> 4;
    const int K = g.K, nt = K / BK;
    unsigned voffA[2], voffB[2];
#pragma unroll
    for (int i = 0; i < 2; ++i) { int R, C; stage_rc(tid * 16 + i * 8192, R, C); const int Rb = Epi::PERM ? ((R & ~31) + perm32(R & 31)) : R;
        voffA[i] = (unsigned)(R * K + C) * 2u; voffB[i] = (unsigned)(Rb * K + C) * 2u; }
    const size_t kstep = (size_t)(BK * 2);
    const size_t hstep = (size_t)HALF * K * 2;
    const size_t tstep = 2 * hstep;
    const unsigned ldsw = (unsigned)wid * 1024u;
    const int aoff = lds_byte(wr * 64 + fr, fq * 8), boff = lds_byte(wc * 32 + fr, fq * 8);
#define PG8_SA(b, h) (((b) * 2 + (h)) * HTB)
#define PG8_SB(b, h) ((4 + (b) * 2 + (h)) * HTB)
#define PG8_STAGE(bufoff, gbase, voff) do { _Pragma("unroll") for (int _i = 0; _i < 2; ++_i) \
        __builtin_amdgcn_global_load_lds((const unsigned*)((const char*)(gbase) + (voff)[_i]), (PG8_LAS unsigned*)(lds + (bufoff) + ldsw + _i * 8192), 16, 0, 0); } while (0)
#define PG8_LDA(dst, b, h) do { _Pragma("unroll") for (int m = 0; m < 4; ++m) _Pragma("unroll") for (int k = 0; k < 2; ++k) dst[m][k] = *(const PG8_LAS bf16x8*)(lds + PG8_SA(b, h) + aoff + m * 2048 + k * 1024); } while (0)
#define PG8_LDB(dst, b, h) do { _Pragma("unroll") for (int n = 0; n < 2; ++n) _Pragma("unroll") for (int k = 0; k < 2; ++k) dst[n][k] = *(const PG8_LAS bf16x8*)(lds + PG8_SB(b, h) + boff + n * 2048 + k * 1024); } while (0)
#define PG8_MMA(ai, bj, At, Bt) do { __builtin_amdgcn_s_setprio(1); _Pragma("unroll") for (int m = 0; m < 4; ++m) _Pragma("unroll") for (int n = 0; n < 2; ++n) _Pragma("unroll") for (int k = 0; k < 2; ++k) \
        acc[ai][bj][m][n] = __builtin_amdgcn_mfma_f32_16x16x32_bf16(Bt[n][k], At[m][k], acc[ai][bj][m][n], 0, 0, 0); __builtin_amdgcn_s_setprio(0); } while (0)
#define PG8_WAIT_V(n) asm volatile("s_waitcnt vmcnt(" #n ")" ::: "memory")
#define PG8_WAIT_L(n) asm volatile("s_waitcnt lgkmcnt(" #n ")" ::: "memory")
#define PG8_BAR __builtin_amdgcn_s_barrier()
#define PG8_SCHED __builtin_amdgcn_sched_barrier(0)
    Unit cur, nxt; int ui = 0;
    if (!S.next(0, cur)) return;
    f32x4 acc[2][2][4][2];
#pragma unroll
    for (int a = 0; a < 2; ++a)
#pragma unroll
        for (int b = 0; b < 2; ++b)
#pragma unroll
            for (int m = 0; m < 4; ++m)
#pragma unroll
                for (int n = 0; n < 2; ++n) acc[a][b][m][n] = (f32x4){0.f, 0.f, 0.f, 0.f};
    bf16x8 At[4][2], B0[2][2], B1[2][2];
    const char* cA = (const char*)g.A + (size_t)cur.pm * tstep; const char* cB = (const char*)g.Bt + (size_t)cur.pn * tstep;
    S.a_ready(cur);
    if constexpr (SP2) {
        PG8_STAGE(PG8_SB(0, 0), cB, voffB); PG8_STAGE(PG8_SB(0, 1), cB + hstep, voffB); PG8_STAGE(PG8_SA(0, 0), cA, voffA); PG8_STAGE(PG8_SA(0, 1), cA + hstep, voffA);
        if (wr == 1) PG8_BAR;
        PG8_WAIT_V(2); PG8_BAR;
        PG8_STAGE(PG8_SB(1, 0), cB + kstep, voffB); PG8_STAGE(PG8_SA(1, 0), cA + kstep, voffA); PG8_STAGE(PG8_SB(1, 1), cB + hstep + kstep, voffB);
        PG8_WAIT_V(6); PG8_BAR;
    } else {
        PG8_STAGE(PG8_SB(0, 0), cB, voffB); PG8_STAGE(PG8_SA(0, 0), cA, voffA); PG8_STAGE(PG8_SB(0, 1), cB + hstep, voffB); PG8_STAGE(PG8_SA(0, 1), cA + hstep, voffA);
        if (wr == 1) PG8_BAR;
        PG8_WAIT_V(4); PG8_BAR;
        PG8_STAGE(PG8_SB(1, 0), cB + kstep, voffB); PG8_STAGE(PG8_SA(1, 0), cA + kstep, voffA); PG8_STAGE(PG8_SB(1, 1), cB + hstep + kstep, voffB);
        PG8_WAIT_V(6); PG8_BAR;
    }
    for (;;) {
        const bool has_next = S.next(ui + 1, nxt);
        const char* nA = has_next ? (const char*)g.A + (size_t)nxt.pm * tstep : cA; const char* nB = has_next ? (const char*)g.Bt + (size_t)nxt.pn * tstep : cB;
        for (int t = 0; t < nt; t += 2) {
            const bool last = (t == nt - 2);
            const char* a1 = cA + (size_t)(t + 1) * kstep;
            const char* a2 = last ? nA : cA + (size_t)(t + 2) * kstep; const char* b2 = last ? nB : cB + (size_t)(t + 2) * kstep;
            const char* a3 = a2 + kstep; const char* b3 = b2 + kstep;
            if (last && has_next) S.a_ready(nxt);
            if constexpr (SP2) {
            PG8_LDB(B0, 0, 0); PG8_LDB(B1, 0, 1); PG8_SCHED; PG8_LDA(At, 0, 0); PG8_STAGE(PG8_SA(1, 1), a1 + hstep, voffA);
            PG8_WAIT_V(8); PG8_WAIT_L(0); PG8_BAR; PG8_MMA(0, 0, At, B0); PG8_MMA(0, 1, At, B1); PG8_BAR; PG8_SCHED;
            PG8_LDA(At, 0, 1); PG8_STAGE(PG8_SB(0, 0), b2, voffB); PG8_STAGE(PG8_SB(0, 1), b2 + hstep, voffB); PG8_STAGE(PG8_SA(0, 0), a2, voffA);
            PG8_WAIT_V(8); PG8_WAIT_L(0); PG8_BAR; PG8_MMA(1, 0, At, B0); PG8_MMA(1, 1, At, B1); PG8_BAR; PG8_SCHED;
            PG8_LDB(B0, 1, 0); PG8_LDB(B1, 1, 1); PG8_SCHED; PG8_LDA(At, 1, 0); PG8_STAGE(PG8_SA(0, 1), a2 + hstep, voffA);
            PG8_WAIT_V(8); PG8_WAIT_L(0); PG8_BAR; PG8_MMA(0, 0, At, B0); PG8_MMA(0, 1, At, B1); PG8_BAR; PG8_SCHED;
            PG8_LDA(At, 1, 1); PG8_STAGE(PG8_SB(1, 0), b3, voffB); PG8_STAGE(PG8_SB(1, 1), b3 + hstep, voffB); PG8_STAGE(PG8_SA(1, 0), a3, voffA);
            PG8_WAIT_V(8); PG8_WAIT_L(0); PG8_BAR; PG8_MMA(1, 0, At, B0); PG8_MMA(1, 1, At, B1); PG8_BAR; PG8_SCHED;
            } else {
            PG8_LDB(B0, 0, 0); PG8_SCHED; PG8_LDA(At, 0, 0); PG8_STAGE(PG8_SA(1, 1), a1 + hstep, voffA);
            PG8_WAIT_L(8); PG8_BAR; PG8_WAIT_L(0); PG8_MMA(0, 0, At, B0); PG8_BAR; PG8_SCHED;
            PG8_LDB(B1, 0, 1); PG8_STAGE(PG8_SB(0, 0), b2, voffB);
            PG8_BAR; PG8_WAIT_L(0); PG8_MMA(0, 1, At, B1); PG8_BAR;
            PG8_LDA(At, 0, 1); PG8_STAGE(PG8_SA(0, 0), a2, voffA);
            PG8_BAR; PG8_WAIT_L(0); PG8_MMA(1, 0, At, B0); PG8_BAR; PG8_SCHED;
            PG8_STAGE(PG8_SB(0, 1), b2 + hstep, voffB);
            PG8_WAIT_V(6); PG8_BAR; PG8_MMA(1, 1, At, B1); PG8_BAR;
            PG8_LDB(B0, 1, 0); PG8_SCHED; PG8_LDA(At, 1, 0); PG8_STAGE(PG8_SA(0, 1), a2 + hstep, voffA);
            PG8_WAIT_L(8); PG8_BAR; PG8_WAIT_L(0); PG8_MMA(0, 0, At, B0); PG8_BAR; PG8_SCHED;
            PG8_LDB(B1, 1, 1); PG8_STAGE(PG8_SB(1, 0), b3, voffB);
            PG8_BAR; PG8_WAIT_L(0); PG8_MMA(0, 1, At, B1); PG8_BAR;
            PG8_LDA(At, 1, 1); PG8_STAGE(PG8_SA(1, 0), a3, voffA);
            PG8_BAR; PG8_WAIT_L(0); PG8_MMA(1, 0, At, B0); PG8_BAR; PG8_SCHED;
            PG8_STAGE(PG8_SB(1, 1), b3 + hstep, voffB);
            PG8_WAIT_V(6); PG8_BAR; PG8_MMA(1, 1, At, B1); PG8_BAR;
            }
        }
        if constexpr (ALIGN_EPI) { if (wr == 0) PG8_BAR; }
        if constexpr (!Epi::AFTER_DRAIN) { E(acc, cur, wr, wc, fr, fq); S.done(cur); }
        if (!has_next) break;
#pragma unroll
        for (int a = 0; a < 2; ++a)
#pragma unroll
            for (int b = 0; b < 2; ++b)
#pragma unroll
                for (int m = 0; m < 4; ++m)
#pragma unroll
                    for (int n = 0; n < 2; ++n) acc[a][b][m][n] = (f32x4){0.f, 0.f, 0.f, 0.f};
        cur = nxt; cA = nA; cB = nB; ++ui;
        if constexpr (ALIGN_EPI) { if (wr == 1) PG8_BAR; }
    }
    PG8_WAIT_V(0);
    if constexpr (!ALIGN_EPI) { if (wr == 0) PG8_BAR; }
    PG8_BAR;
    if constexpr (Epi::AFTER_DRAIN) { E.fused(acc, cur, wr, wc, fr, fq, lds, wid, lane); S.done(cur); }
#undef PG8_SA
#undef PG8_SB
#undef PG8_STAGE
#undef PG8_LDA
#undef PG8_LDB
#undef PG8_MMA
#undef PG8_WAIT_V
#undef PG8_WAIT_L
#undef PG8_BAR
#undef PG8_SCHED
}
}
#ifndef PG8_SP2
#define PG8_SP2 true
#endif
#ifndef PG8_ALIGN
#define PG8_ALIGN true
#endif

constexpr int NWAVES = 8;
#ifndef MK_N_LAUNCHES
#define MK_N_LAUNCHES 1
#endif
constexpr int NPHASE = 9;
constexpr int N_LAUNCHES = MK_N_LAUNCHES;

constexpr int NB = 4, SEQ = 4096, M = NB * SEQ, D = 4096;
constexpr int D_SSD = 4096, D_CONV = 4096, D_MIX = 8192, NH = 64, HD = 64, NG = 8, NS = 128, D_XBC = 6144;
constexpr int NPROJ = 22592, NP = 22784, PP = NP - 4096;
constexpr int O_Z = 0, O_X = 4096, O_B = 8192, O_C = 9216, O_CH = 10240, O_U = 10240, R_SCB = 18432, R_DT = 22528, O_SCB = R_SCB - 4096, O_DT = R_DT - 4096, CH_TILE0 = O_CH / 256, CH_TILES = 32;
constexpr int SRC_DT = 10240, SRC_SCB = 10304, SRC_SCC = 14400, SRC_SCH = 18496;
__host__ __device__ constexpr int win_row_of_src_col(int n) {
    return n < SRC_DT ? n : n < SRC_SCB ? R_DT + (n - SRC_DT) : n < SRC_SCC ? R_SCB + (n - SRC_SCB)
         : n < SRC_SCH ? O_CH + ((n - SRC_SCC) >> 7) * 256 + ((n - SRC_SCC) & 127) : O_CH + ((n - SRC_SCH) >> 7) * 256 + 128 + ((n - SRC_SCH) & 127); }
constexpr int PH = 8, PK = 128, PTOP = 16, PQ = 2048, NEXP = 16384, HK = 128;
constexpr float EPS = 1e-6f;

constexpr size_t MiB = 1u << 20;
constexpr size_t WS_CTL = 0, CTL_ZERO_BYTES = 1 * MiB;
constexpr size_t WS_XN = 1 * MiB;
constexpr size_t WS_WIN = 129 * MiB;
constexpr size_t WS_WOUT = 307 * MiB;
constexpr size_t WS_WQ = 371 * MiB;
constexpr size_t WS_CONV = 1 * MiB;
constexpr size_t WS_Y = 387 * MiB;
constexpr size_t WS_PROJ = 643 * MiB;
constexpr size_t WS_U8 = 1227 * MiB;
constexpr size_t WS_V8 = 1291 * MiB;
constexpr size_t WS_SU = 1376 * MiB, WS_SV = 1376 * MiB + 65536;
constexpr size_t WS_XQ = 772 * MiB, WS_XS = 836 * MiB;
constexpr size_t WS_Q = 899 * MiB;
constexpr size_t WS_HB = 1027 * MiB;
constexpr size_t WS_SSQ = 1355 * MiB;
constexpr size_t WS_KH = 1359 * MiB;
constexpr size_t WS_IDX = 1360 * MiB;
constexpr size_t WS_GATE = 1368 * MiB;
constexpr size_t WS_END = 1377 * MiB;
static_assert(WS_WIN + (size_t)NP * D * 2 <= WS_WOUT && WS_Y + (size_t)M * D_MIX * 2 <= WS_PROJ && WS_PROJ + (size_t)M * PP * 2 <= WS_U8 && WS_V8 + (size_t)NEXP * D <= WS_SSQ && WS_Q + (size_t)M * PQ * 4 <= WS_SSQ, "d_ws map");
constexpr int CW_TMO = 0, CW_CODE = 1, CW_TICKET = 64;
constexpr int CW_BAR = 4096;

constexpr int RING_OFF = 0, RING_BYTES = 131072;
constexpr int LDSCTL_OFF = RING_BYTES, MISC_OFF = LDSCTL_OFF + 320;
constexpr int LDS_BYTES = 147456;
static_assert(MISC_OFF + 128 <= LDS_BYTES, "LDS map");

#define GAS __attribute__((address_space(1)))
#define LAS __attribute__((address_space(3)))
typedef unsigned short bf16;
typedef unsigned v4u __attribute__((ext_vector_type(4)));
typedef float f32x4 __attribute__((ext_vector_type(4)));
typedef short bf16x8 __attribute__((ext_vector_type(8)));
typedef GAS unsigned gu32;
typedef GAS unsigned long long gu64;
#define RLX_AGENT __ATOMIC_RELAXED, __HIP_MEMORY_SCOPE_AGENT
#define LDS_WAIT() asm volatile("s_waitcnt lgkmcnt(0)" ::: "memory")
#define VM_WAIT() asm volatile("s_waitcnt vmcnt(0)" ::: "memory")
__device__ __forceinline__ unsigned long long rt() { return __builtin_amdgcn_s_memrealtime(); }
__device__ __forceinline__ unsigned f2bf(float f) { unsigned u = __builtin_bit_cast(unsigned, f); return (u + 0x7fffu + ((u >> 16) & 1u)) >> 16; }
__device__ __forceinline__ unsigned pk2(float lo, float hi) { return f2bf(lo) | (f2bf(hi) << 16); }


#define XB_TMO      128
#define XB_XCNT(j)  (256  + 64 * (j))
#define XB_XSUB(j)  (1280 + 64 * (j))
#define XB_XGEN(j)  (2304 + 64 * (j))
#define XB_TOP      3328
#define XB_TOPGEN   3392
#define XCD_BAR_WORDS 3456
#define XB_SPIN_CAP (1u << 18)

__device__ __forceinline__ unsigned xb_ld(unsigned* p)              { return __hip_atomic_load(p, __ATOMIC_RELAXED, __HIP_MEMORY_SCOPE_AGENT); }
__device__ __forceinline__ unsigned xb_add(unsigned* p, unsigned v) { return __hip_atomic_fetch_add(p, v, __ATOMIC_RELAXED, __HIP_MEMORY_SCOPE_AGENT); }
__device__ __forceinline__ unsigned xb_xcc_id() { return (unsigned)__builtin_amdgcn_s_getreg((3 << 11) | 20) & 0xFu; }
#define XB_SPIN(cond, bar) do { unsigned _sp = 0; while (cond) { __builtin_amdgcn_s_sleep(1); \
    if ((++_sp & 255u) == 0u) { if (xb_ld(&(bar)[XB_TMO])) break; if (_sp > XB_SPIN_CAP) { atomicAdd(&(bar)[XB_TMO], 1u); break; } } } } while (0)

struct XcdBarrier {
    unsigned* bar; unsigned x;
    volatile LAS unsigned* st;
};

__device__ __forceinline__ XcdBarrier xcd_barrier_post(unsigned* bar, volatile LAS unsigned* st) {
    XcdBarrier b; b.bar = bar; b.x = xb_xcc_id(); b.st = st;
    if (threadIdx.x == 0) (void)xb_add(&bar[XB_XCNT(b.x)], 1u);
    return b;
}
__device__ __forceinline__ void xcd_barrier_complete(unsigned* bar, unsigned x, unsigned& nloc, unsigned& nx) {
    const unsigned G = gridDim.x * gridDim.y * gridDim.z;
    unsigned sum, cnt, mine, sp = 0u;
    for (;;) {
        sum = 0u; cnt = 0u; mine = 0u;
#pragma unroll
        for (unsigned j = 0; j < 16; ++j) { const unsigned c = xb_ld(&bar[XB_XCNT(j)]); sum += c; cnt += (c > 0u) ? 1u : 0u; mine = (j == x) ? c : mine; }
        if (sum == G) break;
        __builtin_amdgcn_s_sleep(1);
        if ((++sp & 255u) == 0u) { if (xb_ld(&bar[XB_TMO])) break; if (sp > XB_SPIN_CAP) { atomicAdd(&bar[XB_TMO], 1u); break; } }
    }
    nloc = mine > 0u ? mine : 1u; nx = cnt > 0u ? cnt : 1u;
}

__device__ __forceinline__ void xcd_barrier(const XcdBarrier& b) {
    asm volatile("s_waitcnt vmcnt(0)" ::: "memory");
    __syncthreads();
    if (threadIdx.x == 0) {
        unsigned* bar = b.bar;
        __builtin_amdgcn_s_waitcnt(0);
        unsigned nloc = b.st[0], nx = b.st[1];
        if (nloc == 0u) { xcd_barrier_complete(bar, b.x, nloc, nx); b.st[0] = nloc; b.st[1] = nx; }
        const unsigned old = xb_add(&bar[XB_XSUB(b.x)], 1u);
        const unsigned gen = old / nloc;
        if (old + 1u == (gen + 1u) * nloc) {
            __builtin_amdgcn_fence(__ATOMIC_RELEASE, "agent");
            asm volatile("s_waitcnt vmcnt(0)" ::: "memory");
            const unsigned og = xb_add(&bar[XB_TOP], 1u);
            const unsigned tg = og / nx;
            if (og + 1u == (tg + 1u) * nx) xb_add(&bar[XB_TOPGEN], 1u);
            else XB_SPIN(xb_ld(&bar[XB_TOPGEN]) == tg, bar);
            __builtin_amdgcn_fence(__ATOMIC_ACQUIRE, "agent");
            xb_add(&bar[XB_XGEN(b.x)], 1u);
            asm volatile("s_waitcnt vmcnt(0)" ::: "memory");
        } else {
            XB_SPIN(xb_ld(&bar[XB_XGEN(b.x)]) == gen, bar);
            __builtin_amdgcn_fence(__ATOMIC_ACQUIRE, "agent");
            asm volatile("s_waitcnt vmcnt(0)" ::: "memory");
        }
    }
    __syncthreads();
}


#ifndef PROBE_REP
#define PROBE_REP 0
#endif
#define NREP(k) (1 + (((PROBE_REP) >> (k)) & 1))
typedef unsigned u32x4 __attribute__((ext_vector_type(4)));
typedef unsigned u32x2 __attribute__((ext_vector_type(2)));
typedef float f32x2 __attribute__((ext_vector_type(2)));
typedef __bf16 bf2_t __attribute__((ext_vector_type(2)));

__device__ __forceinline__ float wave_sum(float v) {
#pragma unroll
    for (int o = 1; o < 64; o <<= 1) v += __shfl_xor(v, o);
    return v;
}
__device__ __forceinline__ unsigned cvtpk(float lo, float hi) { unsigned r; asm volatile("v_cvt_pk_bf16_f32 %0, %1, %2" : "=v"(r) : "v"(lo), "v"(hi)); return r; }
__device__ __forceinline__ float bflo(unsigned w) { return __uint_as_float(w << 16); }
__device__ __forceinline__ float bfhi(unsigned w) { return __uint_as_float(w & 0xffff0000u); }
__device__ __forceinline__ float siluf(float x) { return x * __builtin_amdgcn_rcpf(1.0f + __expf(-x)); }
__device__ __forceinline__ float dot2bf(unsigned a, unsigned b, float c) { return __builtin_amdgcn_fdot2_f32_bf16(__builtin_bit_cast(bf2_t, a), __builtin_bit_cast(bf2_t, b), c, false); }

__device__ __forceinline__ void p0_transpose_item(const float* W, int K, int N, bf16* WT, bool remap, const float* kgain, LAS float* scr, int item, int lane) {
    const int nblk = N / 32, kb = item / nblk, nb = item % nblk, k0 = 64 * kb, n0 = 32 * nb, d0 = remap ? win_row_of_src_col(n0) : n0;
#pragma unroll 8
    for (int i = 0; i < 32; ++i) { const int kk = 2 * i + (lane >> 5); scr[kk * 33 + (lane & 31)] = __builtin_nontemporal_load((const GAS float*)W + ((size_t)(k0 + kk) * N + n0 + (lane & 31))) * (kgain ? kgain[k0 + kk] : 1.0f); }
    LDS_WAIT(); asm volatile("" ::: "memory");
    const int c = lane & 7;
#pragma unroll
    for (int j = 0; j < 4; ++j) { const int n = (lane >> 3) + 8 * j; const LAS float* s = scr + (8 * c) * 33 + n;
        v4u o; o.x = pk2(s[0 * 33], s[1 * 33]); o.y = pk2(s[2 * 33], s[3 * 33]); o.z = pk2(s[4 * 33], s[5 * 33]); o.w = pk2(s[6 * 33], s[7 * 33]);
        *(GAS v4u*)(WT + (size_t)(d0 + n) * K + k0 + 8 * c) = o; }
    LDS_WAIT(); asm volatile("" ::: "memory");
}
__device__ __forceinline__ void rms_row_to_bf16(const float* xrow, const float* w, bf16* orow, int lane) {
    const GAS f32x4* xr = (const GAS f32x4*)xrow + lane;
    f32x4 v[16]; float s = 0.f;
#pragma unroll
    for (int j = 0; j < 16; ++j) { v[j] = __builtin_nontemporal_load(xr + 64 * j); s += (v[j].x * v[j].x + v[j].y * v[j].y) + (v[j].z * v[j].z + v[j].w * v[j].w); }
    const float rs = 1.0f / sqrtf(wave_sum(s) * (1.f / D) + EPS);
    const GAS f32x4* wr = (const GAS f32x4*)w + lane;
    GAS u32x2* o8 = (GAS u32x2*)orow + lane;
#pragma unroll
    for (int j = 0; j < 16; ++j) { const f32x4 g = wr[64 * j]; u32x2 o; o.x = cvtpk(v[j].x * rs * g.x, v[j].y * rs * g.y); o.y = cvtpk(v[j].z * rs * g.z, v[j].w * rs * g.w); o8[64 * j] = o; }
}

__device__ __forceinline__ void unpack8(const u32x4 v, float (&f)[8]) { f[0] = bflo(v.x); f[1] = bfhi(v.x); f[2] = bflo(v.y); f[3] = bfhi(v.y); f[4] = bflo(v.z); f[5] = bfhi(v.z); f[6] = bflo(v.w); f[7] = bfhi(v.w); }
__device__ __forceinline__ unsigned pack_i8x4(float a, float b, float c, float d) {
    const int ia = __float2int_rn(a), ib = __float2int_rn(b), ic = __float2int_rn(c), id = __float2int_rn(d);
    return ((unsigned)ia & 0xffu) | (((unsigned)ib & 0xffu) << 8) | (((unsigned)ic & 0xffu) << 16) | ((unsigned)id << 24);
}
__device__ __forceinline__ void rms_row_to_bf16_i8(const bf16* hrow, const float* w, float* rsout, unsigned char* qrow, float* qscale, int lane) {
    const GAS u32x4* hr = (const GAS u32x4*)hrow + lane;
    float v[8][8]; float s = 0.f;
#pragma unroll
    for (int j = 0; j < 8; ++j) { const u32x4 t = hr[64 * j]; v[j][0] = bflo(t.x); v[j][1] = bfhi(t.x); v[j][2] = bflo(t.y); v[j][3] = bfhi(t.y); v[j][4] = bflo(t.z); v[j][5] = bfhi(t.z); v[j][6] = bflo(t.w); v[j][7] = bfhi(t.w);
#pragma unroll
        for (int k = 0; k < 8; ++k) s += v[j][k] * v[j][k]; }
    const float rs = 1.0f / sqrtf(wave_sum(s) * (1.f / D) + EPS);
    float am = 0.f; if (lane == 0) *rsout = rs;
#pragma unroll
    for (int j = 0; j < 8; ++j) { const GAS f32x4* wp = (const GAS f32x4*)(w + (j * 64 + lane) * 8); const f32x4 ga = wp[0], gb = wp[1]; const float g[8] = {ga.x, ga.y, ga.z, ga.w, gb.x, gb.y, gb.z, gb.w};
#pragma unroll
        for (int k = 0; k < 8; ++k) { v[j][k] *= rs * g[k]; am = fmaxf(am, fabsf(v[j][k])); }
        }
#pragma unroll
    for (int o = 1; o < 64; o <<= 1) am = fmaxf(am, __shfl_xor(am, o));
    const float sc = am > 0.f ? am * (1.0f / 127.0f) : 1.0f, inv = 1.0f / sc;
    GAS u32x2* q8 = (GAS u32x2*)qrow + lane;
#pragma unroll
    for (int j = 0; j < 8; ++j) { u32x2 p; p.x = pack_i8x4(v[j][0] * inv, v[j][1] * inv, v[j][2] * inv, v[j][3] * inv); p.y = pack_i8x4(v[j][4] * inv, v[j][5] * inv, v[j][6] * inv, v[j][7] * inv); q8[64 * j] = p; }
    if (lane == 0) *qscale = sc;
}

__device__ __forceinline__ u32x4 pack8(const float (&f)[8]) { u32x4 o; o.x = cvtpk(f[0], f[1]); o.y = cvtpk(f[2], f[3]); o.z = cvtpk(f[4], f[5]); o.w = cvtpk(f[6], f[7]); return o; }
__device__ __forceinline__ void conv_prepass(const bf16* PROJ, const float* conv_w, const float* conv_b, bf16* CONV, int gtid, int gthreads) {
    constexpr int NCG = D_XBC / 8, NSEG = SEQ / 16, NIT = NB * NSEG * NCG;
    int it = gtid; if (it >= NIT) return;
#define CP_ITEM(IT, CG, ROW, Z) do { const int _bs = (IT) / NCG; CG = (IT) % NCG; const int _seg = _bs % NSEG, _b = _bs / NSEG; Z = (_seg == 0); ROW = _b * SEQ + _seg * 16; } while (0)
#define CP_SRC(ROW, CG) (PROJ + (size_t)(ROW) * PP + O_X + (CG) * 8)
    int cg, row; bool z0; CP_ITEM(it, cg, row, z0); const bf16* src = CP_SRC(row, cg);
    u32x4 raw[19];
#pragma unroll
    for (int rr = 0; rr < 19; ++rr) raw[rr] = __builtin_nontemporal_load((const GAS u32x4*)(src + (ptrdiff_t)((rr >= 3 || !z0) ? rr - 3 : 0) * PP));
    for (;;) {
        const int itn = it + gthreads; const bool has_next = itn < NIT;
        int cgn = cg, rown = row; bool zn = z0; if (has_next) CP_ITEM(itn, cgn, rown, zn); const bf16* srcn = CP_SRC(rown, cgn);
        const int ch = cg * 8;
        float w[4][8], bias[8];
#pragma unroll
        for (int k = 0; k < 4; ++k) { const f32x4 wa = *(const GAS f32x4*)(conv_w + (size_t)k * D_XBC + ch), wb = *(const GAS f32x4*)(conv_w + (size_t)k * D_XBC + ch + 4);
            w[k][0] = wa.x; w[k][1] = wa.y; w[k][2] = wa.z; w[k][3] = wa.w; w[k][4] = wb.x; w[k][5] = wb.y; w[k][6] = wb.z; w[k][7] = wb.w; }
        { const f32x4 ba = *(const GAS f32x4*)(conv_b + ch), bb = *(const GAS f32x4*)(conv_b + ch + 4); bias[0] = ba.x; bias[1] = ba.y; bias[2] = ba.z; bias[3] = ba.w; bias[4] = bb.x; bias[5] = bb.y; bias[6] = bb.z; bias[7] = bb.w; }
        float win[3][8];
#pragma unroll
        for (int rr = 0; rr < 3; ++rr) { const u32x4 v = z0 ? (u32x4){0u, 0u, 0u, 0u} : raw[rr]; unpack8(v, win[rr]);
            if (has_next) raw[rr] = __builtin_nontemporal_load((const GAS u32x4*)(srcn + (ptrdiff_t)(zn ? 0 : rr - 3) * PP)); }
        bf16* dst = CONV + (size_t)row * D_XBC + ch;
#pragma unroll
        for (int i = 0; i < 16; ++i) { float cur[8], o[8]; unpack8(raw[3 + i], cur);
            if (has_next) raw[3 + i] = __builtin_nontemporal_load((const GAS u32x4*)(srcn + (ptrdiff_t)i * PP));
#pragma unroll
            for (int j = 0; j < 8; ++j) { o[j] = siluf(bias[j] + w[0][j] * win[0][j] + w[1][j] * win[1][j] + w[2][j] * win[2][j] + w[3][j] * cur[j]); win[0][j] = win[1][j]; win[1][j] = win[2][j]; win[2][j] = cur[j]; }
            *(GAS u32x4*)(dst + (size_t)i * D_XBC) = pack8(o); }
        if (!has_next) break;
        it = itn; cg = cgn; row = rown; src = srcn; z0 = zn;
    }
#undef CP_ITEM
#undef CP_SRC
}
constexpr int C_CM = 0, C_BM = 32768, C_BTW = 65536, C_XDT = 98304, C_XB = 114688, C_SM = LDSCTL_OFF + 512;
static_assert(C_XB + 16384 <= RING_BYTES && C_SM + 2 * 2048 + 2048 <= LDS_BYTES, "ssd lds");
__device__ __forceinline__ int sw256(int r, int c) { return r * 256 + ((c ^ (r & 15)) << 4); }
__device__ __forceinline__ int sw128(int r, int c) { return r * 128 + ((c ^ (r & 7)) << 4); }
__device__ __forceinline__ int swT(int r, int c) { return r * 256 + ((c ^ (((r >> 3) ^ r) & 15)) << 4); }
__device__ __forceinline__ float wave_incl_scan(float x) {
    x += __builtin_bit_cast(float, __builtin_amdgcn_update_dpp(0, __builtin_bit_cast(int, x), 0x111, 0xf, 0xf, true));
    x += __builtin_bit_cast(float, __builtin_amdgcn_update_dpp(0, __builtin_bit_cast(int, x), 0x112, 0xf, 0xf, true));
    x += __builtin_bit_cast(float, __builtin_amdgcn_update_dpp(0, __builtin_bit_cast(int, x), 0x114, 0xf, 0xf, true));
    x += __builtin_bit_cast(float, __builtin_amdgcn_update_dpp(0, __builtin_bit_cast(int, x), 0x118, 0xf, 0xf, true));
    x += __builtin_bit_cast(float, __builtin_amdgcn_update_dpp(0, __builtin_bit_cast(int, x), 0x142, 0xa, 0xf, true));
    x += __builtin_bit_cast(float, __builtin_amdgcn_update_dpp(0, __builtin_bit_cast(int, x), 0x143, 0xc, 0xf, true));
    return x;
}
__device__ __forceinline__ void ssd_dt_scan(LAS float* sm, float r0, float r1, float a_neg, int lane) {
    const float d0 = r0 > 20.f ? r0 : __logf(1.0f + __expf(r0)), d1 = r1 > 20.f ? r1 : __logf(1.0f + __expf(r1));
    const float v0 = wave_incl_scan(d0 * a_neg); float v1 = wave_incl_scan(d1 * a_neg);
    v1 += __shfl(v0, 63);
    const float aend = __shfl(v1, 63);
    sm[lane] = d0; sm[64 + lane] = d1; sm[128 + lane] = v0; sm[192 + lane] = v1;
    sm[256 + lane] = __expf(aend - v0); sm[320 + lane] = __expf(aend - v1); sm[384 + lane] = __expf(v0); sm[448 + lane] = __expf(v1);
}
__device__ __forceinline__ void ssd_unit(LAS unsigned char* lds, int b, int h, const bf16* PROJ, const bf16* CONV, const float* dt_bias, const float* a_log, const float* ssd_d,
                                         bf16* Y, float* SSQ, int tid, int wave, int lane) {
    LAS float* smb = (LAS float*)(lds + C_SM); LAS float* ssqp = smb + 1024;
    const int g = h >> 3, pb = wave & 3, th = wave >> 2;
    const float a_neg = -__expf(a_log[h]), dtb = dt_bias[h], Dh = ssd_d[h];
    const size_t rowbase = (size_t)b * SEQ;
    const GAS unsigned char* convb = (const GAS unsigned char*)CONV; const GAS unsigned char* projb = (const GAS unsigned char*)PROJ; GAS unsigned char* yb = (GAS unsigned char*)Y; GAS unsigned char* ssqb = (GAS unsigned char*)SSQ;
#define SSD_ROLES(TT, LL) \
    const bool xitem = (TT) < 128, bitem = (TT) >= 128 && (TT) < 384; \
    const int icg = xitem ? ((TT) & 7) : (((TT) - 128) & 15), its = xitem ? ((TT) >> 3) : (((TT) - 128) >> 4); \
    const unsigned toff = (unsigned)(((rowbase + its * 8) * D_XBC + (xitem ? h * 64 + icg * 8 : D_SSD + g * 128 + icg * 8)) * 2); \
    const unsigned coff = (unsigned)(((rowbase + ((TT) >> 4)) * D_XBC + D_SSD + NG * NS + g * 128 + ((TT) & 15) * 8) * 2); \
    const unsigned doff = (unsigned)(((rowbase + (LL)) * PP + O_DT + h) * 2); \
    const int r = (LL) & 15, q = (LL) >> 4;
    f32x4 ST[8];
#pragma unroll
    for (int i = 0; i < 8; ++i) ST[i] = (f32x4){0.f, 0.f, 0.f, 0.f};
    u32x4 pft[8], pfc[4]; float dr0 = 0.f, dr1 = 0.f;
#define SSD_LBAR() do { asm volatile("s_waitcnt lgkmcnt(0)" ::: "memory"); __builtin_amdgcn_s_barrier(); asm volatile("" ::: "memory"); } while (0)
#define SSD_PREFETCH(cc) do { const unsigned _ro = (unsigned)(cc) * (128u * D_XBC * 2u); \
        if (xitem || bitem) { _Pragma("unroll") for (int _i = 0; _i < 8; ++_i) pft[_i] = *(const GAS u32x4*)(convb + (toff + _ro + (unsigned)_i * (D_XBC * 2u))); } \
        _Pragma("unroll") for (int _k = 0; _k < 4; ++_k) pfc[_k] = *(const GAS u32x4*)(convb + (coff + _ro + (unsigned)_k * (32u * D_XBC * 2u))); } while (0)
#define SSD_DTLOAD(cc) do { if (wave == 0) { const unsigned _o = doff + (unsigned)(cc) * (128u * PP * 2u); \
        dr0 = __uint_as_float((unsigned)*(const GAS unsigned short*)(projb + _o) << 16) + dtb; dr1 = __uint_as_float((unsigned)*(const GAS unsigned short*)(projb + (_o + 64u * PP * 2u)) << 16) + dtb; } } while (0)
    { SSD_ROLES(tid, lane) SSD_DTLOAD(0); SSD_PREFETCH(0); (void)r; (void)q; }
    if (wave == 0) ssd_dt_scan(smb, dr0, dr1, a_neg, lane);
    for (int c = 0; c < SEQ / 128; ++c) {
        const int t0 = c * 128, cn = c + 1 < SEQ / 128 ? c + 1 : c;
        int tt = tid, ll = lane; asm volatile("" : "+v"(tt), "+v"(ll));
        SSD_ROLES(tt, ll)
        LAS float* dtv = smb + (c & 1) * 512; LAS float* acum = dtv + 128; LAS float* wend = dtv + 256; LAS float* eac = dtv + 384;
        SSD_LBAR();
        if (c > 0 && tt < 128) *(GAS float*)(ssqb + (unsigned)(((rowbase + t0 - 128 + tt) * NH + h) * 4)) = (ssqp[tt] + ssqp[128 + tt]) + (ssqp[256 + tt] + ssqp[384 + tt]);
#pragma unroll
        for (int k = 0; k < 4; ++k) *(LAS u32x4*)(lds + C_CM + sw256((tt >> 4) + 32 * k, tt & 15)) = pfc[k];
        if (xitem || bitem) {
            const LAS float* sc = xitem ? dtv : wend; const f32x4 sa = *(const LAS f32x4*)(sc + its * 8), sb2 = *(const LAS f32x4*)(sc + its * 8 + 4); const float s8[8] = {sa.x, sa.y, sa.z, sa.w, sb2.x, sb2.y, sb2.z, sb2.w};
            float o[8][8];
#pragma unroll
            for (int i = 0; i < 8; ++i) { unpack8(pft[i], o[i]);
                if (xitem) *(LAS u32x4*)(lds + C_XB + sw128(its * 8 + i, icg)) = pft[i]; else *(LAS u32x4*)(lds + C_BM + sw256(its * 8 + i, icg)) = pft[i]; }
#pragma unroll
            for (int j = 0; j < 8; ++j) { const float f[8] = {o[0][j] * s8[0], o[1][j] * s8[1], o[2][j] * s8[2], o[3][j] * s8[3], o[4][j] * s8[4], o[5][j] * s8[5], o[6][j] * s8[6], o[7][j] * s8[7]};
                *(LAS u32x4*)(lds + (xitem ? C_XDT : C_BTW) + swT(icg * 8 + j, its)) = pack8(f); }
        }
        SSD_DTLOAD(cn);
        SSD_LBAR();
        if (wave == 0) ssd_dt_scan(smb + ((c + 1) & 1) * 512, dr0, dr1, a_neg, ll);
        f32x4 cb[8];
        {   bf16x8 cfr[4];
#pragma unroll
            for (int ks = 0; ks < 4; ++ks) cfr[ks] = *(const LAS bf16x8*)(lds + C_CM + sw256(16 * wave + r, 4 * ks + q));
#pragma unroll
            for (int sp = 0; sp < 4; ++sp) { cb[2 * sp] = (f32x4){0.f, 0.f, 0.f, 0.f}; cb[2 * sp + 1] = (f32x4){0.f, 0.f, 0.f, 0.f};
                if (2 * sp <= wave) {
                    bf16x8 a0[4], a1[4];
#pragma unroll
                    for (int ks = 0; ks < 4; ++ks) { a0[ks] = *(const LAS bf16x8*)(lds + C_BM + sw256(32 * sp + r, 4 * ks + q)); a1[ks] = *(const LAS bf16x8*)(lds + C_BM + sw256(32 * sp + 16 + r, 4 * ks + q)); }
                    __builtin_amdgcn_sched_barrier(0);
#pragma unroll
                    for (int ks = 0; ks < 4; ++ks) { cb[2 * sp] = __builtin_amdgcn_mfma_f32_16x16x32_bf16(a0[ks], cfr[ks], cb[2 * sp], 0, 0, 0); cb[2 * sp + 1] = __builtin_amdgcn_mfma_f32_16x16x32_bf16(a1[ks], cfr[ks], cb[2 * sp + 1], 0, 0, 0); }
                    __builtin_amdgcn_sched_barrier(0); } } }
        SSD_LBAR();
        {   const float ac_t = acum[16 * wave + r]; const int row = 16 * wave + r;
#pragma unroll
            for (int sb = 0; sb < 8; ++sb) {
                if (sb <= wave) { const f32x4 as4 = *(const LAS f32x4*)(acum + 16 * sb + 4 * q); float m[4];
#pragma unroll
                    for (int j = 0; j < 4; ++j) { const float e = __expf(fminf(ac_t - as4[j], 0.f)); m[j] = (sb == wave && 4 * q + j > r) ? 0.f : cb[sb][j] * e; }
                    u32x2 pk; pk.x = cvtpk(m[0], m[1]); pk.y = cvtpk(m[2], m[3]);
                    *(LAS u32x2*)(lds + C_BM + row * 256 + (((2 * sb + (q >> 1)) ^ (row & 15)) << 4) + (q & 1) * 8) = pk;
                } else if (sb == wave + 1 && !(wave & 1)) {
                    *(LAS u32x2*)(lds + C_BM + row * 256 + (((2 * sb + (q >> 1)) ^ (row & 15)) << 4) + (q & 1) * 8) = (u32x2){0u, 0u}; } } }
        u32x2 zv[4];
#pragma unroll
        for (int j = 0; j < 4; ++j) zv[j] = *(const GAS u32x2*)(projb + (unsigned)(((rowbase + t0 + 16 * (4 * th + j) + r) * PP + O_Z + h * 64 + 16 * pb + 4 * q) * 2));
        SSD_PREFETCH(cn);
        SSD_LBAR();
        bf16x8 xfr[4], sfr[4];
#pragma unroll
        for (int ks = 0; ks < 4; ++ks) { xfr[ks] = *(const LAS bf16x8*)(lds + C_XDT + swT(16 * pb + r, 4 * ks + q));
            sfr[ks] = __builtin_bit_cast(bf16x8, (u32x4){cvtpk(ST[2 * ks][0], ST[2 * ks][1]), cvtpk(ST[2 * ks][2], ST[2 * ks][3]), cvtpk(ST[2 * ks + 1][0], ST[2 * ks + 1][1]), cvtpk(ST[2 * ks + 1][2], ST[2 * ks + 1][3])}); }
#pragma unroll
        for (int j = 0; j < 4; ++j) {
            const int tb = 4 * th + j, trow = 16 * tb + r; const size_t grow = rowbase + t0 + trow; const int p0 = 16 * pb + 4 * q;
            f32x4 ad = (f32x4){0.f, 0.f, 0.f, 0.f}, ao = (f32x4){0.f, 0.f, 0.f, 0.f};
            bf16x8 mmf[4]; u32x2 clo[4], chi[4];
            {   const int cbase = C_CM + trow * 256 + (q & 1) * 8;
#pragma unroll
                for (int ks = 0; ks < 4; ++ks) { mmf[ks] = *(const LAS bf16x8*)(lds + C_BM + sw256(trow, 4 * ks + q));
                    clo[ks] = *(const LAS u32x2*)(lds + cbase + (((4 * ks + (q >> 1)) ^ (trow & 15)) << 4)); chi[ks] = *(const LAS u32x2*)(lds + cbase + (((4 * ks + 2 + (q >> 1)) ^ (trow & 15)) << 4)); } }
            __builtin_amdgcn_sched_barrier(0);
#pragma unroll
            for (int ks = 0; ks < 4; ++ks) { if (2 * ks <= tb) ad = __builtin_amdgcn_mfma_f32_16x16x32_bf16(xfr[ks], mmf[ks], ad, 0, 0, 0);
                ao = __builtin_amdgcn_mfma_f32_16x16x32_bf16(sfr[ks], __builtin_bit_cast(bf16x8, (u32x4){clo[ks].x, clo[ks].y, chi[ks].x, chi[ks].y}), ao, 0, 0, 0); }
            __builtin_amdgcn_sched_barrier(0);
            const float ea = eac[trow];
            const u32x2 xv = *(const LAS u32x2*)(lds + C_XB + trow * 128 + (((2 * pb + (q >> 1)) ^ (trow & 7)) << 4) + (q & 1) * 8);
            const float xx[4] = {bflo(xv.x), bfhi(xv.x), bflo(xv.y), bfhi(xv.y)}, zz[4] = {bflo(zv[j].x), bfhi(zv[j].x), bflo(zv[j].y), bfhi(zv[j].y)};
            float y[4], sq = 0.f;
#pragma unroll
            for (int k = 0; k < 4; ++k) { y[k] = (ad[k] + ea * ao[k] + Dh * xx[k]) * siluf(zz[k]); sq += y[k] * y[k]; }
            u32x2 ov; ov.x = cvtpk(y[0], y[1]); ov.y = cvtpk(y[2], y[3]);
            *(GAS u32x2*)(yb + (unsigned)((grow * D_MIX + h * 64 + p0) * 2)) = ov;
            sq += __shfl_xor(sq, 16); sq += __shfl_xor(sq, 32);
            if (q == 0) ssqp[pb * 128 + trow] = sq;
            __builtin_amdgcn_sched_barrier(0);
        }
        {   const float dend = __expf(acum[127]);
#pragma unroll
            for (int np = 0; np < 4; ++np) { ST[2 * np] = ST[2 * np] * dend; ST[2 * np + 1] = ST[2 * np + 1] * dend;
                bf16x8 a0[4], a1[4];
#pragma unroll
                for (int ks = 0; ks < 4; ++ks) { a0[ks] = *(const LAS bf16x8*)(lds + C_BTW + swT(32 * np + r, 4 * ks + q)); a1[ks] = *(const LAS bf16x8*)(lds + C_BTW + swT(32 * np + 16 + r, 4 * ks + q)); }
                __builtin_amdgcn_sched_barrier(0);
#pragma unroll
                for (int ks = 0; ks < 4; ++ks) { ST[2 * np] = __builtin_amdgcn_mfma_f32_16x16x32_bf16(a0[ks], xfr[ks], ST[2 * np], 0, 0, 0); ST[2 * np + 1] = __builtin_amdgcn_mfma_f32_16x16x32_bf16(a1[ks], xfr[ks], ST[2 * np + 1], 0, 0, 0); }
                __builtin_amdgcn_sched_barrier(0); } }
    }
#undef SSD_ROLES
#undef SSD_LBAR
#undef SSD_PREFETCH
#undef SSD_DTLOAD
    __syncthreads();
    if (tid < 128) *(GAS float*)(ssqb + (unsigned)(((rowbase + SEQ - 128 + tid) * NH + h) * 4)) = (ssqp[tid] + ssqp[128 + tid]) + (ssqp[256 + tid] + ssqp[384 + tid]);
}

__device__ __forceinline__ void p3_rows2(int row0, const bf16* PROJ, const float* sc_w, const float* sc_nw, const float* ssd_nw, const float* SSQ, bf16* Y, LAS unsigned char* scr, int lane) {
    const int s0 = row0 & (SEQ - 1); const bool halo = s0 >= 2;
    const bf16* pr = PROJ + (size_t)row0 * PP + lane * 8;
    float ss0 = 0.f, ss1 = 0.f;
#pragma unroll 2
    for (int i = 0; i < 8; ++i) {
        const int c0 = (i * 64 + lane) * 8; const bf16* q = pr + i * 512; const bf16* qh = halo ? q : q + 2 * PP;
        const u32x4 um2v = *(const GAS u32x4*)(qh - 2 * PP + O_U), um1v = *(const GAS u32x4*)(qh - PP + O_U), u0v = *(const GAS u32x4*)(q + O_U), u1v = *(const GAS u32x4*)(q + PP + O_U);
        const u32x4 b0v = *(const GAS u32x4*)(q + O_SCB), b1v = *(const GAS u32x4*)(q + PP + O_SCB);
        const f32x4 w0a = *(const GAS f32x4*)(sc_w + c0), w0b = *(const GAS f32x4*)(sc_w + c0 + 4), w1a = *(const GAS f32x4*)(sc_w + D_CONV + c0), w1b = *(const GAS f32x4*)(sc_w + D_CONV + c0 + 4),
                    w2a = *(const GAS f32x4*)(sc_w + 2 * D_CONV + c0), w2b = *(const GAS f32x4*)(sc_w + 2 * D_CONV + c0 + 4);
        const float w0[8] = {w0a.x, w0a.y, w0a.z, w0a.w, w0b.x, w0b.y, w0b.z, w0b.w}, w1[8] = {w1a.x, w1a.y, w1a.z, w1a.w, w1b.x, w1b.y, w1b.z, w1b.w}, w2[8] = {w2a.x, w2a.y, w2a.z, w2a.w, w2b.x, w2b.y, w2b.z, w2b.w};
        float um2[8], um1[8], u0[8], u1[8], b0[8], b1[8];
        unpack8(um2v, um2); unpack8(um1v, um1); unpack8(u0v, u0); unpack8(u1v, u1);
#pragma unroll
        for (int j = 0; j < 8; ++j) { um2[j] = halo ? um2[j] : 0.f; um1[j] = halo ? um1[j] : 0.f; }
        unpack8(b0v, b0); unpack8(b1v, b1);
        float y0[8], y1[8];
#pragma unroll
        for (int j = 0; j < 8; ++j) { y0[j] = b0[j] * (w2[j] * u0[j] + w0[j] * um2[j] + w1[j] * um1[j]); y1[j] = b1[j] * (w2[j] * u1[j] + w0[j] * um1[j] + w1[j] * u0[j]); ss0 += y0[j] * y0[j]; ss1 += y1[j] * y1[j]; }
        *(LAS u32x4*)(scr + c0 * 2) = pack8(y0); *(LAS u32x4*)(scr + 8192 + c0 * 2) = pack8(y1);
    }
    const float rs0 = 1.0f / sqrtf(wave_sum(ss0) * (1.f / D_CONV) + EPS), rs1 = 1.0f / sqrtf(wave_sum(ss1) * (1.f / D_CONV) + EPS);
    bf16* yrow = Y + (size_t)row0 * D_MIX + lane * 8;
#pragma unroll 2
    for (int i = 0; i < 8; ++i) { const int c0 = (i * 64 + lane) * 8;
        float f0[8], f1[8]; unpack8(*(const LAS u32x4*)(scr + c0 * 2), f0); unpack8(*(const LAS u32x4*)(scr + 8192 + c0 * 2), f1);
        const f32x4 ga = *(const GAS f32x4*)(sc_nw + c0), gb = *(const GAS f32x4*)(sc_nw + c0 + 4); const float g[8] = {ga.x, ga.y, ga.z, ga.w, gb.x, gb.y, gb.z, gb.w};
#pragma unroll
        for (int j = 0; j < 8; ++j) { f0[j] *= rs0 * g[j]; f1[j] *= rs1 * g[j]; }
        *(GAS u32x4*)(yrow + D_SSD + i * 512) = pack8(f0); *(GAS u32x4*)(yrow + D_MIX + D_SSD + i * 512) = pack8(f1); }
    float gs0 = SSQ[(size_t)row0 * NH + lane], gs1 = SSQ[(size_t)(row0 + 1) * NH + lane];
    gs0 += __shfl_xor(gs0, 1); gs0 += __shfl_xor(gs0, 2); gs0 += __shfl_xor(gs0, 4); gs1 += __shfl_xor(gs1, 1); gs1 += __shfl_xor(gs1, 2); gs1 += __shfl_xor(gs1, 4);
#pragma unroll 2
    for (int i = 0; i < 8; ++i) { const int c0 = (i * 64 + lane) * 8;
        const float rg0 = 1.0f / sqrtf(__shfl(gs0, i * 8) * (1.f / 512.f) + EPS), rg1 = 1.0f / sqrtf(__shfl(gs1, i * 8) * (1.f / 512.f) + EPS);
        float f0[8], f1[8]; unpack8(*(const GAS u32x4*)(yrow + i * 512), f0); unpack8(*(const GAS u32x4*)(yrow + D_MIX + i * 512), f1);
        const f32x4 ga = *(const GAS f32x4*)(ssd_nw + c0), gb = *(const GAS f32x4*)(ssd_nw + c0 + 4); const float g[8] = {ga.x, ga.y, ga.z, ga.w, gb.x, gb.y, gb.z, gb.w};
#pragma unroll
        for (int j = 0; j < 8; ++j) { f0[j] *= rg0 * g[j]; f1[j] *= rg1 * g[j]; }
        *(GAS u32x4*)(yrow + i * 512) = pack8(f0); *(GAS u32x4*)(yrow + D_MIX + i * 512) = pack8(f1); }
}

constexpr int KROW = 272;
constexpr int RT_KH = 0, RT_KL = 128 * KROW, RT_LST = 2 * 128 * KROW, RT_END = RT_LST + 2 * 128 * 16 * 4;
static_assert(RT_END <= RING_BYTES, "route lds");
__device__ __forceinline__ unsigned ord_enc(float s) { const unsigned b = __float_as_uint(s); return (b & 0x80000000u) ? ~b : (b | 0x80000000u); }
__device__ __forceinline__ float ord_dec(unsigned p) { const unsigned o = p & ~127u; return __uint_as_float((o & 0x80000000u) ? (o & 0x7fffffffu) : ~o); }
__device__ __forceinline__ void cex_desc(unsigned& a, unsigned& b) { const unsigned hi = a > b ? a : b, lo = a > b ? b : a; a = hi; b = lo; }
__device__ __forceinline__ void bitonic_merge16_desc(unsigned (&v)[16]) {
#pragma unroll
    for (int j = 8; j > 0; j >>= 1)
#pragma unroll
        for (int i = 0; i < 16; ++i) if ((i & j) == 0) cex_desc(v[i], v[i | j]);
}
__device__ __forceinline__ void bitonic_sort16_desc(unsigned (&v)[16]) {
#pragma unroll
    for (int k = 2; k <= 16; k <<= 1)
#pragma unroll
        for (int j = k >> 1; j > 0; j >>= 1)
#pragma unroll
            for (int i = 0; i < 16; ++i) if ((i & j) == 0) { if ((i & k) == 0) cex_desc(v[i], v[i | j]); else cex_desc(v[i | j], v[i]); }
}
__device__ __forceinline__ void top16_merge_desc(unsigned (&a)[16], const unsigned (&b)[16]) {
#pragma unroll
    for (int j = 0; j < 16; ++j) a[j] = a[j] > b[15 - j] ? a[j] : b[15 - j];
    bitonic_merge16_desc(a);
}
__device__ __forceinline__ void route_wg(LAS unsigned char* lds, int nun, int pm0, int ph0, int pm1, int ph1, const float* Q, int* IDX, float* GATE, int tid, int wave, int lane) {
    LAS unsigned* lst = (LAS unsigned*)lds;
    const int kq = lane >> 4, lr = lane & 15;
    __syncthreads();
#pragma unroll 1
    for (int ps = 0; ps < 2 * nun; ++ps) { const int un = ps >> 1, pm = un ? pm1 : pm0, h = un ? ph1 : ph0, ltok = ps * 128 + wave * 16 + lr;
        const float* qp = Q + (size_t)(pm * 256 + (ps & 1) * 128 + wave * 16 + lr) * PQ + h * 256 + kq * 4;
        f32x4 sc[2][8];
#pragma unroll
        for (int c = 0; c < 2; ++c)
#pragma unroll
            for (int t = 0; t < 8; ++t) sc[c][t] = *(const GAS f32x4*)(qp + c * 128 + 16 * t);
#pragma unroll
        for (int c = 0; c < 2; ++c) {
            unsigned L[16], Hh[16];
#pragma unroll
            for (int t = 0; t < 4; ++t)
#pragma unroll
                for (int r = 0; r < 4; ++r) { L[4 * t + r] = (ord_enc(sc[c][t][r]) & ~127u) | (unsigned)(127 - (16 * t + 4 * kq + r)); Hh[4 * t + r] = (ord_enc(sc[c][t + 4][r]) & ~127u) | (unsigned)(127 - (16 * (t + 4) + 4 * kq + r)); }
            bitonic_sort16_desc(L); bitonic_sort16_desc(Hh);
            top16_merge_desc(L, Hh);
#pragma unroll
            for (int sh = 16; sh <= 32; sh <<= 1) { unsigned P[16];
#pragma unroll
                for (int j = 0; j < 16; ++j) P[j] = (unsigned)__shfl_xor((int)L[j], sh);
                top16_merge_desc(L, P); }
            if (kq == 0) { LAS u32x4* lp = (LAS u32x4*)(lst + (c * 512 + ltok) * 16);
                lp[0] = (u32x4){L[0], L[1], L[2], L[3]}; lp[1] = (u32x4){L[4], L[5], L[6], L[7]}; lp[2] = (u32x4){L[8], L[9], L[10], L[11]}; lp[3] = (u32x4){L[12], L[13], L[14], L[15]}; }
        }
    }
    __syncthreads();
    if (tid < 256 * nun) { const int un = tid >> 8, h = un ? ph1 : ph0; const size_t gtok = (size_t)((un ? pm1 : pm0) * 256 + (tid & 255));
        const LAS unsigned* l0 = lst + (0 * 512 + tid) * 16; const LAS unsigned* l1 = lst + (1 * 512 + tid) * 16;
        float fr[16]; const float s10 = ord_dec(l1[0]);
#pragma unroll
        for (int a = 0; a < 16; ++a) fr[a] = ord_dec(l0[a]) + s10;
        unsigned long long P = 0ull; float bs[16]; int be[16];
#pragma unroll
        for (int k = 0; k < 16; ++k) {
            float best = fr[0]; int ba = 0;
#pragma unroll
            for (int a = 1; a < 16; ++a) { const bool gt = fr[a] > best; best = gt ? fr[a] : best; ba = gt ? a : ba; }
            const int pb = (int)((P >> (4 * ba)) & 15ull);
            const unsigned p0 = l0[ba], p1 = l1[pb];
            bs[k] = best; be[k] = (127 - (int)(p0 & 127u)) * PK + (127 - (int)(p1 & 127u));
            const int nb2 = pb + 1; float nf = -3.0e38f;
            if (nb2 < 16) { P += 1ull << (4 * ba); nf = ord_dec(p0) + ord_dec(l1[nb2]); }
#pragma unroll
            for (int a = 0; a < 16; ++a) fr[a] = (a == ba) ? nf : fr[a];
        }
        float e[16], sum = 0.f;
#pragma unroll
        for (int k = 0; k < 16; ++k) { e[k] = __expf(bs[k] - bs[0]); sum += e[k]; }
        const float inv = 1.0f / sum;
        int* ip = IDX + gtok * HK + h * 16; float* gp = GATE + gtok * HK + h * 16;
#pragma unroll
        for (int k = 0; k < 16; ++k) { ip[k] = be[k]; gp[k] = e[k] * inv; }
    }
}

__device__ __forceinline__ float gelu_erf(float v) { return 0.5f * v * (1.0f + erff(v * 0.70710678118654752f)); }
constexpr size_t SLICE_BYTES = (size_t)NEXP * 128;
__device__ __forceinline__ void quant_row_fp8(const float* src, unsigned char* dst, float* scale, int lane) {
    const GAS f32x4* xr = (const GAS f32x4*)src + lane;
    f32x4 v[16]; float am = 0.f;
#pragma unroll
    for (int j = 0; j < 16; ++j) { v[j] = __builtin_nontemporal_load(xr + 64 * j); am = fmaxf(am, fmaxf(fmaxf(fabsf(v[j].x), fabsf(v[j].y)), fmaxf(fabsf(v[j].z), fabsf(v[j].w)))); }
#pragma unroll
    for (int o = 1; o < 64; o <<= 1) am = fmaxf(am, __shfl_xor(am, o));
    const float sc = am > 0.f ? am * (1.0f / 224.0f) : 1.0f, inv = 1.0f / sc;
    GAS unsigned char* o1 = (GAS unsigned char*)dst + (size_t)(lane >> 5) * SLICE_BYTES + (lane & 31) * 4;
#pragma unroll
    for (int j = 0; j < 16; ++j) { int p = __builtin_amdgcn_cvt_pk_fp8_f32(v[j].x * inv, v[j].y * inv, 0, false); p = __builtin_amdgcn_cvt_pk_fp8_f32(v[j].z * inv, v[j].w * inv, p, true); *(GAS unsigned*)(o1 + (size_t)(2 * j) * SLICE_BYTES) = (unsigned)p; }
    if (lane == 0) *scale = sc;
}
__device__ __forceinline__ void quant_row_i8(const float* src, unsigned char* dst, float* scale, int lane) {
    const GAS f32x4* xr = (const GAS f32x4*)src + lane;
    f32x4 v[16]; float am = 0.f;
#pragma unroll
    for (int j = 0; j < 16; ++j) { v[j] = __builtin_nontemporal_load(xr + 64 * j); am = fmaxf(am, fmaxf(fmaxf(fabsf(v[j].x), fabsf(v[j].y)), fmaxf(fabsf(v[j].z), fabsf(v[j].w)))); }
#pragma unroll
    for (int o = 1; o < 64; o <<= 1) am = fmaxf(am, __shfl_xor(am, o));
    const float sc = am > 0.f ? am * (1.0f / 127.0f) : 1.0f, inv = 1.0f / sc;
    GAS unsigned char* o1 = (GAS unsigned char*)dst + (size_t)(lane >> 5) * SLICE_BYTES + (lane & 31) * 4;
#pragma unroll
    for (int j = 0; j < 16; ++j) *(GAS unsigned*)(o1 + (size_t)(2 * j) * SLICE_BYTES) = pack_i8x4(v[j].x * inv, v[j].y * inv, v[j].z * inv, v[j].w * inv);
    if (lane == 0) *scale = sc;
}
__device__ __forceinline__ void rs16(const float (&d)[16], int bit, int sh1, int sh2, int sh3, float (&out)[2]) {
    float n8[8], n4[4];
#pragma unroll
    for (int m = 0; m < 8; ++m) { const bool up = (bit & sh1) != 0; const float mine = up ? d[8 + m] : d[m], theirs = up ? d[m] : d[8 + m]; n8[m] = mine + __shfl_xor(theirs, sh1); }
#pragma unroll
    for (int m = 0; m < 4; ++m) { const bool up = (bit & sh2) != 0; const float mine = up ? n8[4 + m] : n8[m], theirs = up ? n8[m] : n8[4 + m]; n4[m] = mine + __shfl_xor(theirs, sh2); }
#pragma unroll
    for (int m = 0; m < 2; ++m) { const bool up = (bit & sh3) != 0; const float mine = up ? n4[2 + m] : n4[m], theirs = up ? n4[m] : n4[2 + m]; out[m] = mine + __shfl_xor(theirs, sh3); }
}
__device__ __forceinline__ void peer_block(LAS unsigned char* wl, int tok0, const unsigned char* XQ, const float* XS, const unsigned char* U8, const unsigned char* V8, const float* SU, const float* SV, const int* IDX, const float* GATE, const bf16* HB, float* HO, bf16* X2, const float* wfin, int lane) {
    const int rg = lane >> 3, c = lane & 7; const unsigned cofs = (unsigned)c * 16u;
    LAS unsigned short* idxL = (LAS unsigned short*)wl; LAS float* actL = (LAS float*)(wl + 2048); LAS float* ssqL = (LAS float*)(wl + 6144);
#pragma unroll
    for (int j = 0; j < 8; ++j) {
#pragma unroll
        for (int hh = 0; hh < 2; ++hh) { const int k = hh * 64 + lane; idxL[(j * 8 + (k & 7)) * 16 + (k >> 3)] = (unsigned short)IDX[(size_t)(tok0 + j) * HK + k]; }
        *(LAS f32x2*)(actL + j * 128 + lane * 2) = (f32x2){0.f, 0.f}; ssqL[j * 64 + lane] = 0.f; }
    LDS_WAIT();
    for (int urep = 0; urep < NREP(8); ++urep) {
    if (urep) { for (int j = 0; j < 8; ++j) *(LAS f32x2*)(actL + j * 128 + lane * 2) = (f32x2){0.f, 0.f}; LDS_WAIT(); }
#define PB_LOAD(buf, tab, it) do { const int _s = (it) >> 3, _j = (it) & 7; const GAS unsigned char* _base = (const GAS unsigned char*)(tab) + (size_t)_s * SLICE_BYTES; \
        const u32x4 _ia = *(const LAS u32x4*)(idxL + (_j * 8 + rg) * 16), _ib = *(const LAS u32x4*)(idxL + (_j * 8 + rg) * 16 + 8); const unsigned _iw[8] = {_ia.x, _ia.y, _ia.z, _ia.w, _ib.x, _ib.y, _ib.z, _ib.w}; \
        _Pragma("unroll") for (int _i = 0; _i < 16; ++_i) { const unsigned _e = (_iw[_i >> 1] >> (16 * (_i & 1))) & 0xffffu; buf[_i] = *(const GAS u32x4*)(_base + (_e * 128u + cofs)); } } while (0)
#define PB_XLOAD(xa, it) do { xa = __builtin_nontemporal_load((const GAS u32x4*)(XQ + (size_t)(tok0 + ((it) & 7)) * D + ((it) >> 3) * 128 + c * 16)); } while (0)
#define PB_UCOMP(buf, xa, it) do { const int _j = (it) & 7; float _d[16]; \
        _Pragma("unroll") for (int _i = 0; _i < 16; ++_i) { int _a = __builtin_amdgcn_sdot4((int)buf[_i].x, (int)xa.x, 0, false); _a = __builtin_amdgcn_sdot4((int)buf[_i].y, (int)xa.y, _a, false); \
            _a = __builtin_amdgcn_sdot4((int)buf[_i].z, (int)xa.z, _a, false); _a = __builtin_amdgcn_sdot4((int)buf[_i].w, (int)xa.w, _a, false); _d[_i] = (float)_a; } \
        float _n2[2]; rs16(_d, c, 4, 2, 1, _n2); \
        LAS f32x2* _pp = (LAS f32x2*)(actL + _j * 128 + lane * 2); f32x2 _p = *_pp; _p.x += _n2[0]; _p.y += _n2[1]; *_pp = _p; } while (0)
    {   u32x4 bufA[16], bufB[16], xaA, xaB;
        PB_XLOAD(xaA, 0); PB_LOAD(bufA, U8, 0);
#pragma unroll 1
        for (int it = 0; it < 256; it += 2) {
            PB_XLOAD(xaB, it + 1); PB_LOAD(bufB, U8, it + 1);
            __builtin_amdgcn_sched_barrier(0);
            PB_UCOMP(bufA, xaA, it);
            __builtin_amdgcn_sched_barrier(0);
            PB_XLOAD(xaA, (it + 2) & 255); PB_LOAD(bufA, U8, (it + 2) & 255);
            __builtin_amdgcn_sched_barrier(0);
            PB_UCOMP(bufB, xaB, it + 1);
            __builtin_amdgcn_sched_barrier(0);
        }
    }
    }
#pragma unroll 1
    for (int j = 0; j < 8; ++j) { const int tok = tok0 + j, k0 = 16 * c + rg, k1 = k0 + 8;
        LAS f32x2* pp = (LAS f32x2*)(actL + j * 128 + lane * 2); const f32x2 p = *pp;
        const unsigned ew = *(const LAS unsigned*)(idxL + (j * 8 + rg) * 16 + 2 * c); const int e0 = (int)(ew & 0xffffu), e1 = (int)(ew >> 16);
        const float g0 = GATE[(size_t)tok * HK + k0], g1 = GATE[(size_t)tok * HK + k1];
        const float xs = XS[tok]; const float a0 = gelu_erf(p.x * xs * SU[e0]) * g0 * SV[e0], a1 = gelu_erf(p.y * xs * SU[e1]) * g1 * SV[e1];
        *pp = (f32x2){a0, a1}; }
    LDS_WAIT();
    for (int vrep = 0; vrep < NREP(9); ++vrep) {
    if (vrep) { for (int j = 0; j < 8; ++j) ssqL[j * 64 + lane] = 0.f; LDS_WAIT(); }
#define PB_HOFF(it) ((size_t)(tok0 + ((it) & 7)) * D + ((it) >> 3) * 128 + 16 * c + 2 * rg)
#define PB_VCOMP(buf, it) do { const int _j = (it) & 7; \
        const LAS f32x4* _ap = (const LAS f32x4*)(actL + (_j * 8 + rg) * 16); const f32x4 _a0 = _ap[0], _a1 = _ap[1], _a2 = _ap[2], _a3 = _ap[3]; \
        const float _av[16] = {_a0.x, _a0.y, _a0.z, _a0.w, _a1.x, _a1.y, _a1.z, _a1.w, _a2.x, _a2.y, _a2.z, _a2.w, _a3.x, _a3.y, _a3.z, _a3.w}; \
        f32x2 _o[8]; _Pragma("unroll") for (int _m = 0; _m < 8; ++_m) _o[_m] = (f32x2){0.f, 0.f}; \
        _Pragma("unroll") for (int _i = 0; _i < 16; ++_i) { const f32x2 _a2v = (f32x2){_av[_i], _av[_i]}; const unsigned _w[4] = {buf[_i].x, buf[_i].y, buf[_i].z, buf[_i].w}; \
            _Pragma("unroll") for (int _q = 0; _q < 4; ++_q) { const f32x2 _lo = __builtin_amdgcn_cvt_pk_f32_fp8((int)_w[_q], false), _hi = __builtin_amdgcn_cvt_pk_f32_fp8((int)_w[_q], true); _o[2 * _q] += _a2v * _lo; _o[2 * _q + 1] += _a2v * _hi; } } \
        const float _ov[16] = {_o[0].x, _o[0].y, _o[1].x, _o[1].y, _o[2].x, _o[2].y, _o[3].x, _o[3].y, _o[4].x, _o[4].y, _o[5].x, _o[5].y, _o[6].x, _o[6].y, _o[7].x, _o[7].y}; \
        float _n2[2]; rs16(_ov, lane, 32, 16, 8, _n2); \
        __builtin_nontemporal_store(cvtpk(_n2[0], _n2[1]), (GAS unsigned*)(X2 + PB_HOFF(it))); } while (0)
    {   u32x4 bufA[16], bufB[16];
        PB_LOAD(bufA, V8, 0);
#pragma unroll 1
        for (int it = 0; it < 256; it += 2) {
            PB_LOAD(bufB, V8, it + 1);
            __builtin_amdgcn_sched_barrier(0);
            PB_VCOMP(bufA, it);
            __builtin_amdgcn_sched_barrier(0);
            if (it + 2 < 256) { PB_LOAD(bufA, V8, it + 2); }
            __builtin_amdgcn_sched_barrier(0);
            PB_VCOMP(bufB, it + 1);
            __builtin_amdgcn_sched_barrier(0);
        }
    }
    }
#undef PB_LOAD
#undef PB_XLOAD
#undef PB_UCOMP
#undef PB_HOFF
#undef PB_VCOMP
    LDS_WAIT();
    asm volatile("s_waitcnt vmcnt(0)" ::: "memory");
#pragma unroll 1
    for (int j = 0; j < 8; ++j) { const size_t ro = (size_t)(tok0 + j) * D;
        const GAS u32x2* sp = (const GAS u32x2*)(X2 + ro) + lane; const GAS u32x2* hp = (const GAS u32x2*)(HB + ro) + lane;
        f32x4 xv[16]; float ss = 0.f;
#pragma unroll
        for (int q = 0; q < 16; ++q) { const u32x2 v = __builtin_nontemporal_load(sp + 64 * q), hv = __builtin_nontemporal_load(hp + 64 * q);
            xv[q] = (f32x4){bflo(v.x) + bflo(hv.x), bfhi(v.x) + bfhi(hv.x), bflo(v.y) + bflo(hv.y), bfhi(v.y) + bfhi(hv.y)}; ss += (xv[q].x * xv[q].x + xv[q].y * xv[q].y) + (xv[q].z * xv[q].z + xv[q].w * xv[q].w); }
        const float rs = 1.0f / sqrtf(wave_sum(ss) * (1.f / D) + EPS);
        GAS f32x4* rp = (GAS f32x4*)(HO + ro) + lane; unsigned gofs = (unsigned)lane * 16u; asm volatile("" : "+v"(gofs));
#pragma unroll
        for (int q = 0; q < 16; ++q) { const f32x4 g = *(const GAS f32x4*)((const GAS unsigned char*)wfin + (gofs + (unsigned)q * 1024u)); rp[64 * q] = (f32x4){xv[q].x * rs * g.x, xv[q].y * rs * g.y, xv[q].z * rs * g.z, xv[q].w * rs * g.w}; } }
}

struct Args { const float* in[18]; float* out; unsigned char* ws; int ph_lo, ph_hi, li, pad; };
__global__ void __launch_bounds__(NWAVES * 64, 2) mk_fwd(Args args) {
    extern __shared__ __attribute__((aligned(16))) unsigned char lds_raw[];
    LAS unsigned char* lds = (LAS unsigned char*)lds_raw;
    volatile LAS unsigned* MISC = (volatile LAS unsigned*)(lds + MISC_OFF);
    const int tid = threadIdx.x, lane = tid & 63, wave = __builtin_amdgcn_readfirstlane(tid >> 6);
    const int G = gridDim.x, bid = blockIdx.x;
    const int vcu = (G % 8 == 0) ? (bid % 8) * (G / 8) + bid / 8 : bid;
    unsigned char* ws = args.ws;
    gu32* ctl = (gu32*)(ws + WS_CTL);
    const float* x = args.in[0]; const float* w_in = args.in[1]; const float* ssd_conv_w = args.in[2]; const float* ssd_conv_b = args.in[3]; const float* ssd_dt_bias = args.in[4];
    const float* ssd_a_log = args.in[5]; const float* ssd_d = args.in[6]; const float* ssd_norm_w = args.in[7]; const float* sc_conv_w = args.in[8]; const float* sc_norm_w = args.in[9];
    const float* w_out = args.in[10]; const float* norm_mix_w = args.in[11]; const float* norm_ffn_w = args.in[12]; const float* w_query = args.in[13]; const float* sub_keys = args.in[14];
    const float* peer_u = args.in[15]; const float* peer_v = args.in[16]; const float* norm_final_w = args.in[17];
    float* out = args.out;
    bf16* XN = (bf16*)(ws + WS_XN); bf16* WIN = (bf16*)(ws + WS_WIN); bf16* WOUT = (bf16*)(ws + WS_WOUT); bf16* WQ = (bf16*)(ws + WS_WQ); bf16* Y = (bf16*)(ws + WS_Y); bf16* PROJ = (bf16*)(ws + WS_PROJ);
    unsigned char* U8 = ws + WS_U8; unsigned char* V8 = ws + WS_V8; float* SU = (float*)(ws + WS_SU); float* SV = (float*)(ws + WS_SV); unsigned char* XQ = ws + WS_XQ; float* XS = (float*)(ws + WS_XS); float* RS = XS + 16384; float* QF = (float*)(ws + WS_Q); float* SSQ = (float*)(ws + WS_SSQ); bf16* HB = (bf16*)(ws + WS_HB); bf16* KHI = (bf16*)(ws + WS_KH); bf16* KLO = KHI + 8 * 2 * 128 * 128;
    int* IDX = (int*)(ws + WS_IDX); float* GATE = (float*)(ws + WS_GATE);

    for (int u = tid; u < (LDS_BYTES - LDSCTL_OFF) / 4; u += NWAVES * 64) ((LAS unsigned*)(lds + LDSCTL_OFF))[u] = 0u;
    __syncthreads();
    XcdBarrier bar; bar.bar = (unsigned*)(ctl + CW_BAR); bar.x = 0; bar.st = nullptr;
    if (N_LAUNCHES == 1) bar = xcd_barrier_post((unsigned*)(ctl + CW_BAR), MISC + 8);
#define GRID_BAR() do { if (N_LAUNCHES == 1) xcd_barrier(bar); } while (0)
    const int lo = args.ph_lo, hi = args.ph_hi;
#ifndef PH_MASK
#define PH_MASK 0x1ff
#endif
#define PH_EN(k) (((PH_MASK) >> (k)) & 1)

#define IN(k) (lo <= (k) && (k) < hi)
#define BOTH(k) (IN(k) && IN((k) + 1 + ((k) == 6)))
    const int gw = vcu * NWAVES + wave, NGW = G * NWAVES;

    if (PH_EN(0) && IN(0)) { for (int rep = 0; rep < NREP(0); ++rep) {
        LAS float* scr = (LAS float*)(lds + RING_OFF + wave * 16384);
        constexpr int I_IN = (D / 64) * (NPROJ / 32);
        for (int it = gw; it < I_IN; it += NGW) p0_transpose_item(w_in, D, NPROJ, WIN, true, nullptr, scr, it, lane);
        { GAS v4u* z = (GAS v4u*)(WIN + (size_t)NPROJ * D); const size_t n16 = (size_t)(NP - NPROJ) * D * 2 / 16;
          for (size_t i = (size_t)bid * 512 + tid; i < n16; i += (size_t)G * 512) z[i] = (v4u){0u, 0u, 0u, 0u}; }
        for (int m = gw; m < M; m += NGW) rms_row_to_bf16(x + (size_t)m * D, norm_mix_w, XN + (size_t)m * D, lane);
        __syncthreads(); }
        if (BOTH(0)) GRID_BAR();
    }
    if (PH_EN(1) && IN(1)) {
        pg8::Gemm g{XN, WIN, M, NP, D}; pg8::StaticOrder S; S.init(M, NP, G, bid);
        pg8::EpiProj E{PROJ, PP, CH_TILE0, CH_TILES, O_U};
        pg8::gemm_phase<pg8::EpiProj, pg8::StaticOrder, PG8_ALIGN, PG8_SP2>(lds + RING_OFF, g, S, E);
        if (NREP(1) == 2) { __syncthreads(); pg8::gemm_phase<pg8::EpiProj, pg8::StaticOrder, PG8_ALIGN, PG8_SP2>(lds + RING_OFF, g, S, E); }
        {
            const int nwg = (M / 256) * (NP / 256), rem = nwg % G, first = rem ? rem : 0, nb = G - first;
            if (bid >= first) {
                __syncthreads();
                LAS float* scr = (LAS float*)(lds + RING_OFF + wave * 16384);
                const int fi0 = bid - first;
                for (int wt = fi0; wt < 16 * (D / 512); wt += nb) { const int kb = wt >> 3, d = (wt & 7) * 512 + tid;
                    LAS float* kl = (LAS float*)(lds + RING_OFF);
                    for (int i = tid; i < 128 * 128 / 4; i += 512) ((LAS f32x4*)kl)[i] = ((const GAS f32x4*)(sub_keys + (size_t)kb * 16384))[i];
                    float wq[128]; const float gd = norm_ffn_w[d];
#pragma unroll
                    for (int jj = 0; jj < 32; ++jj) { const f32x4 t = *(const GAS f32x4*)(w_query + (size_t)d * PQ + kb * 128 + 4 * jj); wq[4 * jj] = t.x * gd; wq[4 * jj + 1] = t.y * gd; wq[4 * jj + 2] = t.z * gd; wq[4 * jj + 3] = t.w * gd; }
                    __syncthreads();
#pragma unroll 1
                    for (int k = 0; k < 128; ++k) { float a0 = 0.f, a1 = 0.f;
#pragma unroll
                        for (int jj = 0; jj < 32; ++jj) { const f32x4 kk = *(const LAS f32x4*)(kl + k * 128 + 4 * jj); a0 += wq[4 * jj] * kk.x + wq[4 * jj + 2] * kk.z; a1 += wq[4 * jj + 1] * kk.y + wq[4 * jj + 3] * kk.w; }
                        ((GAS unsigned short*)WQ)[(size_t)(kb * 128 + k) * D + d] = (unsigned short)(cvtpk(a0 + a1, 0.f) & 0xffffu); }
                    __syncthreads(); }
                constexpr int I_OUT = (D_MIX / 64) * (D / 32);
                const int gwt = (bid - first) * NWAVES + wave, ngwt = nb * NWAVES;
                for (int it = gwt; it < I_OUT; it += ngwt) p0_transpose_item(w_out, D_MIX, D, WOUT, false, nullptr, scr, it, lane);
            }
        }
        {
            unsigned* tk = (unsigned*)(ctl + CW_TICKET);
            for (;;) { unsigned t0 = 0; if (lane == 0) t0 = xb_add(tk, 1u); t0 = __builtin_amdgcn_readfirstlane(t0); if (t0 >= 2u * NEXP / 4u) break;
#pragma unroll 1
                for (int k = 0; k < 4; ++k) { const int r = (int)t0 * 4 + k; const bool second = r >= NEXP; const int e = second ? r - NEXP : r;
                    if (second) quant_row_fp8(peer_v + (size_t)e * D, V8 + (size_t)e * 128, SV + e, lane); else quant_row_i8(peer_u + (size_t)e * D, U8 + (size_t)e * 128, SU + e, lane); } }
        }
        if (BOTH(1)) GRID_BAR();
    }
    if (PH_EN(2) && IN(2)) {
        bf16* CONV = (bf16*)(ws + WS_CONV);
        for (int rep = 0; rep < NREP(2); ++rep) {
        for (int prep = 0; prep < NREP(10); ++prep) conv_prepass(PROJ, ssd_conv_w, ssd_conv_b, CONV, vcu * 512 + tid, G * 512);
        GRID_BAR();
        for (int u = bid; u < NB * NH; u += G) {
            const int xc = u & 7, j = u >> 3, bg = xc * 4 + (j >> 3), hh = j & 7, b = bg >> 3, gq = bg & 7, h = gq * 8 + hh;
            ssd_unit(lds, b, h, PROJ, CONV, ssd_dt_bias, ssd_a_log, ssd_d, Y, SSQ, tid, wave, lane);
        }
        }
        if (BOTH(2)) GRID_BAR();
    }
    if (PH_EN(3) && IN(3)) {
        for (int m2 = gw; m2 < M / 2; m2 += NGW) p3_rows2(2 * m2, PROJ, sc_conv_w, sc_norm_w, ssd_norm_w, SSQ, Y, lds + RING_OFF + wave * 16384, lane);
        if (BOTH(3)) GRID_BAR();
    }
    if (PH_EN(4) && IN(4)) {
        pg8::Gemm g{Y, WOUT, M, D, D_MIX}; pg8::StaticOrder S; S.init(M, D, G, bid);
        pg8::EpiResBf16 E{HB, x, D};
        pg8::gemm_phase<pg8::EpiResBf16, pg8::StaticOrder, PG8_ALIGN, PG8_SP2>(lds + RING_OFF, g, S, E);
        if (NREP(4) == 2) { __syncthreads(); pg8::gemm_phase<pg8::EpiResBf16, pg8::StaticOrder, PG8_ALIGN, PG8_SP2>(lds + RING_OFF, g, S, E); }
        if (BOTH(4)) GRID_BAR();
    }
    if (PH_EN(5) && IN(5)) { for (int rep = 0; rep < NREP(5); ++rep) {
        for (int m = gw; m < M; m += NGW) rms_row_to_bf16_i8(HB + (size_t)m * D, norm_ffn_w, RS + m, XQ + (size_t)m * D, XS + m, lane);
        }
        if (BOTH(5)) GRID_BAR();
    }
    if (PH_EN(6) && IN(6)) {
        pg8::Gemm g{HB, WQ, M, PQ, D}; pg8::StaticOrder S; S.init(M, PQ, G, bid);
        pg8::EpiRowScaleF32 E{QF, RS, PQ};
        pg8::gemm_phase<pg8::EpiRowScaleF32, pg8::StaticOrder, PG8_ALIGN, PG8_SP2>(lds + RING_OFF, g, S, E);
        if (NREP(6) == 2) { __syncthreads(); pg8::gemm_phase<pg8::EpiRowScaleF32, pg8::StaticOrder, PG8_ALIGN, PG8_SP2>(lds + RING_OFF, g, S, E); }
        asm volatile("s_waitcnt vmcnt(0)" ::: "memory"); __syncthreads();
        for (int i = 0; ; i += 2) { pg8::Unit u0, u1; if (!S.next(i, u0)) break; const bool two = S.next(i + 1, u1);
            route_wg(lds + RING_OFF, two ? 2 : 1, u0.pm, u0.pn, two ? u1.pm : u0.pm, two ? u1.pn : u0.pn, QF, IDX, GATE, tid, wave, lane); }
        if (BOTH(6)) GRID_BAR();
    }
    if (PH_EN(8) && IN(8)) {
        for (int t8 = bid * NWAVES + wave; t8 < M / 8; t8 += G * NWAVES) peer_block(lds + wave * 8192, t8 * 8, XQ, XS, U8, V8, SU, SV, IDX, GATE, HB, out, (bf16*)(ws + WS_Y), norm_final_w, lane);
    }
#undef IN
#undef BOTH
#undef GRID_BAR
}

extern "C" void kernel_launch(void* const* d_in, const int* in_sizes, int n_in, void* d_out, int out_size, void* d_ws, size_t ws_size, hipStream_t stream) {
    static int grid = 0;
    if (grid == 0) {
        if (n_in != 18 || in_sizes[0] != M * D || out_size != M * D || ws_size < WS_END) { fprintf(stderr, "kernel_launch: unexpected shapes / workspace: n_in %d in0 %d out %d ws %zu (need %zu)\n", n_in, n_in > 0 ? in_sizes[0] : -1, out_size, ws_size, (size_t)WS_END); grid = -1; return; }
        int dev = 0, cus = 0, per_cu = 0;
        if (hipGetDevice(&dev) != hipSuccess || hipDeviceGetAttribute(&cus, hipDeviceAttributeMultiprocessorCount, dev) != hipSuccess) { fprintf(stderr, "kernel_launch: device query failed\n"); grid = -1; return; }
        if (hipFuncSetAttribute((const void*)mk_fwd, hipFuncAttributeMaxDynamicSharedMemorySize, LDS_BYTES) != hipSuccess) { fprintf(stderr, "kernel_launch: hipFuncSetAttribute failed\n"); grid = -1; return; }
        if (hipOccupancyMaxActiveBlocksPerMultiprocessor(&per_cu, (const void*)mk_fwd, NWAVES * 64, LDS_BYTES) != hipSuccess || per_cu < 1)
            fprintf(stderr, "kernel_launch: note: occupancy query reports %d workgroups per CU\n", per_cu);
        (void)hipGetLastError();
        grid = cus;
    }
    if (grid < 0) return;
    if (hipMemsetAsync((char*)d_ws + WS_CTL, 0, CTL_ZERO_BYTES, stream) != hipSuccess) { fprintf(stderr, "kernel_launch: memset failed\n"); return; }
    Args a{};
    for (int i = 0; i < 18; ++i) a.in[i] = (const float*)d_in[i];
    a.out = (float*)d_out; a.ws = (unsigned char*)d_ws;
    for (int li = 0; li < N_LAUNCHES; ++li) {
        a.ph_lo = (N_LAUNCHES == 1) ? 0 : li; a.ph_hi = (N_LAUNCHES == 1) ? NPHASE : li + 1; a.li = li; a.pad = 0;
        hipLaunchKernelGGL(mk_fwd, dim3(grid), dim3(NWAVES * 64), LDS_BYTES, stream, a);
        const hipError_t le = hipPeekAtLastError();
        if (le != hipSuccess) { fprintf(stderr, "kernel_launch: launch %d failed: %s\n", li, hipGetErrorName(le)); break; }
    }
}
```

```cpp
#include <hip/hip_runtime.h>
#include <cstdio>
#include <cstdint>
namespace pg8 {
#define PG8_LAS __attribute__((address_space(3)))
typedef unsigned short bf16_t;
typedef short bf16x8 __attribute__((ext_vector_type(8)));
typedef float f32x4 __attribute__((ext_vector_type(4)));
typedef unsigned u32x4 __attribute__((ext_vector_type(4)));
constexpr int BM = 256, BK = 64, HALF = 128, HTB = HALF * BK * 2  , STAGE_BYTES = 8 * HTB, NXCD = 8, WGM = 8;

__host__ __device__ __forceinline__ int lds_byte(int r, int c) { const int st = (r >> 4) * 2 + (c >> 5), rr = r & 15, cc = c & 31, ob = rr * 64 + cc * 2; return st * 1024 + (ob ^ (((ob >> 9) & 1) << 5)); }
__host__ __device__ __forceinline__ void stage_rc(int b, int& R, int& C) { const int st = b / 1024, sb = b % 1024, swz = sb ^ (((sb >> 9) & 1) << 5); R = (st >> 1) * 16 + swz / 64; C = (st & 1) * 32 + (swz % 64) / 2; }
__host__ __device__ __forceinline__ int perm32(int rho) { const int n = rho >> 4, i = rho & 15; return 8 * (i >> 2) + 4 * n + (i & 3); }

struct Unit { int pm, pn; };
struct Gemm { const bf16_t* A; const bf16_t* Bt; int M, N, K; };

struct StaticOrder {
    int nM, nN, nwg, G, c;
    __host__ __device__ void init(int M, int N, int G_, int c_) { nM = M / BM; nN = N / BM; nwg = nM * nN; G = G_; c = c_; }
    __host__ __device__ bool next(int i, Unit& u) const {
        const long L = (long)i * G + c; if (L >= nwg) return false;
        int wgid = (int)L; { const int q = nwg / NXCD, r = nwg % NXCD, xcd = wgid % NXCD, off = wgid / NXCD; wgid = (xcd < r ? xcd * (q + 1) : r * (q + 1) + (xcd - r) * q) + off; }
        const int nig = WGM * nN, gid = wgid / nig, fm = gid * WGM, gsz = (nM - fm) < WGM ? (nM - fm) : WGM;
        u.pm = fm + ((wgid % nig) % gsz); u.pn = (wgid % nig) / gsz; return true;
    }
    __device__ __forceinline__ void a_ready(const Unit&) const {}
    __device__ __forceinline__ void done(const Unit&) const {}
};

__device__ __forceinline__ unsigned cvt_pk_bf16(float lo, float hi) { unsigned r; asm volatile("v_cvt_pk_bf16_f32 %0, %1, %2" : "=v"(r) : "v"(lo), "v"(hi)); return r; }
typedef float f32x2 __attribute__((ext_vector_type(2)));
__device__ __forceinline__ f32x2 gelu_pk(f32x2 v) {
    const f32x2 av = __builtin_elementwise_abs(v), d = av * 0.2316418882f + 1.0f;
    f32x2 t; t.x = __builtin_amdgcn_rcpf(d.x); t.y = __builtin_amdgcn_rcpf(d.y);
    f32x2 q = t * 0.5307027145f + (-0.7265760135f); q = q * t + 0.7107068705f; q = q * t + (-0.142248368f); q = q * t + 0.127414796f; q = q * t;
    const f32x2 s = (v * v) * (-0.72134752044f);
    f32x2 e; e.x = __builtin_amdgcn_exp2f(s.x); e.y = __builtin_amdgcn_exp2f(s.y);
    const f32x2 m = v * (q * e), r = v - m;
    f32x2 o; o.x = v.x < 0.f ? m.x : r.x; o.y = v.y < 0.f ? m.y : r.y; return o;
}

template <int ACT  > struct EpiBf16 {
    static constexpr bool PERM = true, AFTER_DRAIN = false; static_assert(ACT == 0 || ACT == 1, "EpiBf16: ACT is 0 (none) or 1 (gelu_pk)");
    bf16_t* O; int ldc; const float* bias; int split_cols; size_t split_stride; float scale0;
    __device__ __forceinline__ void operator()(const f32x4 (&acc)[2][2][4][2], const Unit& u, int wr, int wc, int fr, int fq) const {
        const int row0 = u.pm * BM + wr * 64 + fr; int colt = u.pn * BM; bf16_t* base = O;
        float sc = 1.f; if (split_cols) { const int t = colt / split_cols; base += (size_t)t * split_stride; colt -= t * split_cols; if (t == 0) sc = scale0; }
        const int col0 = colt + wc * 32 + 8 * fq, bcol0 = u.pn * BM + wc * 32 + 8 * fq;
        f32x4 bv[2][2];
#pragma unroll
        for (int bj = 0; bj < 2; ++bj)
#pragma unroll
            for (int n = 0; n < 2; ++n) bv[bj][n] = bias ? *(const f32x4*)(bias + bcol0 + bj * HALF + 4 * n) : (f32x4){0.f, 0.f, 0.f, 0.f};
#pragma unroll
        for (int ai = 0; ai < 2; ++ai)
#pragma unroll
            for (int m = 0; m < 4; ++m) { bf16_t* rowp = base + (size_t)(row0 + ai * HALF + m * 16) * ldc + col0;
#pragma unroll
                for (int bj = 0; bj < 2; ++bj) { f32x4 v0 = acc[ai][bj][m][0] + bv[bj][0], v1 = acc[ai][bj][m][1] + bv[bj][1];
                    if (ACT == 1) { f32x2 a = gelu_pk((f32x2){v0[0], v0[1]}), b = gelu_pk((f32x2){v0[2], v0[3]}), c = gelu_pk((f32x2){v1[0], v1[1]}), d = gelu_pk((f32x2){v1[2], v1[3]});
                        v0 = (f32x4){a.x, a.y, b.x, b.y}; v1 = (f32x4){c.x, c.y, d.x, d.y}; }
                    v0 = v0 * sc; v1 = v1 * sc; u32x4 w; w.x = cvt_pk_bf16(v0[0], v0[1]); w.y = cvt_pk_bf16(v0[2], v0[3]); w.z = cvt_pk_bf16(v1[0], v1[1]); w.w = cvt_pk_bf16(v1[2], v1[3]);
                    __builtin_nontemporal_store(w, (u32x4*)(rowp + bj * HALF)); } }
    }
};

struct EpiResF32 {
    static constexpr bool PERM = false, AFTER_DRAIN = false;
    float* C; const float* R; int ldc;
    __device__ __forceinline__ void operator()(const f32x4 (&acc)[2][2][4][2], const Unit& u, int wr, int wc, int fr, int fq) const {
        const int row0 = u.pm * BM + wr * 64 + fr, col0 = u.pn * BM + wc * 32 + 4 * fq;
#pragma unroll
        for (int ai = 0; ai < 2; ++ai)
#pragma unroll
            for (int m = 0; m < 4; ++m) { const size_t off = (size_t)(row0 + ai * HALF + m * 16) * ldc + col0;
#pragma unroll
                for (int bj = 0; bj < 2; ++bj)
#pragma unroll
                    for (int n = 0; n < 2; ++n) { f32x4 r = (f32x4){0.f, 0.f, 0.f, 0.f}; if (R) r = *(const f32x4*)(R + off + bj * HALF + n * 16);
                        __builtin_nontemporal_store(acc[ai][bj][m][n] + r, (f32x4*)(C + off + bj * HALF + n * 16)); }
                asm volatile("" ::: "memory"); }
    }
};
struct EpiResBf16 {
    static constexpr bool PERM = true, AFTER_DRAIN = false;
    bf16_t* O; const float* R; int ldc;
    __device__ __forceinline__ void operator()(const f32x4 (&acc)[2][2][4][2], const Unit& u, int wr, int wc, int fr, int fq) const {
        const int row0 = u.pm * BM + wr * 64 + fr, col0 = u.pn * BM + wc * 32 + 8 * fq;
#pragma unroll
        for (int ai = 0; ai < 2; ++ai)
#pragma unroll
            for (int m = 0; m < 4; ++m) { const size_t off = (size_t)(row0 + ai * HALF + m * 16) * ldc + col0;
#pragma unroll
                for (int bj = 0; bj < 2; ++bj) { const f32x4 r0 = __builtin_nontemporal_load((const f32x4*)(R + off + bj * HALF)), r1 = __builtin_nontemporal_load((const f32x4*)(R + off + bj * HALF + 4));
                    const f32x4 v0 = acc[ai][bj][m][0] + r0, v1 = acc[ai][bj][m][1] + r1;
                    u32x4 w; w.x = cvt_pk_bf16(v0[0], v0[1]); w.y = cvt_pk_bf16(v0[2], v0[3]); w.z = cvt_pk_bf16(v1[0], v1[1]); w.w = cvt_pk_bf16(v1[2], v1[3]);
                    __builtin_nontemporal_store(w, (u32x4*)(O + off + bj * HALF)); }
                asm volatile("" ::: "memory"); }
    }
};
struct EpiProj {
    static constexpr bool PERM = true, AFTER_DRAIN = false;
    bf16_t* O; int ldc, ch_tile0, ch_tiles, u_col0;
    __device__ __forceinline__ void operator()(const f32x4 (&acc)[2][2][4][2], const Unit& u, int wr, int wc, int fr, int fq) const {
        const int row0 = u.pm * BM + wr * 64 + fr, cin = wc * 32 + 8 * fq;
        const bool chv = u.pn >= ch_tile0 && u.pn < ch_tile0 + ch_tiles;
        if (chv) { const int col0 = u_col0 + (u.pn - ch_tile0) * HALF + cin;
#pragma unroll
            for (int ai = 0; ai < 2; ++ai)
#pragma unroll
                for (int m = 0; m < 4; ++m) { const f32x4 v0 = acc[ai][0][m][0] * acc[ai][1][m][0], v1 = acc[ai][0][m][1] * acc[ai][1][m][1];
                    u32x4 w; w.x = cvt_pk_bf16(v0[0], v0[1]); w.y = cvt_pk_bf16(v0[2], v0[3]); w.z = cvt_pk_bf16(v1[0], v1[1]); w.w = cvt_pk_bf16(v1[2], v1[3]);
                    __builtin_nontemporal_store(w, (u32x4*)(O + (size_t)(row0 + ai * HALF + m * 16) * ldc + col0)); }
        } else { const int col0 = (u.pn >= ch_tile0 + ch_tiles ? u.pn - ch_tiles / 2 : u.pn) * BM + cin;
#pragma unroll
            for (int ai = 0; ai < 2; ++ai)
#pragma unroll
                for (int m = 0; m < 4; ++m) { bf16_t* rowp = O + (size_t)(row0 + ai * HALF + m * 16) * ldc + col0;
#pragma unroll
                    for (int bj = 0; bj < 2; ++bj) { const f32x4 v0 = acc[ai][bj][m][0], v1 = acc[ai][bj][m][1];
                        u32x4 w; w.x = cvt_pk_bf16(v0[0], v0[1]); w.y = cvt_pk_bf16(v0[2], v0[3]); w.z = cvt_pk_bf16(v1[0], v1[1]); w.w = cvt_pk_bf16(v1[2], v1[3]);
                        __builtin_nontemporal_store(w, (u32x4*)(rowp + bj * HALF)); } }
        }
    }
};
struct EpiRowScaleF32 {
    static constexpr bool PERM = false, AFTER_DRAIN = false;
    float* C; const float* rowscale; int ldc;
    __device__ __forceinline__ void operator()(const f32x4 (&acc)[2][2][4][2], const Unit& u, int wr, int wc, int fr, int fq) const {
        const int row0 = u.pm * BM + wr * 64 + fr, col0 = u.pn * BM + wc * 32 + 4 * fq;
#pragma unroll
        for (int ai = 0; ai < 2; ++ai)
#pragma unroll
            for (int m = 0; m < 4; ++m) { const int row = row0 + ai * HALF + m * 16; const float rsv = rowscale[row]; const size_t off = (size_t)row * ldc + col0;
#pragma unroll
                for (int bj = 0; bj < 2; ++bj)
#pragma unroll
                    for (int n = 0; n < 2; ++n) __builtin_nontemporal_store(acc[ai][bj][m][n] * rsv, (f32x4*)(C + off + bj * HALF + n * 16)); }
    }
};
template <class Epi, class Sched, bool ALIGN_EPI = false, bool SP2 = false>
__device__ __forceinline__ void gemm_phase(PG8_LAS unsigned char* lds, const Gemm g, const Sched& S, const Epi& E) {
    const int tid = threadIdx.x, wid = __builtin_amdgcn_readfirstlane(tid >> 6), lane = tid & 63, wr = wid >> 2, wc = wid & 3, fr = lane & 15, fq = lane >> 4;
    const int K = g.K, nt = K / BK;
    unsigned voffA[2], voffB[2];
#pragma unroll
    for (int i = 0; i < 2; ++i) { int R, C; stage_rc(tid * 16 + i * 8192, R, C); const int Rb = Epi::PERM ? ((R & ~31) + perm32(R & 31)) : R;
        voffA[i] = (unsigned)(R * K + C) * 2u; voffB[i] = (unsigned)(Rb * K + C) * 2u; }
    const size_t kstep = (size_t)(BK * 2);
    const size_t hstep = (size_t)HALF * K * 2;
    const size_t tstep = 2 * hstep;
    const unsigned ldsw = (unsigned)wid * 1024u;
    const int aoff = lds_byte(wr * 64 + fr, fq * 8), boff = lds_byte(wc * 32 + fr, fq * 8);
#define PG8_SA(b, h) (((b) * 2 + (h)) * HTB)
#define PG8_SB(b, h) ((4 + (b) * 2 + (h)) * HTB)
#define PG8_STAGE(bufoff, gbase, voff) do { _Pragma("unroll") for (int _i = 0; _i < 2; ++_i) \
        __builtin_amdgcn_global_load_lds((const unsigned*)((const char*)(gbase) + (voff)[_i]), (PG8_LAS unsigned*)(lds + (bufoff) + ldsw + _i * 8192), 16, 0, 0); } while (0)
#define PG8_LDA(dst, b, h) do { _Pragma("unroll") for (int m = 0; m < 4; ++m) _Pragma("unroll") for (int k = 0; k < 2; ++k) dst[m][k] = *(const PG8_LAS bf16x8*)(lds + PG8_SA(b, h) + aoff + m * 2048 + k * 1024); } while (0)
#define PG8_LDB(dst, b, h) do { _Pragma("unroll") for (int n = 0; n < 2; ++n) _Pragma("unroll") for (int k = 0; k < 2; ++k) dst[n][k] = *(const PG8_LAS bf16x8*)(lds + PG8_SB(b, h) + boff + n * 2048 + k * 1024); } while (0)
#define PG8_MMA(ai, bj, At, Bt) do { __builtin_amdgcn_s_setprio(1); _Pragma("unroll") for (int m = 0; m < 4; ++m) _Pragma("unroll") for (int n = 0; n < 2; ++n) _Pragma("unroll") for (int k = 0; k < 2; ++k) \
        acc[ai][bj][m][n] = __builtin_amdgcn_mfma_f32_16x16x32_bf16(Bt[n][k], At[m][k], acc[ai][bj][m][n], 0, 0, 0); __builtin_amdgcn_s_setprio(0); } while (0)
#define PG8_WAIT_V(n) asm volatile("s_waitcnt vmcnt(" #n ")" ::: "memory")
#define PG8_WAIT_L(n) asm volatile("s_waitcnt lgkmcnt(" #n ")" ::: "memory")
#define PG8_BAR __builtin_amdgcn_s_barrier()
#define PG8_SCHED __builtin_amdgcn_sched_barrier(0)
    Unit cur, nxt; int ui = 0;
    if (!S.next(0, cur)) return;
    f32x4 acc[2][2][4][2];
#pragma unroll
    for (int a = 0; a < 2; ++a)
#pragma unroll
        for (int b = 0; b < 2; ++b)
#pragma unroll
            for (int m = 0; m < 4; ++m)
#pragma unroll
                for (int n = 0; n < 2; ++n) acc[a][b][m][n] = (f32x4){0.f, 0.f, 0.f, 0.f};
    bf16x8 At[4][2], B0[2][2], B1[2][2];
    const char* cA = (const char*)g.A + (size_t)cur.pm * tstep; const char* cB = (const char*)g.Bt + (size_t)cur.pn * tstep;
    S.a_ready(cur);
    if constexpr (SP2) {
        PG8_STAGE(PG8_SB(0, 0), cB, voffB); PG8_STAGE(PG8_SB(0, 1), cB + hstep, voffB); PG8_STAGE(PG8_SA(0, 0), cA, voffA); PG8_STAGE(PG8_SA(0, 1), cA + hstep, voffA);
        if (wr == 1) PG8_BAR;
        PG8_WAIT_V(2); PG8_BAR;
        PG8_STAGE(PG8_SB(1, 0), cB + kstep, voffB); PG8_STAGE(PG8_SA(1, 0), cA + kstep, voffA); PG8_STAGE(PG8_SB(1, 1), cB + hstep + kstep, voffB);
        PG8_WAIT_V(6); PG8_BAR;
    } else {
        PG8_STAGE(PG8_SB(0, 0), cB, voffB); PG8_STAGE(PG8_SA(0, 0), cA, voffA); PG8_STAGE(PG8_SB(0, 1), cB + hstep, voffB); PG8_STAGE(PG8_SA(0, 1), cA + hstep, voffA);
        if (wr == 1) PG8_BAR;
        PG8_WAIT_V(4); PG8_BAR;
        PG8_STAGE(PG8_SB(1, 0), cB + kstep, voffB); PG8_STAGE(PG8_SA(1, 0), cA + kstep, voffA); PG8_STAGE(PG8_SB(1, 1), cB + hstep + kstep, voffB);
        PG8_WAIT_V(6); PG8_BAR;
    }
    for (;;) {
        const bool has_next = S.next(ui + 1, nxt);
        const char* nA = has_next ? (const char*)g.A + (size_t)nxt.pm * tstep : cA; const char* nB = has_next ? (const char*)g.Bt + (size_t)nxt.pn * tstep : cB;
        for (int t = 0; t < nt; t += 2) {
            const bool last = (t == nt - 2);
            const char* a1 = cA + (size_t)(t + 1) * kstep;
            const char* a2 = last ? nA : cA + (size_t)(t + 2) * kstep; const char* b2 = last ? nB : cB + (size_t)(t + 2) * kstep;
            const char* a3 = a2 + kstep; const char* b3 = b2 + kstep;
            if (last && has_next) S.a_ready(nxt);
            if constexpr (SP2) {
            PG8_LDB(B0, 0, 0); PG8_LDB(B1, 0, 1); PG8_SCHED; PG8_LDA(At, 0, 0); PG8_STAGE(PG8_SA(1, 1), a1 + hstep, voffA);
            PG8_WAIT_V(8); PG8_WAIT_L(0); PG8_BAR; PG8_MMA(0, 0, At, B0); PG8_MMA(0, 1, At, B1); PG8_BAR; PG8_SCHED;
            PG8_LDA(At, 0, 1); PG8_STAGE(PG8_SB(0, 0), b2, voffB); PG8_STAGE(PG8_SB(0, 1), b2 + hstep, voffB); PG8_STAGE(PG8_SA(0, 0), a2, voffA);
            PG8_WAIT_V(8); PG8_WAIT_L(0); PG8_BAR; PG8_MMA(1, 0, At, B0); PG8_MMA(1, 1, At, B1); PG8_BAR; PG8_SCHED;
            PG8_LDB(B0, 1, 0); PG8_LDB(B1, 1, 1); PG8_SCHED; PG8_LDA(At, 1, 0); PG8_STAGE(PG8_SA(0, 1), a2 + hstep, voffA);
            PG8_WAIT_V(8); PG8_WAIT_L(0); PG8_BAR; PG8_MMA(0, 0, At, B0); PG8_MMA(0, 1, At, B1); PG8_BAR; PG8_SCHED;
            PG8_LDA(At, 1, 1); PG8_STAGE(PG8_SB(1, 0), b3, voffB); PG8_STAGE(PG8_SB(1, 1), b3 + hstep, voffB); PG8_STAGE(PG8_SA(1, 0), a3, voffA);
            PG8_WAIT_V(8); PG8_WAIT_L(0); PG8_BAR; PG8_MMA(1, 0, At, B0); PG8_MMA(1, 1, At, B1); PG8_BAR; PG8_SCHED;
            } else {
            PG8_LDB(B0, 0, 0); PG8_SCHED; PG8_LDA(At, 0, 0); PG8_STAGE(PG8_SA(1, 1), a1 + hstep, voffA);
            PG8_WAIT_L(8); PG8_BAR; PG8_WAIT_L(0); PG8_MMA(0, 0, At, B0); PG8_BAR; PG8_SCHED;
            PG8_LDB(B1, 0, 1); PG8_STAGE(PG8_SB(0, 0), b2, voffB);
            PG8_BAR; PG8_WAIT_L(0); PG8_MMA(0, 1, At, B1); PG8_BAR;
            PG8_LDA(At, 0, 1); PG8_STAGE(PG8_SA(0, 0), a2, voffA);
            PG8_BAR; PG8_WAIT_L(0); PG8_MMA(1, 0, At, B0); PG8_BAR; PG8_SCHED;
            PG8_STAGE(PG8_SB(0, 1), b2 + hstep, voffB);
            PG8_WAIT_V(6); PG8_BAR; PG8_MMA(1, 1, At, B1); PG8_BAR;
            PG8_LDB(B0, 1, 0); PG8_SCHED; PG8_LDA(At, 1, 0); PG8_STAGE(PG8_SA(0, 1), a2 + hstep, voffA);
            PG8_WAIT_L(8); PG8_BAR; PG8_WAIT_L(0); PG8_MMA(0, 0, At, B0); PG8_BAR; PG8_SCHED;
            PG8_LDB(B1, 1, 1); PG8_STAGE(PG8_SB(1, 0), b3, voffB);
            PG8_BAR; PG8_WAIT_L(0); PG8_MMA(0, 1, At, B1); PG8_BAR;
            PG8_LDA(At, 1, 1); PG8_STAGE(PG8_SA(1, 0), a3, voffA);
            PG8_BAR; PG8_WAIT_L(0); PG8_MMA(1, 0, At, B0); PG8_BAR; PG8_SCHED;
            PG8_STAGE(PG8_SB(1, 1), b3 + hstep, voffB);
            PG8_WAIT_V(6); PG8_BAR; PG8_MMA(1, 1, At, B1); PG8_BAR;
            }
        }
        if constexpr (ALIGN_EPI) { if (wr == 0) PG8_BAR; }
        if constexpr (!Epi::AFTER_DRAIN) { E(acc, cur, wr, wc, fr, fq); S.done(cur); }
        if (!has_next) break;
#pragma unroll
        for (int a = 0; a < 2; ++a)
#pragma unroll
            for (int b = 0; b < 2; ++b)
#pragma unroll
                for (int m = 0; m < 4; ++m)
#pragma unroll
                    for (int n = 0; n < 2; ++n) acc[a][b][m][n] = (f32x4){0.f, 0.f, 0.f, 0.f};
        cur = nxt; cA = nA; cB = nB; ++ui;
        if constexpr (ALIGN_EPI) { if (wr == 1) PG8_BAR; }
    }
    PG8_WAIT_V(0);
    if constexpr (!ALIGN_EPI) { if (wr == 0) PG8_BAR; }
    PG8_BAR;
    if constexpr (Epi::AFTER_DRAIN) { E.fused(acc, cur, wr, wc, fr, fq, lds, wid, lane); S.done(cur); }
#undef PG8_SA
#undef PG8_SB
#undef PG8_STAGE
#undef PG8_LDA
#undef PG8_LDB
#undef PG8_MMA
#undef PG8_WAIT_V
#undef PG8_WAIT_L
#undef PG8_BAR
#undef PG8_SCHED
}
}
#ifndef PG8_SP2
#define PG8_SP2 true
#endif
#ifndef PG8_ALIGN
#define PG8_ALIGN true
#endif

constexpr int NWAVES = 8;
#ifndef MK_N_LAUNCHES
#define MK_N_LAUNCHES 1
#endif
constexpr int NPHASE = 9;
constexpr int N_LAUNCHES = MK_N_LAUNCHES;

constexpr int NB = 4, SEQ = 4096, M = NB * SEQ, D = 4096;
constexpr int D_SSD = 4096, D_CONV = 4096, D_MIX = 8192, NH = 64, HD = 64, NG = 8, NS = 128, D_XBC = 6144;
constexpr int NPROJ = 22592, NP = 22784, PP = NP - 4096;
constexpr int O_Z = 0, O_X = 4096, O_B = 8192, O_C = 9216, O_CH = 10240, O_U = 10240, R_SCB = 18432, R_DT = 22528, O_SCB = R_SCB - 4096, O_DT = R_DT - 4096, CH_TILE0 = O_CH / 256, CH_TILES = 32;
constexpr int SRC_DT = 10240, SRC_SCB = 10304, SRC_SCC = 14400, SRC_SCH = 18496;
__host__ __device__ constexpr int win_row_of_src_col(int n) {
    return n < SRC_DT ? n : n < SRC_SCB ? R_DT + (n - SRC_DT) : n < SRC_SCC ? R_SCB + (n - SRC_SCB)
         : n < SRC_SCH ? O_CH + ((n - SRC_SCC) >> 7) * 256 + ((n - SRC_SCC) & 127) : O_CH + ((n - SRC_SCH) >> 7) * 256 + 128 + ((n - SRC_SCH) & 127); }
constexpr int PH = 8, PK = 128, PTOP = 16, PQ = 2048, NEXP = 16384, HK = 128;
constexpr float EPS = 1e-6f;

constexpr size_t MiB = 1u << 20;
constexpr size_t WS_CTL = 0, CTL_ZERO_BYTES = 1 * MiB;
constexpr size_t WS_XN = 1 * MiB;
constexpr size_t WS_WIN = 129 * MiB;
constexpr size_t WS_WOUT = 307 * MiB;
constexpr size_t WS_WQ = 371 * MiB;
constexpr size_t WS_CONV = 1 * MiB;
constexpr size_t WS_Y = 387 * MiB;
constexpr size_t WS_PROJ = 643 * MiB;
constexpr size_t WS_U8 = 1227 * MiB;
constexpr size_t WS_V8 = 1291 * MiB;
constexpr size_t WS_SU = 1376 * MiB, WS_SV = 1376 * MiB + 65536;
constexpr size_t WS_XQ = 772 * MiB, WS_XS = 836 * MiB;
constexpr size_t WS_Q = 899 * MiB;
constexpr size_t WS_HB = 1027 * MiB;
constexpr size_t WS_SSQ = 1355 * MiB;
constexpr size_t WS_KH = 1359 * MiB;
constexpr size_t WS_IDX = 1360 * MiB;
constexpr size_t WS_GATE = 1368 * MiB;
constexpr size_t WS_END = 1377 * MiB;
static_assert(WS_WIN + (size_t)NP * D * 2 <= WS_WOUT && WS_Y + (size_t)M * D_MIX * 2 <= WS_PROJ && WS_PROJ + (size_t)M * PP * 2 <= WS_U8 && WS_V8 + (size_t)NEXP * D <= WS_SSQ && WS_Q + (size_t)M * PQ * 4 <= WS_SSQ, "d_ws map");
constexpr int CW_TMO = 0, CW_CODE = 1, CW_TICKET = 64;
constexpr int CW_BAR = 4096;

constexpr int RING_OFF = 0, RING_BYTES = 131072;
constexpr int LDSCTL_OFF = RING_BYTES, MISC_OFF = LDSCTL_OFF + 320;
constexpr int LDS_BYTES = 147456;
static_assert(MISC_OFF + 128 <= LDS_BYTES, "LDS map");

#define GAS __attribute__((address_space(1)))
#define LAS __attribute__((address_space(3)))
typedef unsigned short bf16;
typedef unsigned v4u __attribute__((ext_vector_type(4)));
typedef float f32x4 __attribute__((ext_vector_type(4)));
typedef short bf16x8 __attribute__((ext_vector_type(8)));
typedef GAS unsigned gu32;
typedef GAS unsigned long long gu64;
#define RLX_AGENT __ATOMIC_RELAXED, __HIP_MEMORY_SCOPE_AGENT
#define LDS_WAIT() asm volatile("s_waitcnt lgkmcnt(0)" ::: "memory")
#define VM_WAIT() asm volatile("s_waitcnt vmcnt(0)" ::: "memory")
__device__ __forceinline__ unsigned long long rt() { return __builtin_amdgcn_s_memrealtime(); }
__device__ __forceinline__ unsigned f2bf(float f) { unsigned u = __builtin_bit_cast(unsigned, f); return (u + 0x7fffu + ((u >> 16) & 1u)) >> 16; }
__device__ __forceinline__ unsigned pk2(float lo, float hi) { return f2bf(lo) | (f2bf(hi) << 16); }


#define XB_TMO      128
#define XB_XCNT(j)  (256  + 64 * (j))
#define XB_XSUB(j)  (1280 + 64 * (j))
#define XB_XGEN(j)  (2304 + 64 * (j))
#define XB_TOP      3328
#define XB_TOPGEN   3392
#define XCD_BAR_WORDS 3456
#define XB_SPIN_CAP (1u << 18)

__device__ __forceinline__ unsigned xb_ld(unsigned* p)              { return __hip_atomic_load(p, __ATOMIC_RELAXED, __HIP_MEMORY_SCOPE_AGENT); }
__device__ __forceinline__ unsigned xb_add(unsigned* p, unsigned v) { return __hip_atomic_fetch_add(p, v, __ATOMIC_RELAXED, __HIP_MEMORY_SCOPE_AGENT); }
__device__ __forceinline__ unsigned xb_xcc_id() { return (unsigned)__builtin_amdgcn_s_getreg((3 << 11) | 20) & 0xFu; }
#define XB_SPIN(cond, bar) do { unsigned _sp = 0; while (cond) { __builtin_amdgcn_s_sleep(1); \
    if ((++_sp & 255u) == 0u) { if (xb_ld(&(bar)[XB_TMO])) break; if (_sp > XB_SPIN_CAP) { atomicAdd(&(bar)[XB_TMO], 1u); break; } } } } while (0)

struct XcdBarrier {
    unsigned* bar; unsigned x;
    volatile LAS unsigned* st;
};

__device__ __forceinline__ XcdBarrier xcd_barrier_post(unsigned* bar, volatile LAS unsigned* st) {
    XcdBarrier b; b.bar = bar; b.x = xb_xcc_id(); b.st = st;
    if (threadIdx.x == 0) (void)xb_add(&bar[XB_XCNT(b.x)], 1u);
    return b;
}
__device__ __forceinline__ void xcd_barrier_complete(unsigned* bar, unsigned x, unsigned& nloc, unsigned& nx) {
    const unsigned G = gridDim.x * gridDim.y * gridDim.z;
    unsigned sum, cnt, mine, sp = 0u;
    for (;;) {
        sum = 0u; cnt = 0u; mine = 0u;
#pragma unroll
        for (unsigned j = 0; j < 16; ++j) { const unsigned c = xb_ld(&bar[XB_XCNT(j)]); sum += c; cnt += (c > 0u) ? 1u : 0u; mine = (j == x) ? c : mine; }
        if (sum == G) break;
        __builtin_amdgcn_s_sleep(1);
        if ((++sp & 255u) == 0u) { if (xb_ld(&bar[XB_TMO])) break; if (sp > XB_SPIN_CAP) { atomicAdd(&bar[XB_TMO], 1u); break; } }
    }
    nloc = mine > 0u ? mine : 1u; nx = cnt > 0u ? cnt : 1u;
}

__device__ __forceinline__ void xcd_barrier(const XcdBarrier& b) {
    asm volatile("s_waitcnt vmcnt(0)" ::: "memory");
    __syncthreads();
    if (threadIdx.x == 0) {
        unsigned* bar = b.bar;
        __builtin_amdgcn_s_waitcnt(0);
        unsigned nloc = b.st[0], nx = b.st[1];
        if (nloc == 0u) { xcd_barrier_complete(bar, b.x, nloc, nx); b.st[0] = nloc; b.st[1] = nx; }
        const unsigned old = xb_add(&bar[XB_XSUB(b.x)], 1u);
        const unsigned gen = old / nloc;
        if (old + 1u == (gen + 1u) * nloc) {
            __builtin_amdgcn_fence(__ATOMIC_RELEASE, "agent");
            asm volatile("s_waitcnt vmcnt(0)" ::: "memory");
            const unsigned og = xb_add(&bar[XB_TOP], 1u);
            const unsigned tg = og / nx;
            if (og + 1u == (tg + 1u) * nx) xb_add(&bar[XB_TOPGEN], 1u);
            else XB_SPIN(xb_ld(&bar[XB_TOPGEN]) == tg, bar);
            __builtin_amdgcn_fence(__ATOMIC_ACQUIRE, "agent");
            xb_add(&bar[XB_XGEN(b.x)], 1u);
            asm volatile("s_waitcnt vmcnt(0)" ::: "memory");
        } else {
            XB_SPIN(xb_ld(&bar[XB_XGEN(b.x)]) == gen, bar);
            __builtin_amdgcn_fence(__ATOMIC_ACQUIRE, "agent");
            asm volatile("s_waitcnt vmcnt(0)" ::: "memory");
        }
    }
    __syncthreads();
}


#ifndef PROBE_REP
#define PROBE_REP 0
#endif
#define NREP(k) (1 + (((PROBE_REP) >> (k)) & 1))
typedef unsigned u32x4 __attribute__((ext_vector_type(4)));
typedef unsigned u32x2 __attribute__((ext_vector_type(2)));
typedef float f32x2 __attribute__((ext_vector_type(2)));
typedef __bf16 bf2_t __attribute__((ext_vector_type(2)));

__device__ __forceinline__ float wave_sum(float v) {
#pragma unroll
    for (int o = 1; o < 64; o <<= 1) v += __shfl_xor(v, o);
    return v;
}
__device__ __forceinline__ unsigned cvtpk(float lo, float hi) { unsigned r; asm volatile("v_cvt_pk_bf16_f32 %0, %1, %2" : "=v"(r) : "v"(lo), "v"(hi)); return r; }
__device__ __forceinline__ float bflo(unsigned w) { return __uint_as_float(w << 16); }
__device__ __forceinline__ float bfhi(unsigned w) { return __uint_as_float(w & 0xffff0000u); }
__device__ __forceinline__ float siluf(float x) { return x * __builtin_amdgcn_rcpf(1.0f + __expf(-x)); }
__device__ __forceinline__ float dot2bf(unsigned a, unsigned b, float c) { return __builtin_amdgcn_fdot2_f32_bf16(__builtin_bit_cast(bf2_t, a), __builtin_bit_cast(bf2_t, b), c, false); }

__device__ __forceinline__ void p0_transpose_item(const float* W, int K, int N, bf16* WT, bool remap, const float* kgain, LAS float* scr, int item, int lane) {
    const int nblk = N / 32, kb = item / nblk, nb = item % nblk, k0 = 64 * kb, n0 = 32 * nb, d0 = remap ? win_row_of_src_col(n0) : n0;
#pragma unroll 8
    for (int i = 0; i < 32; ++i) { const int kk = 2 * i + (lane >> 5); scr[kk * 33 + (lane & 31)] = __builtin_nontemporal_load((const GAS float*)W + ((size_t)(k0 + kk) * N + n0 + (lane & 31))) * (kgain ? kgain[k0 + kk] : 1.0f); }
    LDS_WAIT(); asm volatile("" ::: "memory");
    const int c = lane & 7;
#pragma unroll
    for (int j = 0; j < 4; ++j) { const int n = (lane >> 3) + 8 * j; const LAS float* s = scr + (8 * c) * 33 + n;
        v4u o; o.x = pk2(s[0 * 33], s[1 * 33]); o.y = pk2(s[2 * 33], s[3 * 33]); o.z = pk2(s[4 * 33], s[5 * 33]); o.w = pk2(s[6 * 33], s[7 * 33]);
        *(GAS v4u*)(WT + (size_t)(d0 + n) * K + k0 + 8 * c) = o; }
    LDS_WAIT(); asm volatile("" ::: "memory");
}
__device__ __forceinline__ void rms_row_to_bf16(const float* xrow, const float* w, bf16* orow, int lane) {
    const GAS f32x4* xr = (const GAS f32x4*)xrow + lane;
    f32x4 v[16]; float s = 0.f;
#pragma unroll
    for (int j = 0; j < 16; ++j) { v[j] = __builtin_nontemporal_load(xr + 64 * j); s += (v[j].x * v[j].x + v[j].y * v[j].y) + (v[j].z * v[j].z + v[j].w * v[j].w); }
    const float rs = 1.0f / sqrtf(wave_sum(s) * (1.f / D) + EPS);
    const GAS f32x4* wr = (const GAS f32x4*)w + lane;
    GAS u32x2* o8 = (GAS u32x2*)orow + lane;
#pragma unroll
    for (int j = 0; j < 16; ++j) { const f32x4 g = wr[64 * j]; u32x2 o; o.x = cvtpk(v[j].x * rs * g.x, v[j].y * rs * g.y); o.y = cvtpk(v[j].z * rs * g.z, v[j].w * rs * g.w); o8[64 * j] = o; }
}

__device__ __forceinline__ void unpack8(const u32x4 v, float (&f)[8]) { f[0] = bflo(v.x); f[1] = bfhi(v.x); f[2] = bflo(v.y); f[3] = bfhi(v.y); f[4] = bflo(v.z); f[5] = bfhi(v.z); f[6] = bflo(v.w); f[7] = bfhi(v.w); }
__device__ __forceinline__ unsigned pack_i8x4(float a, float b, float c, float d) {
    const int ia = __float2int_rn(a), ib = __float2int_rn(b), ic = __float2int_rn(c), id = __float2int_rn(d);
    return ((unsigned)ia & 0xffu) | (((unsigned)ib & 0xffu) << 8) | (((unsigned)ic & 0xffu) << 16) | ((unsigned)id << 24);
}
__device__ __forceinline__ void rms_row_to_bf16_i8(const bf16* hrow, const float* w, float* rsout, unsigned char* qrow, float* qscale, int lane) {
    const GAS u32x4* hr = (const GAS u32x4*)hrow + lane;
    float v[8][8]; float s = 0.f;
#pragma unroll
    for (int j = 0; j < 8; ++j) { const u32x4 t = hr[64 * j]; v[j][0] = bflo(t.x); v[j][1] = bfhi(t.x); v[j][2] = bflo(t.y); v[j][3] = bfhi(t.y); v[j][4] = bflo(t.z); v[j][5] = bfhi(t.z); v[j][6] = bflo(t.w); v[j][7] = bfhi(t.w);
#pragma unroll
        for (int k = 0; k < 8; ++k) s += v[j][k] * v[j][k]; }
    const float rs = 1.0f / sqrtf(wave_sum(s) * (1.f / D) + EPS);
    float am = 0.f; if (lane == 0) *rsout = rs;
#pragma unroll
    for (int j = 0; j < 8; ++j) { const GAS f32x4* wp = (const GAS f32x4*)(w + (j * 64 + lane) * 8); const f32x4 ga = wp[0], gb = wp[1]; const float g[8] = {ga.x, ga.y, ga.z, ga.w, gb.x, gb.y, gb.z, gb.w};
#pragma unroll
        for (int k = 0; k < 8; ++k) { v[j][k] *= rs * g[k]; am = fmaxf(am, fabsf(v[j][k])); }
        }
#pragma unroll
    for (int o = 1; o < 64; o <<= 1) am = fmaxf(am, __shfl_xor(am, o));
    const float sc = am > 0.f ? am * (1.0f / 127.0f) : 1.0f, inv = 1.0f / sc;
    GAS u32x2* q8 = (GAS u32x2*)qrow + lane;
#pragma unroll
    for (int j = 0; j < 8; ++j) { u32x2 p; p.x = pack_i8x4(v[j][0] * inv, v[j][1] * inv, v[j][2] * inv, v[j][3] * inv); p.y = pack_i8x4(v[j][4] * inv, v[j][5] * inv, v[j][6] * inv, v[j][7] * inv); q8[64 * j] = p; }
    if (lane == 0) *qscale = sc;
}

__device__ __forceinline__ u32x4 pack8(const float (&f)[8]) { u32x4 o; o.x = cvtpk(f[0], f[1]); o.y = cvtpk(f[2], f[3]); o.z = cvtpk(f[4], f[5]); o.w = cvtpk(f[6], f[7]); return o; }
__device__ __forceinline__ void conv_prepass(const bf16* PROJ, const float* conv_w, const float* conv_b, bf16* CONV, int gtid, int gthreads) {
    constexpr int NCG = D_XBC / 8, NSEG = SEQ / 16, NIT = NB * NSEG * NCG;
    int it = gtid; if (it >= NIT) return;
#define CP_ITEM(IT, CG, ROW, Z) do { const int _bs = (IT) / NCG; CG = (IT) % NCG; const int _seg = _bs % NSEG, _b = _bs / NSEG; Z = (_seg == 0); ROW = _b * SEQ + _seg * 16; } while (0)
#define CP_SRC(ROW, CG) (PROJ + (size_t)(ROW) * PP + O_X + (CG) * 8)
    int cg, row; bool z0; CP_ITEM(it, cg, row, z0); const bf16* src = CP_SRC(row, cg);
    u32x4 raw[19];
#pragma unroll
    for (int rr = 0; rr < 19; ++rr) raw[rr] = __builtin_nontemporal_load((const GAS u32x4*)(src + (ptrdiff_t)((rr >= 3 || !z0) ? rr - 3 : 0) * PP));
    for (;;) {
        const int itn = it + gthreads; const bool has_next = itn < NIT;
        int cgn = cg, rown = row; bool zn = z0; if (has_next) CP_ITEM(itn, cgn, rown, zn); const bf16* srcn = CP_SRC(rown, cgn);
        const int ch = cg * 8;
        float w[4][8], bias[8];
#pragma unroll
        for (int k = 0; k < 4; ++k) { const f32x4 wa = *(const GAS f32x4*)(conv_w + (size_t)k * D_XBC + ch), wb = *(const GAS f32x4*)(conv_w + (size_t)k * D_XBC + ch + 4);
            w[k][0] = wa.x; w[k][1] = wa.y; w[k][2] = wa.z; w[k][3] = wa.w; w[k][4] = wb.x; w[k][5] = wb.y; w[k][6] = wb.z; w[k][7] = wb.w; }
        { const f32x4 ba = *(const GAS f32x4*)(conv_b + ch), bb = *(const GAS f32x4*)(conv_b + ch + 4); bias[0] = ba.x; bias[1] = ba.y; bias[2] = ba.z; bias[3] = ba.w; bias[4] = bb.x; bias[5] = bb.y; bias[6] = bb.z; bias[7] = bb.w; }
        float win[3][8];
#pragma unroll
        for (int rr = 0; rr < 3; ++rr) { const u32x4 v = z0 ? (u32x4){0u, 0u, 0u, 0u} : raw[rr]; unpack8(v, win[rr]);
            if (has_next) raw[rr] = __builtin_nontemporal_load((const GAS u32x4*)(srcn + (ptrdiff_t)(zn ? 0 : rr - 3) * PP)); }
        bf16* dst = CONV + (size_t)row * D_XBC + ch;
#pragma unroll
        for (int i = 0; i < 16; ++i) { float cur[8], o[8]; unpack8(raw[3 + i], cur);
            if (has_next) raw[3 + i] = __builtin_nontemporal_load((const GAS u32x4*)(srcn + (ptrdiff_t)i * PP));
#pragma unroll
            for (int j = 0; j < 8; ++j) { o[j] = siluf(bias[j] + w[0][j] * win[0][j] + w[1][j] * win[1][j] + w[2][j] * win[2][j] + w[3][j] * cur[j]); win[0][j] = win[1][j]; win[1][j] = win[2][j]; win[2][j] = cur[j]; }
            *(GAS u32x4*)(dst + (size_t)i * D_XBC) = pack8(o); }
        if (!has_next) break;
        it = itn; cg = cgn; row = rown; src = srcn; z0 = zn;
    }
#undef CP_ITEM
#undef CP_SRC
}
constexpr int C_CM = 0, C_BM = 32768, C_BTW = 65536, C_XDT = 98304, C_XB = 114688, C_SM = LDSCTL_OFF + 512;
static_assert(C_XB + 16384 <= RING_BYTES && C_SM + 2 * 2048 + 2048 <= LDS_BYTES, "ssd lds");
__device__ __forceinline__ int sw256(int r, int c) { return r * 256 + ((c ^ (r & 15)) << 4); }
__device__ __forceinline__ int sw128(int r, int c) { return r * 128 + ((c ^ (r & 7)) << 4); }
__device__ __forceinline__ int swT(int r, int c) { return r * 256 + ((c ^ (((r >> 3) ^ r) & 15)) << 4); }
__device__ __forceinline__ float wave_incl_scan(float x) {
    x += __builtin_bit_cast(float, __builtin_amdgcn_update_dpp(0, __builtin_bit_cast(int, x), 0x111, 0xf, 0xf, true));
    x += __builtin_bit_cast(float, __builtin_amdgcn_update_dpp(0, __builtin_bit_cast(int, x), 0x112, 0xf, 0xf, true));
    x += __builtin_bit_cast(float, __builtin_amdgcn_update_dpp(0, __builtin_bit_cast(int, x), 0x114, 0xf, 0xf, true));
    x += __builtin_bit_cast(float, __builtin_amdgcn_update_dpp(0, __builtin_bit_cast(int, x), 0x118, 0xf, 0xf, true));
    x += __builtin_bit_cast(float, __builtin_amdgcn_update_dpp(0, __builtin_bit_cast(int, x), 0x142, 0xa, 0xf, true));
    x += __builtin_bit_cast(float, __builtin_amdgcn_update_dpp(0, __builtin_bit_cast(int, x), 0x143, 0xc, 0xf, true));
    return x;
}
__device__ __forceinline__ void ssd_dt_scan(LAS float* sm, float r0, float r1, float a_neg, int lane) {
    const float d0 = r0 > 20.f ? r0 : __logf(1.0f + __expf(r0)), d1 = r1 > 20.f ? r1 : __logf(1.0f + __expf(r1));
    const float v0 = wave_incl_scan(d0 * a_neg); float v1 = wave_incl_scan(d1 * a_neg);
    v1 += __shfl(v0, 63);
    const float aend = __shfl(v1, 63);
    sm[lane] = d0; sm[64 + lane] = d1; sm[128 + lane] = v0; sm[192 + lane] = v1;
    sm[256 + lane] = __expf(aend - v0); sm[320 + lane] = __expf(aend - v1); sm[384 + lane] = __expf(v0); sm[448 + lane] = __expf(v1);
}
__device__ __forceinline__ void ssd_unit(LAS unsigned char* lds, int b, int h, const bf16* PROJ, const bf16* CONV, const float* dt_bias, const float* a_log, const float* ssd_d,
                                         bf16* Y, float* SSQ, int tid, int wave, int lane) {
    LAS float* smb = (LAS float*)(lds + C_SM); LAS float* ssqp = smb + 1024;
    const int g = h >> 3, pb = wave & 3, th = wave >> 2;
    const float a_neg = -__expf(a_log[h]), dtb = dt_bias[h], Dh = ssd_d[h];
    const size_t rowbase = (size_t)b * SEQ;
    const GAS unsigned char* convb = (const GAS unsigned char*)CONV; const GAS unsigned char* projb = (const GAS unsigned char*)PROJ; GAS unsigned char* yb = (GAS unsigned char*)Y; GAS unsigned char* ssqb = (GAS unsigned char*)SSQ;
#define SSD_ROLES(TT, LL) \
    const bool xitem = (TT) < 128, bitem = (TT) >= 128 && (TT) < 384; \
    const int icg = xitem ? ((TT) & 7) : (((TT) - 128) & 15), its = xitem ? ((TT) >> 3) : (((TT) - 128) >> 4); \
    const unsigned toff = (unsigned)(((rowbase + its * 8) * D_XBC + (xitem ? h * 64 + icg * 8 : D_SSD + g * 128 + icg * 8)) * 2); \
    const unsigned coff = (unsigned)(((rowbase + ((TT) >> 4)) * D_XBC + D_SSD + NG * NS + g * 128 + ((TT) & 15) * 8) * 2); \
    const unsigned doff = (unsigned)(((rowbase + (LL)) * PP + O_DT + h) * 2); \
    const int r = (LL) & 15, q = (LL) >> 4;
    f32x4 ST[8];
#pragma unroll
    for (int i = 0; i < 8; ++i) ST[i] = (f32x4){0.f, 0.f, 0.f, 0.f};
    u32x4 pft[8], pfc[4]; float dr0 = 0.f, dr1 = 0.f;
#define SSD_LBAR() do { asm volatile("s_waitcnt lgkmcnt(0)" ::: "memory"); __builtin_amdgcn_s_barrier(); asm volatile("" ::: "memory"); } while (0)
#define SSD_PREFETCH(cc) do { const unsigned _ro = (unsigned)(cc) * (128u * D_XBC * 2u); \
        if (xitem || bitem) { _Pragma("unroll") for (int _i = 0; _i < 8; ++_i) pft[_i] = *(const GAS u32x4*)(convb + (toff + _ro + (unsigned)_i * (D_XBC * 2u))); } \
        _Pragma("unroll") for (int _k = 0; _k < 4; ++_k) pfc[_k] = *(const GAS u32x4*)(convb + (coff + _ro + (unsigned)_k * (32u * D_XBC * 2u))); } while (0)
#define SSD_DTLOAD(cc) do { if (wave == 0) { const unsigned _o = doff + (unsigned)(cc) * (128u * PP * 2u); \
        dr0 = __uint_as_float((unsigned)*(const GAS unsigned short*)(projb + _o) << 16) + dtb; dr1 = __uint_as_float((unsigned)*(const GAS unsigned short*)(projb + (_o + 64u * PP * 2u)) << 16) + dtb; } } while (0)
    { SSD_ROLES(tid, lane) SSD_DTLOAD(0); SSD_PREFETCH(0); (void)r; (void)q; }
    if (wave == 0) ssd_dt_scan(smb, dr0, dr1, a_neg, lane);
    for (int c = 0; c < SEQ / 128; ++c) {
        const int t0 = c * 128, cn = c + 1 < SEQ / 128 ? c + 1 : c;
        int tt = tid, ll = lane; asm volatile("" : "+v"(tt), "+v"(ll));
        SSD_ROLES(tt, ll)
        LAS float* dtv = smb + (c & 1) * 512; LAS float* acum = dtv + 128; LAS float* wend = dtv + 256; LAS float* eac = dtv + 384;
        SSD_LBAR();
        if (c > 0 && tt < 128) *(GAS float*)(ssqb + (unsigned)(((rowbase + t0 - 128 + tt) * NH + h) * 4)) = (ssqp[tt] + ssqp[128 + tt]) + (ssqp[256 + tt] + ssqp[384 + tt]);
#pragma unroll
        for (int k = 0; k < 4; ++k) *(LAS u32x4*)(lds + C_CM + sw256((tt >> 4) + 32 * k, tt & 15)) = pfc[k];
        if (xitem || bitem) {
            const LAS float* sc = xitem ? dtv : wend; const f32x4 sa = *(const LAS f32x4*)(sc + its * 8), sb2 = *(const LAS f32x4*)(sc + its * 8 + 4); const float s8[8] = {sa.x, sa.y, sa.z, sa.w, sb2.x, sb2.y, sb2.z, sb2.w};
            float o[8][8];
#pragma unroll
            for (int i = 0; i < 8; ++i) { unpack8(pft[i], o[i]);
                if (xitem) *(LAS u32x4*)(lds + C_XB + sw128(its * 8 + i, icg)) = pft[i]; else *(LAS u32x4*)(lds + C_BM + sw256(its * 8 + i, icg)) = pft[i]; }
#pragma unroll
            for (int j = 0; j < 8; ++j) { const float f[8] = {o[0][j] * s8[0], o[1][j] * s8[1], o[2][j] * s8[2], o[3][j] * s8[3], o[4][j] * s8[4], o[5][j] * s8[5], o[6][j] * s8[6], o[7][j] * s8[7]};
                *(LAS u32x4*)(lds + (xitem ? C_XDT : C_BTW) + swT(icg * 8 + j, its)) = pack8(f); }
        }
        SSD_DTLOAD(cn);
        SSD_LBAR();
        if (wave == 0) ssd_dt_scan(smb + ((c + 1) & 1) * 512, dr0, dr1, a_neg, ll);
        f32x4 cb[8];
        {   bf16x8 cfr[4];
#pragma unroll
            for (int ks = 0; ks < 4; ++ks) cfr[ks] = *(const LAS bf16x8*)(lds + C_CM + sw256(16 * wave + r, 4 * ks + q));
#pragma unroll
            for (int sp = 0; sp < 4; ++sp) { cb[2 * sp] = (f32x4){0.f, 0.f, 0.f, 0.f}; cb[2 * sp + 1] = (f32x4){0.f, 0.f, 0.f, 0.f};
                if (2 * sp <= wave) {
                    bf16x8 a0[4], a1[4];
#pragma unroll
                    for (int ks = 0; ks < 4; ++ks) { a0[ks] = *(const LAS bf16x8*)(lds + C_BM + sw256(32 * sp + r, 4 * ks + q)); a1[ks] = *(const LAS bf16x8*)(lds + C_BM + sw256(32 * sp + 16 + r, 4 * ks + q)); }
                    __builtin_amdgcn_sched_barrier(0);
#pragma unroll
                    for (int ks = 0; ks < 4; ++ks) { cb[2 * sp] = __builtin_amdgcn_mfma_f32_16x16x32_bf16(a0[ks], cfr[ks], cb[2 * sp], 0, 0, 0); cb[2 * sp + 1] = __builtin_amdgcn_mfma_f32_16x16x32_bf16(a1[ks], cfr[ks], cb[2 * sp + 1], 0, 0, 0); }
                    __builtin_amdgcn_sched_barrier(0); } } }
        SSD_LBAR();
        {   const float ac_t = acum[16 * wave + r]; const int row = 16 * wave + r;
#pragma unroll
            for (int sb = 0; sb < 8; ++sb) {
                if (sb <= wave) { const f32x4 as4 = *(const LAS f32x4*)(acum + 16 * sb + 4 * q); float m[4];
#pragma unroll
                    for (int j = 0; j < 4; ++j) { const float e = __expf(fminf(ac_t - as4[j], 0.f)); m[j] = (sb == wave && 4 * q + j > r) ? 0.f : cb[sb][j] * e; }
                    u32x2 pk; pk.x = cvtpk(m[0], m[1]); pk.y = cvtpk(m[2], m[3]);
                    *(LAS u32x2*)(lds + C_BM + row * 256 + (((2 * sb + (q >> 1)) ^ (row & 15)) << 4) + (q & 1) * 8) = pk;
                } else if (sb == wave + 1 && !(wave & 1)) {
                    *(LAS u32x2*)(lds + C_BM + row * 256 + (((2 * sb + (q >> 1)) ^ (row & 15)) << 4) + (q & 1) * 8) = (u32x2){0u, 0u}; } } }
        u32x2 zv[4];
#pragma unroll
        for (int j = 0; j < 4; ++j) zv[j] = *(const GAS u32x2*)(projb + (unsigned)(((rowbase + t0 + 16 * (4 * th + j) + r) * PP + O_Z + h * 64 + 16 * pb + 4 * q) * 2));
        SSD_PREFETCH(cn);
        SSD_LBAR();
        bf16x8 xfr[4], sfr[4];
#pragma unroll
        for (int ks = 0; ks < 4; ++ks) { xfr[ks] = *(const LAS bf16x8*)(lds + C_XDT + swT(16 * pb + r, 4 * ks + q));
            sfr[ks] = __builtin_bit_cast(bf16x8, (u32x4){cvtpk(ST[2 * ks][0], ST[2 * ks][1]), cvtpk(ST[2 * ks][2], ST[2 * ks][3]), cvtpk(ST[2 * ks + 1][0], ST[2 * ks + 1][1]), cvtpk(ST[2 * ks + 1][2], ST[2 * ks + 1][3])}); }
#pragma unroll
        for (int j = 0; j < 4; ++j) {
            const int tb = 4 * th + j, trow = 16 * tb + r; const size_t grow = rowbase + t0 + trow; const int p0 = 16 * pb + 4 * q;
            f32x4 ad = (f32x4){0.f, 0.f, 0.f, 0.f}, ao = (f32x4){0.f, 0.f, 0.f, 0.f};
            bf16x8 mmf[4]; u32x2 clo[4], chi[4];
            {   const int cbase = C_CM + trow * 256 + (q & 1) * 8;
#pragma unroll
                for (int ks = 0; ks < 4; ++ks) { mmf[ks] = *(const LAS bf16x8*)(lds + C_BM + sw256(trow, 4 * ks + q));
                    clo[ks] = *(const LAS u32x2*)(lds + cbase + (((4 * ks + (q >> 1)) ^ (trow & 15)) << 4)); chi[ks] = *(const LAS u32x2*)(lds + cbase + (((4 * ks + 2 + (q >> 1)) ^ (trow & 15)) << 4)); } }
            __builtin_amdgcn_sched_barrier(0);
#pragma unroll
            for (int ks = 0; ks < 4; ++ks) { if (2 * ks <= tb) ad = __builtin_amdgcn_mfma_f32_16x16x32_bf16(xfr[ks], mmf[ks], ad, 0, 0, 0);
                ao = __builtin_amdgcn_mfma_f32_16x16x32_bf16(sfr[ks], __builtin_bit_cast(bf16x8, (u32x4){clo[ks].x, clo[ks].y, chi[ks].x, chi[ks].y}), ao, 0, 0, 0); }
            __builtin_amdgcn_sched_barrier(0);
            const float ea = eac[trow];
            const u32x2 xv = *(const LAS u32x2*)(lds + C_XB + trow * 128 + (((2 * pb + (q >> 1)) ^ (trow & 7)) << 4) + (q & 1) * 8);
            const float xx[4] = {bflo(xv.x), bfhi(xv.x), bflo(xv.y), bfhi(xv.y)}, zz[4] = {bflo(zv[j].x), bfhi(zv[j].x), bflo(zv[j].y), bfhi(zv[j].y)};
            float y[4], sq = 0.f;
#pragma unroll
            for (int k = 0; k < 4; ++k) { y[k] = (ad[k] + ea * ao[k] + Dh * xx[k]) * siluf(zz[k]); sq += y[k] * y[k]; }
            u32x2 ov; ov.x = cvtpk(y[0], y[1]); ov.y = cvtpk(y[2], y[3]);
            *(GAS u32x2*)(yb + (unsigned)((grow * D_MIX + h * 64 + p0) * 2)) = ov;
            sq += __shfl_xor(sq, 16); sq += __shfl_xor(sq, 32);
            if (q == 0) ssqp[pb * 128 + trow] = sq;
            __builtin_amdgcn_sched_barrier(0);
        }
        {   const float dend = __expf(acum[127]);
#pragma unroll
            for (int np = 0; np < 4; ++np) { ST[2 * np] = ST[2 * np] * dend; ST[2 * np + 1] = ST[2 * np + 1] * dend;
                bf16x8 a0[4], a1[4];
#pragma unroll
                for (int ks = 0; ks < 4; ++ks) { a0[ks] = *(const LAS bf16x8*)(lds + C_BTW + swT(32 * np + r, 4 * ks + q)); a1[ks] = *(const LAS bf16x8*)(lds + C_BTW + swT(32 * np + 16 + r, 4 * ks + q)); }
                __builtin_amdgcn_sched_barrier(0);
#pragma unroll
                for (int ks = 0; ks < 4; ++ks) { ST[2 * np] = __builtin_amdgcn_mfma_f32_16x16x32_bf16(a0[ks], xfr[ks], ST[2 * np], 0, 0, 0); ST[2 * np + 1] = __builtin_amdgcn_mfma_f32_16x16x32_bf16(a1[ks], xfr[ks], ST[2 * np + 1], 0, 0, 0); }
                __builtin_amdgcn_sched_barrier(0); } }
    }
#undef SSD_ROLES
#undef SSD_LBAR
#undef SSD_PREFETCH
#undef SSD_DTLOAD
    __syncthreads();
    if (tid < 128) *(GAS float*)(ssqb + (unsigned)(((rowbase + SEQ - 128 + tid) * NH + h) * 4)) = (ssqp[tid] + ssqp[128 + tid]) + (ssqp[256 + tid] + ssqp[384 + tid]);
}

__device__ __forceinline__ void p3_rows2(int row0, const bf16* PROJ, const float* sc_w, const float* sc_nw, const float* ssd_nw, const float* SSQ, bf16* Y, LAS unsigned char* scr, int lane) {
    const int s0 = row0 & (SEQ - 1); const bool halo = s0 >= 2;
    const bf16* pr = PROJ + (size_t)row0 * PP + lane * 8;
    float ss0 = 0.f, ss1 = 0.f;
#pragma unroll 2
    for (int i = 0; i < 8; ++i) {
        const int c0 = (i * 64 + lane) * 8; const bf16* q = pr + i * 512; const bf16* qh = halo ? q : q + 2 * PP;
        const u32x4 um2v = *(const GAS u32x4*)(qh - 2 * PP + O_U), um1v = *(const GAS u32x4*)(qh - PP + O_U), u0v = *(const GAS u32x4*)(q + O_U), u1v = *(const GAS u32x4*)(q + PP + O_U);
        const u32x4 b0v = *(const GAS u32x4*)(q + O_SCB), b1v = *(const GAS u32x4*)(q + PP + O_SCB);
        const f32x4 w0a = *(const GAS f32x4*)(sc_w + c0), w0b = *(const GAS f32x4*)(sc_w + c0 + 4), w1a = *(const GAS f32x4*)(sc_w + D_CONV + c0), w1b = *(const GAS f32x4*)(sc_w + D_CONV + c0 + 4),
                    w2a = *(const GAS f32x4*)(sc_w + 2 * D_CONV + c0), w2b = *(const GAS f32x4*)(sc_w + 2 * D_CONV + c0 + 4);
        const float w0[8] = {w0a.x, w0a.y, w0a.z, w0a.w, w0b.x, w0b.y, w0b.z, w0b.w}, w1[8] = {w1a.x, w1a.y, w1a.z, w1a.w, w1b.x, w1b.y, w1b.z, w1b.w}, w2[8] = {w2a.x, w2a.y, w2a.z, w2a.w, w2b.x, w2b.y, w2b.z, w2b.w};
        float um2[8], um1[8], u0[8], u1[8], b0[8], b1[8];
        unpack8(um2v, um2); unpack8(um1v, um1); unpack8(u0v, u0); unpack8(u1v, u1);
#pragma unroll
        for (int j = 0; j < 8; ++j) { um2[j] = halo ? um2[j] : 0.f; um1[j] = halo ? um1[j] : 0.f; }
        unpack8(b0v, b0); unpack8(b1v, b1);
        float y0[8], y1[8];
#pragma unroll
        for (int j = 0; j < 8; ++j) { y0[j] = b0[j] * (w2[j] * u0[j] + w0[j] * um2[j] + w1[j] * um1[j]); y1[j] = b1[j] * (w2[j] * u1[j] + w0[j] * um1[j] + w1[j] * u0[j]); ss0 += y0[j] * y0[j]; ss1 += y1[j] * y1[j]; }
        *(LAS u32x4*)(scr + c0 * 2) = pack8(y0); *(LAS u32x4*)(scr + 8192 + c0 * 2) = pack8(y1);
    }
    const float rs0 = 1.0f / sqrtf(wave_sum(ss0) * (1.f / D_CONV) + EPS), rs1 = 1.0f / sqrtf(wave_sum(ss1) * (1.f / D_CONV) + EPS);
    bf16* yrow = Y + (size_t)row0 * D_MIX + lane * 8;
#pragma unroll 2
    for (int i = 0; i < 8; ++i) { const int c0 = (i * 64 + lane) * 8;
        float f0[8], f1[8]; unpack8(*(const LAS u32x4*)(scr + c0 * 2), f0); unpack8(*(const LAS u32x4*)(scr + 8192 + c0 * 2), f1);
        const f32x4 ga = *(const GAS f32x4*)(sc_nw + c0), gb = *(const GAS f32x4*)(sc_nw + c0 + 4); const float g[8] = {ga.x, ga.y, ga.z, ga.w, gb.x, gb.y, gb.z, gb.w};
#pragma unroll
        for (int j = 0; j < 8; ++j) { f0[j] *= rs0 * g[j]; f1[j] *= rs1 * g[j]; }
        *(GAS u32x4*)(yrow + D_SSD + i * 512) = pack8(f0); *(GAS u32x4*)(yrow + D_MIX + D_SSD + i * 512) = pack8(f1); }
    float gs0 = SSQ[(size_t)row0 * NH + lane], gs1 = SSQ[(size_t)(row0 + 1) * NH + lane];
    gs0 += __shfl_xor(gs0, 1); gs0 += __shfl_xor(gs0, 2); gs0 += __shfl_xor(gs0, 4); gs1 += __shfl_xor(gs1, 1); gs1 += __shfl_xor(gs1, 2); gs1 += __shfl_xor(gs1, 4);
#pragma unroll 2
    for (int i = 0; i < 8; ++i) { const int c0 = (i * 64 + lane) * 8;
        const float rg0 = 1.0f / sqrtf(__shfl(gs0, i * 8) * (1.f / 512.f) + EPS), rg1 = 1.0f / sqrtf(__shfl(gs1, i * 8) * (1.f / 512.f) + EPS);
        float f0[8], f1[8]; unpack8(*(const GAS u32x4*)(yrow + i * 512), f0); unpack8(*(const GAS u32x4*)(yrow + D_MIX + i * 512), f1);
        const f32x4 ga = *(const GAS f32x4*)(ssd_nw + c0), gb = *(const GAS f32x4*)(ssd_nw + c0 + 4); const float g[8] = {ga.x, ga.y, ga.z, ga.w, gb.x, gb.y, gb.z, gb.w};
#pragma unroll
        for (int j = 0; j < 8; ++j) { f0[j] *= rg0 * g[j]; f1[j] *= rg1 * g[j]; }
        *(GAS u32x4*)(yrow + i * 512) = pack8(f0); *(GAS u32x4*)(yrow + D_MIX + i * 512) = pack8(f1); }
}

constexpr int KROW = 272;
constexpr int RT_KH = 0, RT_KL = 128 * KROW, RT_LST = 2 * 128 * KROW, RT_END = RT_LST + 2 * 128 * 16 * 4;
static_assert(RT_END <= RING_BYTES, "route lds");
__device__ __forceinline__ unsigned ord_enc(float s) { const unsigned b = __float_as_uint(s); return (b & 0x80000000u) ? ~b : (b | 0x80000000u); }
__device__ __forceinline__ float ord_dec(unsigned p) { const unsigned o = p & ~127u; return __uint_as_float((o & 0x80000000u) ? (o & 0x7fffffffu) : ~o); }
__device__ __forceinline__ void cex_desc(unsigned& a, unsigned& b) { const unsigned hi = a > b ? a : b, lo = a > b ? b : a; a = hi; b = lo; }
__device__ __forceinline__ void bitonic_merge16_desc(unsigned (&v)[16]) {
#pragma unroll
    for (int j = 8; j > 0; j >>= 1)
#pragma unroll
        for (int i = 0; i < 16; ++i) if ((i & j) == 0) cex_desc(v[i], v[i | j]);
}
__device__ __forceinline__ void bitonic_sort16_desc(unsigned (&v)[16]) {
#pragma unroll
    for (int k = 2; k <= 16; k <<= 1)
#pragma unroll
        for (int j = k >> 1; j > 0; j >>= 1)
#pragma unroll
            for (int i = 0; i < 16; ++i) if ((i & j) == 0) { if ((i & k) == 0) cex_desc(v[i], v[i | j]); else cex_desc(v[i | j], v[i]); }
}
__device__ __forceinline__ void top16_merge_desc(unsigned (&a)[16], const unsigned (&b)[16]) {
#pragma unroll
    for (int j = 0; j < 16; ++j) a[j] = a[j] > b[15 - j] ? a[j] : b[15 - j];
    bitonic_merge16_desc(a);
}
__device__ __forceinline__ void route_wg(LAS unsigned char* lds, int nun, int pm0, int ph0, int pm1, int ph1, const float* Q, int* IDX, float* GATE, int tid, int wave, int lane) {
    LAS unsigned* lst = (LAS unsigned*)lds;
    const int kq = lane >> 4, lr = lane & 15;
    __syncthreads();
#pragma unroll 1
    for (int ps = 0; ps < 2 * nun; ++ps) { const int un = ps >> 1, pm = un ? pm1 : pm0, h = un ? ph1 : ph0, ltok = ps * 128 + wave * 16 + lr;
        const float* qp = Q + (size_t)(pm * 256 + (ps & 1) * 128 + wave * 16 + lr) * PQ + h * 256 + kq * 4;
        f32x4 sc[2][8];
#pragma unroll
        for (int c = 0; c < 2; ++c)
#pragma unroll
            for (int t = 0; t < 8; ++t) sc[c][t] = *(const GAS f32x4*)(qp + c * 128 + 16 * t);
#pragma unroll
        for (int c = 0; c < 2; ++c) {
            unsigned L[16], Hh[16];
#pragma unroll
            for (int t = 0; t < 4; ++t)
#pragma unroll
                for (int r = 0; r < 4; ++r) { L[4 * t + r] = (ord_enc(sc[c][t][r]) & ~127u) | (unsigned)(127 - (16 * t + 4 * kq + r)); Hh[4 * t + r] = (ord_enc(sc[c][t + 4][r]) & ~127u) | (unsigned)(127 - (16 * (t + 4) + 4 * kq + r)); }
            bitonic_sort16_desc(L); bitonic_sort16_desc(Hh);
            top16_merge_desc(L, Hh);
#pragma unroll
            for (int sh = 16; sh <= 32; sh <<= 1) { unsigned P[16];
#pragma unroll
                for (int j = 0; j < 16; ++j) P[j] = (unsigned)__shfl_xor((int)L[j], sh);
                top16_merge_desc(L, P); }
            if (kq == 0) { LAS u32x4* lp = (LAS u32x4*)(lst + (c * 512 + ltok) * 16);
                lp[0] = (u32x4){L[0], L[1], L[2], L[3]}; lp[1] = (u32x4){L[4], L[5], L[6], L[7]}; lp[2] = (u32x4){L[8], L[9], L[10], L[11]}; lp[3] = (u32x4){L[12], L[13], L[14], L[15]}; }
        }
    }
    __syncthreads();
    if (tid < 256 * nun) { const int un = tid >> 8, h = un ? ph1 : ph0; const size_t gtok = (size_t)((un ? pm1 : pm0) * 256 + (tid & 255));
        const LAS unsigned* l0 = lst + (0 * 512 + tid) * 16; const LAS unsigned* l1 = lst + (1 * 512 + tid) * 16;
        float fr[16]; const float s10 = ord_dec(l1[0]);
#pragma unroll
        for (int a = 0; a < 16; ++a) fr[a] = ord_dec(l0[a]) + s10;
        unsigned long long P = 0ull; float bs[16]; int be[16];
#pragma unroll
        for (int k = 0; k < 16; ++k) {
            float best = fr[0]; int ba = 0;
#pragma unroll
            for (int a = 1; a < 16; ++a) { const bool gt = fr[a] > best; best = gt ? fr[a] : best; ba = gt ? a : ba; }
            const int pb = (int)((P >> (4 * ba)) & 15ull);
            const unsigned p0 = l0[ba], p1 = l1[pb];
            bs[k] = best; be[k] = (127 - (int)(p0 & 127u)) * PK + (127 - (int)(p1 & 127u));
            const int nb2 = pb + 1; float nf = -3.0e38f;
            if (nb2 < 16) { P += 1ull << (4 * ba); nf = ord_dec(p0) + ord_dec(l1[nb2]); }
#pragma unroll
            for (int a = 0; a < 16; ++a) fr[a] = (a == ba) ? nf : fr[a];
        }
        float e[16], sum = 0.f;
#pragma unroll
        for (int k = 0; k < 16; ++k) { e[k] = __expf(bs[k] - bs[0]); sum += e[k]; }
        const float inv = 1.0f / sum;
        int* ip = IDX + gtok * HK + h * 16; float* gp = GATE + gtok * HK + h * 16;
#pragma unroll
        for (int k = 0; k < 16; ++k) { ip[k] = be[k]; gp[k] = e[k] * inv; }
    }
}

__device__ __forceinline__ float gelu_erf(float v) { return 0.5f * v * (1.0f + erff(v * 0.70710678118654752f)); }
constexpr size_t SLICE_BYTES = (size_t)NEXP * 128;
__device__ __forceinline__ void quant_row_fp8(const float* src, unsigned char* dst, float* scale, int lane) {
    const GAS f32x4* xr = (const GAS f32x4*)src + lane;
    f32x4 v[16]; float am = 0.f;
#pragma unroll
    for (int j = 0; j < 16; ++j) { v[j] = __builtin_nontemporal_load(xr + 64 * j); am = fmaxf(am, fmaxf(fmaxf(fabsf(v[j].x), fabsf(v[j].y)), fmaxf(fabsf(v[j].z), fabsf(v[j].w)))); }
#pragma unroll
    for (int o = 1; o < 64; o <<= 1) am = fmaxf(am, __shfl_xor(am, o));
    const float sc = am > 0.f ? am * (1.0f / 224.0f) : 1.0f, inv = 1.0f / sc;
    GAS unsigned char* o1 = (GAS unsigned char*)dst + (size_t)(lane >> 5) * SLICE_BYTES + (lane & 31) * 4;
#pragma unroll
    for (int j = 0; j < 16; ++j) { int p = __builtin_amdgcn_cvt_pk_fp8_f32(v[j].x * inv, v[j].y * inv, 0, false); p = __builtin_amdgcn_cvt_pk_fp8_f32(v[j].z * inv, v[j].w * inv, p, true); *(GAS unsigned*)(o1 + (size_t)(2 * j) * SLICE_BYTES) = (unsigned)p; }
    if (lane == 0) *scale = sc;
}
__device__ __forceinline__ void quant_row_i8(const float* src, unsigned char* dst, float* scale, int lane) {
    const GAS f32x4* xr = (const GAS f32x4*)src + lane;
    f32x4 v[16]; float am = 0.f;
#pragma unroll
    for (int j = 0; j < 16; ++j) { v[j] = __builtin_nontemporal_load(xr + 64 * j); am = fmaxf(am, fmaxf(fmaxf(fabsf(v[j].x), fabsf(v[j].y)), fmaxf(fabsf(v[j].z), fabsf(v[j].w)))); }
#pragma unroll
    for (int o = 1; o < 64; o <<= 1) am = fmaxf(am, __shfl_xor(am, o));
    const float sc = am > 0.f ? am * (1.0f / 127.0f) : 1.0f, inv = 1.0f / sc;
    GAS unsigned char* o1 = (GAS unsigned char*)dst + (size_t)(lane >> 5) * SLICE_BYTES + (lane & 31) * 4;
#pragma unroll
    for (int j = 0; j < 16; ++j) *(GAS unsigned*)(o1 + (size_t)(2 * j) * SLICE_BYTES) = pack_i8x4(v[j].x * inv, v[j].y * inv, v[j].z * inv, v[j].w * inv);
    if (lane == 0) *scale = sc;
}
__device__ __forceinline__ void rs16(const float (&d)[16], int bit, int sh1, int sh2, int sh3, float (&out)[2]) {
    float n8[8], n4[4];
#pragma unroll
    for (int m = 0; m < 8; ++m) { const bool up = (bit & sh1) != 0; const float mine = up ? d[8 + m] : d[m], theirs = up ? d[m] : d[8 + m]; n8[m] = mine + __shfl_xor(theirs, sh1); }
#pragma unroll
    for (int m = 0; m < 4; ++m) { const bool up = (bit & sh2) != 0; const float mine = up ? n8[4 + m] : n8[m], theirs = up ? n8[m] : n8[4 + m]; n4[m] = mine + __shfl_xor(theirs, sh2); }
#pragma unroll
    for (int m = 0; m < 2; ++m) { const bool up = (bit & sh3) != 0; const float mine = up ? n4[2 + m] : n4[m], theirs = up ? n4[m] : n4[2 + m]; out[m] = mine + __shfl_xor(theirs, sh3); }
}
__device__ __forceinline__ void peer_block(LAS unsigned char* wl, int tok0, const unsigned char* XQ, const float* XS, const unsigned char* U8, const unsigned char* V8, const float* SU, const float* SV, const int* IDX, const float* GATE, const bf16* HB, float* HO, bf16* X2, const float* wfin, int lane) {
    const int rg = lane >> 3, c = lane & 7; const unsigned cofs = (unsigned)c * 16u;
    LAS unsigned short* idxL = (LAS unsigned short*)wl; LAS float* actL = (LAS float*)(wl + 2048); LAS float* ssqL = (LAS float*)(wl + 6144);
#pragma unroll
    for (int j = 0; j < 8; ++j) {
#pragma unroll
        for (int hh = 0; hh < 2; ++hh) { const int k = hh * 64 + lane; idxL[(j * 8 + (k & 7)) * 16 + (k >> 3)] = (unsigned short)IDX[(size_t)(tok0 + j) * HK + k]; }
        *(LAS f32x2*)(actL + j * 128 + lane * 2) = (f32x2){0.f, 0.f}; ssqL[j * 64 + lane] = 0.f; }
    LDS_WAIT();
    for (int urep = 0; urep < NREP(8); ++urep) {
    if (urep) { for (int j = 0; j < 8; ++j) *(LAS f32x2*)(actL + j * 128 + lane * 2) = (f32x2){0.f, 0.f}; LDS_WAIT(); }
#define PB_LOAD(buf, tab, it) do { const int _s = (it) >> 3, _j = (it) & 7; const GAS unsigned char* _base = (const GAS unsigned char*)(tab) + (size_t)_s * SLICE_BYTES; \
        const u32x4 _ia = *(const LAS u32x4*)(idxL + (_j * 8 + rg) * 16), _ib = *(const LAS u32x4*)(idxL + (_j * 8 + rg) * 16 + 8); const unsigned _iw[8] = {_ia.x, _ia.y, _ia.z, _ia.w, _ib.x, _ib.y, _ib.z, _ib.w}; \
        _Pragma("unroll") for (int _i = 0; _i < 16; ++_i) { const unsigned _e = (_iw[_i >> 1] >> (16 * (_i & 1))) & 0xffffu; buf[_i] = *(const GAS u32x4*)(_base + (_e * 128u + cofs)); } } while (0)
    LAS unsigned char* xsL = wl + 6144; u32x4 xg;
#define PB_XSLICE(s) do { const int _ss = (s) < 32 ? (s) : 31; xg = __builtin_nontemporal_load((const GAS u32x4*)(XQ + (size_t)(tok0 + (lane >> 3)) * D + _ss * 128 + (lane & 7) * 16)); } while (0)
#define PB_XLOAD(xa, it) do { if (((it) & 7) == 0) { *(LAS u32x4*)(xsL + (((it) >> 3) & 1) * 1024 + lane * 16) = xg; LDS_WAIT(); } \
        if (((it) & 7) == 7) PB_XSLICE(((it) >> 3) + 1); \
        xa = *(const LAS u32x4*)(xsL + (((it) >> 3) & 1) * 1024 + ((it) & 7) * 128 + c * 16); } while (0)
#define PB_UCOMP(buf, xa, it) do { const int _j = (it) & 7; float _d[16]; \
        _Pragma("unroll") for (int _i = 0; _i < 16; ++_i) { int _a = __builtin_amdgcn_sdot4((int)buf[_i].x, (int)xa.x, 0, false); _a = __builtin_amdgcn_sdot4((int)buf[_i].y, (int)xa.y, _a, false); \
            _a = __builtin_amdgcn_sdot4((int)buf[_i].z, (int)xa.z, _a, false); _a = __builtin_amdgcn_sdot4((int)buf[_i].w, (int)xa.w, _a, false); _d[_i] = (float)_a; } \
        float _n2[2]; rs16(_d, c, 4, 2, 1, _n2); \
        LAS f32x2* _pp = (LAS f32x2*)(actL + _j * 128 + lane * 2); f32x2 _p = *_pp; _p.x += _n2[0]; _p.y += _n2[1]; *_pp = _p; } while (0)
    {   u32x4 bufA[16], bufB[16], xaA, xaB;
        PB_XSLICE(0); PB_XLOAD(xaA, 0); PB_LOAD(bufA, U8, 0);
#pragma unroll 1
        for (int it = 0; it < 256; it += 2) {
            PB_XLOAD(xaB, it + 1); PB_LOAD(bufB, U8, it + 1);
            __builtin_amdgcn_sched_barrier(0);
            PB_UCOMP(bufA, xaA, it);
            __builtin_amdgcn_sched_barrier(0);
            PB_XLOAD(xaA, (it + 2) & 255); PB_LOAD(bufA, U8, (it + 2) & 255);
            __builtin_amdgcn_sched_barrier(0);
            PB_UCOMP(bufB, xaB, it + 1);
            __builtin_amdgcn_sched_barrier(0);
        }
    }
    }
#pragma unroll 1
    for (int j = 0; j < 8; ++j) { const int tok = tok0 + j, k0 = 16 * c + rg, k1 = k0 + 8;
        LAS f32x2* pp = (LAS f32x2*)(actL + j * 128 + lane * 2); const f32x2 p = *pp;
        const unsigned ew = *(const LAS unsigned*)(idxL + (j * 8 + rg) * 16 + 2 * c); const int e0 = (int)(ew & 0xffffu), e1 = (int)(ew >> 16);
        const float g0 = GATE[(size_t)tok * HK + k0], g1 = GATE[(size_t)tok * HK + k1];
        const float xs = XS[tok]; const float a0 = gelu_erf(p.x * xs * SU[e0]) * g0 * SV[e0], a1 = gelu_erf(p.y * xs * SU[e1]) * g1 * SV[e1];
        *pp = (f32x2){a0, a1}; }
    LDS_WAIT();
    for (int vrep = 0; vrep < NREP(9); ++vrep) {
    if (vrep) { for (int j = 0; j < 8; ++j) ssqL[j * 64 + lane] = 0.f; LDS_WAIT(); }
#define PB_HOFF(it) ((size_t)(tok0 + ((it) & 7)) * D + ((it) >> 3) * 128 + 16 * c + 2 * rg)
#define PB_VCOMP(buf, it) do { const int _j = (it) & 7; \
        const LAS f32x4* _ap = (const LAS f32x4*)(actL + (_j * 8 + rg) * 16); const f32x4 _a0 = _ap[0], _a1 = _ap[1], _a2 = _ap[2], _a3 = _ap[3]; \
        const float _av[16] = {_a0.x, _a0.y, _a0.z, _a0.w, _a1.x, _a1.y, _a1.z, _a1.w, _a2.x, _a2.y, _a2.z, _a2.w, _a3.x, _a3.y, _a3.z, _a3.w}; \
        f32x2 _o[8]; _Pragma("unroll") for (int _m = 0; _m < 8; ++_m) _o[_m] = (f32x2){0.f, 0.f}; \
        _Pragma("unroll") for (int _i = 0; _i < 16; ++_i) { const f32x2 _a2v = (f32x2){_av[_i], _av[_i]}; const unsigned _w[4] = {buf[_i].x, buf[_i].y, buf[_i].z, buf[_i].w}; \
            _Pragma("unroll") for (int _q = 0; _q < 4; ++_q) { const f32x2 _lo = __builtin_amdgcn_cvt_pk_f32_fp8((int)_w[_q], false), _hi = __builtin_amdgcn_cvt_pk_f32_fp8((int)_w[_q], true); _o[2 * _q] += _a2v * _lo; _o[2 * _q + 1] += _a2v * _hi; } } \
        const float _ov[16] = {_o[0].x, _o[0].y, _o[1].x, _o[1].y, _o[2].x, _o[2].y, _o[3].x, _o[3].y, _o[4].x, _o[4].y, _o[5].x, _o[5].y, _o[6].x, _o[6].y, _o[7].x, _o[7].y}; \
        float _n2[2]; rs16(_ov, lane, 32, 16, 8, _n2); \
        __builtin_nontemporal_store(cvtpk(_n2[0], _n2[1]), (GAS unsigned*)(X2 + PB_HOFF(it))); } while (0)
    {   u32x4 bufA[16], bufB[16];
        PB_LOAD(bufA, V8, 0);
#pragma unroll 1
        for (int it = 0; it < 256; it += 2) {
            PB_LOAD(bufB, V8, it + 1);
            __builtin_amdgcn_sched_barrier(0);
            PB_VCOMP(bufA, it);
            __builtin_amdgcn_sched_barrier(0);
            if (it + 2 < 256) { PB_LOAD(bufA, V8, it + 2); }
            __builtin_amdgcn_sched_barrier(0);
            PB_VCOMP(bufB, it + 1);
            __builtin_amdgcn_sched_barrier(0);
        }
    }
    }
#undef PB_LOAD
#undef PB_XLOAD
#undef PB_XSLICE
#undef PB_UCOMP
#undef PB_HOFF
#undef PB_VCOMP
    LDS_WAIT();
    asm volatile("s_waitcnt vmcnt(0)" ::: "memory");
#pragma unroll 1
    for (int j = 0; j < 8; ++j) { const size_t ro = (size_t)(tok0 + j) * D;
        const GAS u32x2* sp = (const GAS u32x2*)(X2 + ro) + lane; const GAS u32x2* hp = (const GAS u32x2*)(HB + ro) + lane;
        f32x4 xv[16]; float ss = 0.f;
#pragma unroll
        for (int q = 0; q < 16; ++q) { const u32x2 v = __builtin_nontemporal_load(sp + 64 * q), hv = __builtin_nontemporal_load(hp + 64 * q);
            xv[q] = (f32x4){bflo(v.x) + bflo(hv.x), bfhi(v.x) + bfhi(hv.x), bflo(v.y) + bflo(hv.y), bfhi(v.y) + bfhi(hv.y)}; ss += (xv[q].x * xv[q].x + xv[q].y * xv[q].y) + (xv[q].z * xv[q].z + xv[q].w * xv[q].w); }
        const float rs = 1.0f / sqrtf(wave_sum(ss) * (1.f / D) + EPS);
        GAS f32x4* rp = (GAS f32x4*)(HO + ro) + lane; unsigned gofs = (unsigned)lane * 16u; asm volatile("" : "+v"(gofs));
#pragma unroll
        for (int q = 0; q < 16; ++q) { const f32x4 g = *(const GAS f32x4*)((const GAS unsigned char*)wfin + (gofs + (unsigned)q * 1024u)); rp[64 * q] = (f32x4){xv[q].x * rs * g.x, xv[q].y * rs * g.y, xv[q].z * rs * g.z, xv[q].w * rs * g.w}; } }
}

struct Args { const float* in[18]; float* out; unsigned char* ws; int ph_lo, ph_hi, li, pad; };
__global__ void __launch_bounds__(NWAVES * 64, 2) mk_fwd(Args args) {
    extern __shared__ __attribute__((aligned(16))) unsigned char lds_raw[];
    LAS unsigned char* lds = (LAS unsigned char*)lds_raw;
    volatile LAS unsigned* MISC = (volatile LAS unsigned*)(lds + MISC_OFF);
    const int tid = threadIdx.x, lane = tid & 63, wave = __builtin_amdgcn_readfirstlane(tid >> 6);
    const int G = gridDim.x, bid = blockIdx.x;
    const int vcu = (G % 8 == 0) ? (bid % 8) * (G / 8) + bid / 8 : bid;
    unsigned char* ws = args.ws;
    gu32* ctl = (gu32*)(ws + WS_CTL);
    const float* x = args.in[0]; const float* w_in = args.in[1]; const float* ssd_conv_w = args.in[2]; const float* ssd_conv_b = args.in[3]; const float* ssd_dt_bias = args.in[4];
    const float* ssd_a_log = args.in[5]; const float* ssd_d = args.in[6]; const float* ssd_norm_w = args.in[7]; const float* sc_conv_w = args.in[8]; const float* sc_norm_w = args.in[9];
    const float* w_out = args.in[10]; const float* norm_mix_w = args.in[11]; const float* norm_ffn_w = args.in[12]; const float* w_query = args.in[13]; const float* sub_keys = args.in[14];
    const float* peer_u = args.in[15]; const float* peer_v = args.in[16]; const float* norm_final_w = args.in[17];
    float* out = args.out;
    bf16* XN = (bf16*)(ws + WS_XN); bf16* WIN = (bf16*)(ws + WS_WIN); bf16* WOUT = (bf16*)(ws + WS_WOUT); bf16* WQ = (bf16*)(ws + WS_WQ); bf16* Y = (bf16*)(ws + WS_Y); bf16* PROJ = (bf16*)(ws + WS_PROJ);
    unsigned char* U8 = ws + WS_U8; unsigned char* V8 = ws + WS_V8; float* SU = (float*)(ws + WS_SU); float* SV = (float*)(ws + WS_SV); unsigned char* XQ = ws + WS_XQ; float* XS = (float*)(ws + WS_XS); float* RS = XS + 16384; float* QF = (float*)(ws + WS_Q); float* SSQ = (float*)(ws + WS_SSQ); bf16* HB = (bf16*)(ws + WS_HB); bf16* KHI = (bf16*)(ws + WS_KH); bf16* KLO = KHI + 8 * 2 * 128 * 128;
    int* IDX = (int*)(ws + WS_IDX); float* GATE = (float*)(ws + WS_GATE);

    for (int u = tid; u < (LDS_BYTES - LDSCTL_OFF) / 4; u += NWAVES * 64) ((LAS unsigned*)(lds + LDSCTL_OFF))[u] = 0u;
    __syncthreads();
    XcdBarrier bar; bar.bar = (unsigned*)(ctl + CW_BAR); bar.x = 0; bar.st = nullptr;
    if (N_LAUNCHES == 1) bar = xcd_barrier_post((unsigned*)(ctl + CW_BAR), MISC + 8);
#define GRID_BAR() do { if (N_LAUNCHES == 1) xcd_barrier(bar); } while (0)
    const int lo = args.ph_lo, hi = args.ph_hi;
#ifndef PH_MASK
#define PH_MASK 0x1ff
#endif
#define PH_EN(k) (((PH_MASK) >> (k)) & 1)

#define IN(k) (lo <= (k) && (k) < hi)
#define BOTH(k) (IN(k) && IN((k) + 1 + ((k) == 6)))
    const int gw = vcu * NWAVES + wave, NGW = G * NWAVES;

    if (PH_EN(0) && IN(0)) { for (int rep = 0; rep < NREP(0); ++rep) {
        LAS float* scr = (LAS float*)(lds + RING_OFF + wave * 16384);
        constexpr int I_IN = (D / 64) * (NPROJ / 32);
        for (int it = gw; it < I_IN; it += NGW) p0_transpose_item(w_in, D, NPROJ, WIN, true, nullptr, scr, it, lane);
        { GAS v4u* z = (GAS v4u*)(WIN + (size_t)NPROJ * D); const size_t n16 = (size_t)(NP - NPROJ) * D * 2 / 16;
          for (size_t i = (size_t)bid * 512 + tid; i < n16; i += (size_t)G * 512) z[i] = (v4u){0u, 0u, 0u, 0u}; }
        for (int m = gw; m < M; m += NGW) rms_row_to_bf16(x + (size_t)m * D, norm_mix_w, XN + (size_t)m * D, lane);
        __syncthreads(); }
        if (BOTH(0)) GRID_BAR();
    }
    if (PH_EN(1) && IN(1)) {
        pg8::Gemm g{XN, WIN, M, NP, D}; pg8::StaticOrder S; S.init(M, NP, G, bid);
        pg8::EpiProj E{PROJ, PP, CH_TILE0, CH_TILES, O_U};
        pg8::gemm_phase<pg8::EpiProj, pg8::StaticOrder, PG8_ALIGN, PG8_SP2>(lds + RING_OFF, g, S, E);
        if (NREP(1) == 2) { __syncthreads(); pg8::gemm_phase<pg8::EpiProj, pg8::StaticOrder, PG8_ALIGN, PG8_SP2>(lds + RING_OFF, g, S, E); }
        {
            const int nwg = (M / 256) * (NP / 256), rem = nwg % G, first = rem ? rem : 0, nb = G - first;
            if (bid >= first) {
                __syncthreads();
                LAS float* scr = (LAS float*)(lds + RING_OFF + wave * 16384);
                const int fi0 = bid - first;
                for (int wt = fi0; wt < 16 * (D / 512); wt += nb) { const int kb = wt >> 3, d = (wt & 7) * 512 + tid;
                    LAS float* kl = (LAS float*)(lds + RING_OFF);
                    for (int i = tid; i < 128 * 128 / 4; i += 512) ((LAS f32x4*)kl)[i] = ((const GAS f32x4*)(sub_keys + (size_t)kb * 16384))[i];
                    float wq[128]; const float gd = norm_ffn_w[d];
#pragma unroll
                    for (int jj = 0; jj < 32; ++jj) { const f32x4 t = *(const GAS f32x4*)(w_query + (size_t)d * PQ + kb * 128 + 4 * jj); wq[4 * jj] = t.x * gd; wq[4 * jj + 1] = t.y * gd; wq[4 * jj + 2] = t.z * gd; wq[4 * jj + 3] = t.w * gd; }
                    __syncthreads();
#pragma unroll 1
                    for (int k = 0; k < 128; ++k) { float a0 = 0.f, a1 = 0.f;
#pragma unroll
                        for (int jj = 0; jj < 32; ++jj) { const f32x4 kk = *(const LAS f32x4*)(kl + k * 128 + 4 * jj); a0 += wq[4 * jj] * kk.x + wq[4 * jj + 2] * kk.z; a1 += wq[4 * jj + 1] * kk.y + wq[4 * jj + 3] * kk.w; }
                        ((GAS unsigned short*)WQ)[(size_t)(kb * 128 + k) * D + d] = (unsigned short)(cvtpk(a0 + a1, 0.f) & 0xffffu); }
                    __syncthreads(); }
                constexpr int I_OUT = (D_MIX / 64) * (D / 32);
                const int gwt = (bid - first) * NWAVES + wave, ngwt = nb * NWAVES;
                for (int it = gwt; it < I_OUT; it += ngwt) p0_transpose_item(w_out, D_MIX, D, WOUT, false, nullptr, scr, it, lane);
            }
        }
        {
            unsigned* tk = (unsigned*)(ctl + CW_TICKET);
            for (;;) { unsigned t0 = 0; if (lane == 0) t0 = xb_add(tk, 1u); t0 = __builtin_amdgcn_readfirstlane(t0); if (t0 >= 2u * NEXP / 4u) break;
#pragma unroll 1
                for (int k = 0; k < 4; ++k) { const int r = (int)t0 * 4 + k; const bool second = r >= NEXP; const int e = second ? r - NEXP : r;
                    if (second) quant_row_fp8(peer_v + (size_t)e * D, V8 + (size_t)e * 128, SV + e, lane); else quant_row_i8(peer_u + (size_t)e * D, U8 + (size_t)e * 128, SU + e, lane); } }
        }
        if (BOTH(1)) GRID_BAR();
    }
    if (PH_EN(2) && IN(2)) {
        bf16* CONV = (bf16*)(ws + WS_CONV);
        for (int rep = 0; rep < NREP(2); ++rep) {
        for (int prep = 0; prep < NREP(10); ++prep) conv_prepass(PROJ, ssd_conv_w, ssd_conv_b, CONV, vcu * 512 + tid, G * 512);
        GRID_BAR();
        for (int u = bid; u < NB * NH; u += G) {
            const int xc = u & 7, j = u >> 3, bg = xc * 4 + (j >> 3), hh = j & 7, b = bg >> 3, gq = bg & 7, h = gq * 8 + hh;
            ssd_unit(lds, b, h, PROJ, CONV, ssd_dt_bias, ssd_a_log, ssd_d, Y, SSQ, tid, wave, lane);
        }
        }
        if (BOTH(2)) GRID_BAR();
    }
    if (PH_EN(3) && IN(3)) {
        for (int m2 = gw; m2 < M / 2; m2 += NGW) p3_rows2(2 * m2, PROJ, sc_conv_w, sc_norm_w, ssd_norm_w, SSQ, Y, lds + RING_OFF + wave * 16384, lane);
        if (BOTH(3)) GRID_BAR();
    }
    if (PH_EN(4) && IN(4)) {
        pg8::Gemm g{Y, WOUT, M, D, D_MIX}; pg8::StaticOrder S; S.init(M, D, G, bid);
        pg8::EpiResBf16 E{HB, x, D};
        pg8::gemm_phase<pg8::EpiResBf16, pg8::StaticOrder, PG8_ALIGN, PG8_SP2>(lds + RING_OFF, g, S, E);
        if (NREP(4) == 2) { __syncthreads(); pg8::gemm_phase<pg8::EpiResBf16, pg8::StaticOrder, PG8_ALIGN, PG8_SP2>(lds + RING_OFF, g, S, E); }
        if (BOTH(4)) GRID_BAR();
    }
    if (PH_EN(5) && IN(5)) { for (int rep = 0; rep < NREP(5); ++rep) {
        for (int m = gw; m < M; m += NGW) rms_row_to_bf16_i8(HB + (size_t)m * D, norm_ffn_w, RS + m, XQ + (size_t)m * D, XS + m, lane);
        }
        if (BOTH(5)) GRID_BAR();
    }
    if (PH_EN(6) && IN(6)) {
        pg8::Gemm g{HB, WQ, M, PQ, D}; pg8::StaticOrder S; S.init(M, PQ, G, bid);
        pg8::EpiRowScaleF32 E{QF, RS, PQ};
        pg8::gemm_phase<pg8::EpiRowScaleF32, pg8::StaticOrder, PG8_ALIGN, PG8_SP2>(lds + RING_OFF, g, S, E);
        if (NREP(6) == 2) { __syncthreads(); pg8::gemm_phase<pg8::EpiRowScaleF32, pg8::StaticOrder, PG8_ALIGN, PG8_SP2>(lds + RING_OFF, g, S, E); }
        asm volatile("s_waitcnt vmcnt(0)" ::: "memory"); __syncthreads();
        for (int i = 0; ; i += 2) { pg8::Unit u0, u1; if (!S.next(i, u0)) break; const bool two = S.next(i + 1, u1);
            route_wg(lds + RING_OFF, two ? 2 : 1, u0.pm, u0.pn, two ? u1.pm : u0.pm, two ? u1.pn : u0.pn, QF, IDX, GATE, tid, wave, lane); }
        if (BOTH(6)) GRID_BAR();
    }
    if (PH_EN(8) && IN(8)) {
        for (int t8 = bid * NWAVES + wave; t8 < M / 8; t8 += G * NWAVES) peer_block(lds + wave * 8192, t8 * 8, XQ, XS, U8, V8, SU, SV, IDX, GATE, HB, out, (bf16*)(ws + WS_Y), norm_final_w, lane);
    }
#undef IN
#undef BOTH
#undef GRID_BAR
}

extern "C" void kernel_launch(void* const* d_in, const int* in_sizes, int n_in, void* d_out, int out_size, void* d_ws, size_t ws_size, hipStream_t stream) {
    static int grid = 0;
    if (grid == 0) {
        if (n_in != 18 || in_sizes[0] != M * D || out_size != M * D || ws_size < WS_END) { fprintf(stderr, "kernel_launch: unexpected shapes / workspace: n_in %d in0 %d out %d ws %zu (need %zu)\n", n_in, n_in > 0 ? in_sizes[0] : -1, out_size, ws_size, (size_t)WS_END); grid = -1; return; }
        int dev = 0, cus = 0, per_cu = 0;
        if (hipGetDevice(&dev) != hipSuccess || hipDeviceGetAttribute(&cus, hipDeviceAttributeMultiprocessorCount, dev) != hipSuccess) { fprintf(stderr, "kernel_launch: device query failed\n"); grid = -1; return; }
        if (hipFuncSetAttribute((const void*)mk_fwd, hipFuncAttributeMaxDynamicSharedMemorySize, LDS_BYTES) != hipSuccess) { fprintf(stderr, "kernel_launch: hipFuncSetAttribute failed\n"); grid = -1; return; }
        if (hipOccupancyMaxActiveBlocksPerMultiprocessor(&per_cu, (const void*)mk_fwd, NWAVES * 64, LDS_BYTES) != hipSuccess || per_cu < 1)
            fprintf(stderr, "kernel_launch: note: occupancy query reports %d workgroups per CU\n", per_cu);
        (void)hipGetLastError();
        grid = cus;
    }
    if (grid < 0) return;
    if (hipMemsetAsync((char*)d_ws + WS_CTL, 0, CTL_ZERO_BYTES, stream) != hipSuccess) { fprintf(stderr, "kernel_launch: memset failed\n"); return; }
    Args a{};
    for (int i = 0; i < 18; ++i) a.in[i] = (const float*)d_in[i];
    a.out = (float*)d_out; a.ws = (unsigned char*)d_ws;
    for (int li = 0; li < N_LAUNCHES; ++li) {
        a.ph_lo = (N_LAUNCHES == 1) ? 0 : li; a.ph_hi = (N_LAUNCHES == 1) ? NPHASE : li + 1; a.li = li; a.pad = 0;
        hipLaunchKernelGGL(mk_fwd, dim3(grid), dim3(NWAVES * 64), LDS_BYTES, stream, a);
        const hipError_t le = hipPeekAtLastError();
        if (le != hipSuccess) { fprintf(stderr, "kernel_launch: launch %d failed: %s\n", li, hipGetErrorName(le)); break; }
    }
}
```

```cpp
#include <hip/hip_runtime.h>
#include <cstdio>
#include <cstdint>
namespace pg8 {
#define PG8_LAS __attribute__((address_space(3)))
typedef unsigned short bf16_t;
typedef short bf16x8 __attribute__((ext_vector_type(8)));
typedef float f32x4 __attribute__((ext_vector_type(4)));
typedef unsigned u32x4 __attribute__((ext_vector_type(4)));
constexpr int BM = 256, BK = 64, HALF = 128, HTB = HALF * BK * 2  , STAGE_BYTES = 8 * HTB, NXCD = 8, WGM = 8;

__host__ __device__ __forceinline__ int lds_byte(int r, int c) { const int st = (r >> 4) * 2 + (c >> 5), rr = r & 15, cc = c & 31, ob = rr * 64 + cc * 2; return st * 1024 + (ob ^ (((ob >> 9) & 1) << 5)); }
__host__ __device__ __forceinline__ void stage_rc(int b, int& R, int& C) { const int st = b / 1024, sb = b % 1024, swz = sb ^ (((sb >> 9) & 1) << 5); R = (st >> 1) * 16 + swz / 64; C = (st & 1) * 32 + (swz % 64) / 2; }
__host__ __device__ __forceinline__ int perm32(int rho) { const int n = rho >> 4, i = rho & 15; return 8 * (i >> 2) + 4 * n + (i & 3); }

struct Unit { int pm, pn; };
struct Gemm { const bf16_t* A; const bf16_t* Bt; int M, N, K; };

struct StaticOrder {
    int nM, nN, nwg, G, c;
    __host__ __device__ void init(int M, int N, int G_, int c_) { nM = M / BM; nN = N / BM; nwg = nM * nN; G = G_; c = c_; }
    __host__ __device__ bool next(int i, Unit& u) const {
        const long L = (long)i * G + c; if (L >= nwg) return false;
        int wgid = (int)L; { const int q = nwg / NXCD, r = nwg % NXCD, xcd = wgid % NXCD, off = wgid / NXCD; wgid = (xcd < r ? xcd * (q + 1) : r * (q + 1) + (xcd - r) * q) + off; }
        const int nig = WGM * nN, gid = wgid / nig, fm = gid * WGM, gsz = (nM - fm) < WGM ? (nM - fm) : WGM;
        u.pm = fm + ((wgid % nig) % gsz); u.pn = (wgid % nig) / gsz; return true;
    }
    __device__ __forceinline__ void a_ready(const Unit&) const {}
    __device__ __forceinline__ void done(const Unit&) const {}
};

__device__ __forceinline__ unsigned cvt_pk_bf16(float lo, float hi) { unsigned r; asm volatile("v_cvt_pk_bf16_f32 %0, %1, %2" : "=v"(r) : "v"(lo), "v"(hi)); return r; }
typedef float f32x2 __attribute__((ext_vector_type(2)));
__device__ __forceinline__ f32x2 gelu_pk(f32x2 v) {
    const f32x2 av = __builtin_elementwise_abs(v), d = av * 0.2316418882f + 1.0f;
    f32x2 t; t.x = __builtin_amdgcn_rcpf(d.x); t.y = __builtin_amdgcn_rcpf(d.y);
    f32x2 q = t * 0.5307027145f + (-0.7265760135f); q = q * t + 0.7107068705f; q = q * t + (-0.142248368f); q = q * t + 0.127414796f; q = q * t;
    const f32x2 s = (v * v) * (-0.72134752044f);
    f32x2 e; e.x = __builtin_amdgcn_exp2f(s.x); e.y = __builtin_amdgcn_exp2f(s.y);
    const f32x2 m = v * (q * e), r = v - m;
    f32x2 o; o.x = v.x < 0.f ? m.x : r.x; o.y = v.y < 0.f ? m.y : r.y; return o;
}

template <int ACT  > struct EpiBf16 {
    static constexpr bool PERM = true, AFTER_DRAIN = false; static_assert(ACT == 0 || ACT == 1, "EpiBf16: ACT is 0 (none) or 1 (gelu_pk)");
    bf16_t* O; int ldc; const float* bias; int split_cols; size_t split_stride; float scale0;
    __device__ __forceinline__ void operator()(const f32x4 (&acc)[2][2][4][2], const Unit& u, int wr, int wc, int fr, int fq) const {
        const int row0 = u.pm * BM + wr * 64 + fr; int colt = u.pn * BM; bf16_t* base = O;
        float sc = 1.f; if (split_cols) { const int t = colt / split_cols; base += (size_t)t * split_stride; colt -= t * split_cols; if (t == 0) sc = scale0; }
        const int col0 = colt + wc * 32 + 8 * fq, bcol0 = u.pn * BM + wc * 32 + 8 * fq;
        f32x4 bv[2][2];
#pragma unroll
        for (int bj = 0; bj < 2; ++bj)
#pragma unroll
            for (int n = 0; n < 2; ++n) bv[bj][n] = bias ? *(const f32x4*)(bias + bcol0 + bj * HALF + 4 * n) : (f32x4){0.f, 0.f, 0.f, 0.f};
#pragma unroll
        for (int ai = 0; ai < 2; ++ai)
#pragma unroll
            for (int m = 0; m < 4; ++m) { bf16_t* rowp = base + (size_t)(row0 + ai * HALF + m * 16) * ldc + col0;
#pragma unroll
                for (int bj = 0; bj < 2; ++bj) { f32x4 v0 = acc[ai][bj][m][0] + bv[bj][0], v1 = acc[ai][bj][m][1] + bv[bj][1];
                    if (ACT == 1) { f32x2 a = gelu_pk((f32x2){v0[0], v0[1]}), b = gelu_pk((f32x2){v0[2], v0[3]}), c = gelu_pk((f32x2){v1[0], v1[1]}), d = gelu_pk((f32x2){v1[2], v1[3]});
                        v0 = (f32x4){a.x, a.y, b.x, b.y}; v1 = (f32x4){c.x, c.y, d.x, d.y}; }
                    v0 = v0 * sc; v1 = v1 * sc; u32x4 w; w.x = cvt_pk_bf16(v0[0], v0[1]); w.y = cvt_pk_bf16(v0[2], v0[3]); w.z = cvt_pk_bf16(v1[0], v1[1]); w.w = cvt_pk_bf16(v1[2], v1[3]);
                    __builtin_nontemporal_store(w, (u32x4*)(rowp + bj * HALF)); } }
    }
};

struct EpiResF32 {
    static constexpr bool PERM = false, AFTER_DRAIN = false;
    float* C; const float* R; int ldc;
    __device__ __forceinline__ void operator()(const f32x4 (&acc)[2][2][4][2], const Unit& u, int wr, int wc, int fr, int fq) const {
        const int row0 = u.pm * BM + wr * 64 + fr, col0 = u.pn * BM + wc * 32 + 4 * fq;
#pragma unroll
        for (int ai = 0; ai < 2; ++ai)
#pragma unroll
            for (int m = 0; m < 4; ++m) { const size_t off = (size_t)(row0 + ai * HALF + m * 16) * ldc + col0;
#pragma unroll
                for (int bj = 0; bj < 2; ++bj)
#pragma unroll
                    for (int n = 0; n < 2; ++n) { f32x4 r = (f32x4){0.f, 0.f, 0.f, 0.f}; if (R) r = *(const f32x4*)(R + off + bj * HALF + n * 16);
                        __builtin_nontemporal_store(acc[ai][bj][m][n] + r, (f32x4*)(C + off + bj * HALF + n * 16)); }
                asm volatile("" ::: "memory"); }
    }
};
struct EpiResBf16 {
    static constexpr bool PERM = true, AFTER_DRAIN = false;
    bf16_t* O; const float* R; int ldc;
    __device__ __forceinline__ void operator()(const f32x4 (&acc)[2][2][4][2], const Unit& u, int wr, int wc, int fr, int fq) const {
        const int row0 = u.pm * BM + wr * 64 + fr, col0 = u.pn * BM + wc * 32 + 8 * fq;
#pragma unroll
        for (int ai = 0; ai < 2; ++ai)
#pragma unroll
            for (int m = 0; m < 4; ++m) { const size_t off = (size_t)(row0 + ai * HALF + m * 16) * ldc + col0;
#pragma unroll
                for (int bj = 0; bj < 2; ++bj) { const f32x4 r0 = __builtin_nontemporal_load((const f32x4*)(R + off + bj * HALF)), r1 = __builtin_nontemporal_load((const f32x4*)(R + off + bj * HALF + 4));
                    const f32x4 v0 = acc[ai][bj][m][0] + r0, v1 = acc[ai][bj][m][1] + r1;
                    u32x4 w; w.x = cvt_pk_bf16(v0[0], v0[1]); w.y = cvt_pk_bf16(v0[2], v0[3]); w.z = cvt_pk_bf16(v1[0], v1[1]); w.w = cvt_pk_bf16(v1[2], v1[3]);
                    __builtin_nontemporal_store(w, (u32x4*)(O + off + bj * HALF)); }
                asm volatile("" ::: "memory"); }
    }
};
struct EpiProj {
    static constexpr bool PERM = true, AFTER_DRAIN = false;
    bf16_t* O; int ldc, ch_tile0, ch_tiles, u_col0;
    __device__ __forceinline__ void operator()(const f32x4 (&acc)[2][2][4][2], const Unit& u, int wr, int wc, int fr, int fq) const {
        const int row0 = u.pm * BM + wr * 64 + fr, cin = wc * 32 + 8 * fq;
        const bool chv = u.pn >= ch_tile0 && u.pn < ch_tile0 + ch_tiles;
        if (chv) { const int col0 = u_col0 + (u.pn - ch_tile0) * HALF + cin;
#pragma unroll
            for (int ai = 0; ai < 2; ++ai)
#pragma unroll
                for (int m = 0; m < 4; ++m) { const f32x4 v0 = acc[ai][0][m][0] * acc[ai][1][m][0], v1 = acc[ai][0][m][1] * acc[ai][1][m][1];
                    u32x4 w; w.x = cvt_pk_bf16(v0[0], v0[1]); w.y = cvt_pk_bf16(v0[2], v0[3]); w.z = cvt_pk_bf16(v1[0], v1[1]); w.w = cvt_pk_bf16(v1[2], v1[3]);
                    __builtin_nontemporal_store(w, (u32x4*)(O + (size_t)(row0 + ai * HALF + m * 16) * ldc + col0)); }
        } else { const int col0 = (u.pn >= ch_tile0 + ch_tiles ? u.pn - ch_tiles / 2 : u.pn) * BM + cin;
#pragma unroll
            for (int ai = 0; ai < 2; ++ai)
#pragma unroll
                for (int m = 0; m < 4; ++m) { bf16_t* rowp = O + (size_t)(row0 + ai * HALF + m * 16) * ldc + col0;
#pragma unroll
                    for (int bj = 0; bj < 2; ++bj) { const f32x4 v0 = acc[ai][bj][m][0], v1 = acc[ai][bj][m][1];
                        u32x4 w; w.x = cvt_pk_bf16(v0[0], v0[1]); w.y = cvt_pk_bf16(v0[2], v0[3]); w.z = cvt_pk_bf16(v1[0], v1[1]); w.w = cvt_pk_bf16(v1[2], v1[3]);
                        __builtin_nontemporal_store(w, (u32x4*)(rowp + bj * HALF)); } }
        }
    }
};
struct EpiRowScaleF32 {
    static constexpr bool PERM = false, AFTER_DRAIN = false;
    float* C; const float* rowscale; int ldc;
    __device__ __forceinline__ void operator()(const f32x4 (&acc)[2][2][4][2], const Unit& u, int wr, int wc, int fr, int fq) const {
        const int row0 = u.pm * BM + wr * 64 + fr, col0 = u.pn * BM + wc * 32 + 4 * fq;
#pragma unroll
        for (int ai = 0; ai < 2; ++ai)
#pragma unroll
            for (int m = 0; m < 4; ++m) { const int row = row0 + ai * HALF + m * 16; const float rsv = rowscale[row]; const size_t off = (size_t)row * ldc + col0;
#pragma unroll
                for (int bj = 0; bj < 2; ++bj)
#pragma unroll
                    for (int n = 0; n < 2; ++n) __builtin_nontemporal_store(acc[ai][bj][m][n] * rsv, (f32x4*)(C + off + bj * HALF + n * 16)); }
    }
};
template <class Epi, class Sched, bool ALIGN_EPI = false, bool SP2 = false>
__device__ __forceinline__ void gemm_phase(PG8_LAS unsigned char* lds, const Gemm g, const Sched& S, const Epi& E) {
    const int tid = threadIdx.x, wid = __builtin_amdgcn_readfirstlane(tid >> 6), lane = tid & 63, wr = wid >> 2, wc = wid & 3, fr = lane & 15, fq = lane >> 4;
    const int K = g.K, nt = K / BK;
    unsigned voffA[2], voffB[2];
#pragma unroll
    for (int i = 0; i < 2; ++i) { int R, C; stage_rc(tid * 16 + i * 8192, R, C); const int Rb = Epi::PERM ? ((R & ~31) + perm32(R & 31)) : R;
        voffA[i] = (unsigned)(R * K + C) * 2u; voffB[i] = (unsigned)(Rb * K + C) * 2u; }
    const size_t kstep = (size_t)(BK * 2);
    const size_t hstep = (size_t)HALF * K * 2;
    const size_t tstep = 2 * hstep;
    const unsigned ldsw = (unsigned)wid * 1024u;
    const int aoff = lds_byte(wr * 64 + fr, fq * 8), boff = lds_byte(wc * 32 + fr, fq * 8);
#define PG8_SA(b, h) (((b) * 2 + (h)) * HTB)
#define PG8_SB(b, h) ((4 + (b) * 2 + (h)) * HTB)
#define PG8_STAGE(bufoff, gbase, voff) do { _Pragma("unroll") for (int _i = 0; _i < 2; ++_i) \
        __builtin_amdgcn_global_load_lds((const unsigned*)((const char*)(gbase) + (voff)[_i]), (PG8_LAS unsigned*)(lds + (bufoff) + ldsw + _i * 8192), 16, 0, 0); } while (0)
#define PG8_LDA(dst, b, h) do { _Pragma("unroll") for (int m = 0; m < 4; ++m) _Pragma("unroll") for (int k = 0; k < 2; ++k) dst[m][k] = *(const PG8_LAS bf16x8*)(lds + PG8_SA(b, h) + aoff + m * 2048 + k * 1024); } while (0)
#define PG8_LDB(dst, b, h) do { _Pragma("unroll") for (int n = 0; n < 2; ++n) _Pragma("unroll") for (int k = 0; k < 2; ++k) dst[n][k] = *(const PG8_LAS bf16x8*)(lds + PG8_SB(b, h) + boff + n * 2048 + k * 1024); } while (0)
#define PG8_MMA(ai, bj, At, Bt) do { __builtin_amdgcn_s_setprio(1); _Pragma("unroll") for (int m = 0; m < 4; ++m) _Pragma("unroll") for (int n = 0; n < 2; ++n) _Pragma("unroll") for (int k = 0; k < 2; ++k) \
        acc[ai][bj][m][n] = __builtin_amdgcn_mfma_f32_16x16x32_bf16(Bt[n][k], At[m][k], acc[ai][bj][m][n], 0, 0, 0); __builtin_amdgcn_s_setprio(0); } while (0)
#define PG8_WAIT_V(n) asm volatile("s_waitcnt vmcnt(" #n ")" ::: "memory")
#define PG8_WAIT_L(n) asm volatile("s_waitcnt lgkmcnt(" #n ")" ::: "memory")
#define PG8_BAR __builtin_amdgcn_s_barrier()
#define PG8_SCHED __builtin_amdgcn_sched_barrier(0)
    Unit cur, nxt; int ui = 0;
    if (!S.next(0, cur)) return;
    f32x4 acc[2][2][4][2];
#pragma unroll
    for (int a = 0; a < 2; ++a)
#pragma unroll
        for (int b = 0; b < 2; ++b)
#pragma unroll
            for (int m = 0; m < 4; ++m)
#pragma unroll
                for (int n = 0; n < 2; ++n) acc[a][b][m][n] = (f32x4){0.f, 0.f, 0.f, 0.f};
    bf16x8 At[4][2], B0[2][2], B1[2][2];
    const char* cA = (const char*)g.A + (size_t)cur.pm * tstep; const char* cB = (const char*)g.Bt + (size_t)cur.pn * tstep;
    S.a_ready(cur);
    if constexpr (SP2) {
        PG8_STAGE(PG8_SB(0, 0), cB, voffB); PG8_STAGE(PG8_SB(0, 1), cB + hstep, voffB); PG8_STAGE(PG8_SA(0, 0), cA, voffA); PG8_STAGE(PG8_SA(0, 1), cA + hstep, voffA);
        if (wr == 1) PG8_BAR;
        PG8_WAIT_V(2); PG8_BAR;
        PG8_STAGE(PG8_SB(1, 0), cB + kstep, voffB); PG8_STAGE(PG8_SA(1, 0), cA + kstep, voffA); PG8_STAGE(PG8_SB(1, 1), cB + hstep + kstep, voffB);
        PG8_WAIT_V(6); PG8_BAR;
    } else {
        PG8_STAGE(PG8_SB(0, 0), cB, voffB); PG8_STAGE(PG8_SA(0, 0), cA, voffA); PG8_STAGE(PG8_SB(0, 1), cB + hstep, voffB); PG8_STAGE(PG8_SA(0, 1), cA + hstep, voffA);
        if (wr == 1) PG8_BAR;
        PG8_WAIT_V(4); PG8_BAR;
        PG8_STAGE(PG8_SB(1, 0), cB + kstep, voffB); PG8_STAGE(PG8_SA(1, 0), cA + kstep, voffA); PG8_STAGE(PG8_SB(1, 1), cB + hstep + kstep, voffB);
        PG8_WAIT_V(6); PG8_BAR;
    }
    for (;;) {
        const bool has_next = S.next(ui + 1, nxt);
        const char* nA = has_next ? (const char*)g.A + (size_t)nxt.pm * tstep : cA; const char* nB = has_next ? (const char*)g.Bt + (size_t)nxt.pn * tstep : cB;
        for (int t = 0; t < nt; t += 2) {
            const bool last = (t == nt - 2);
            const char* a1 = cA + (size_t)(t + 1) * kstep;
            const char* a2 = last ? nA : cA + (size_t)(t + 2) * kstep; const char* b2 = last ? nB : cB + (size_t)(t + 2) * kstep;
            const char* a3 = a2 + kstep; const char* b3 = b2 + kstep;
            if (last && has_next) S.a_ready(nxt);
            if constexpr (SP2) {
            PG8_LDB(B0, 0, 0); PG8_LDB(B1, 0, 1); PG8_SCHED; PG8_LDA(At, 0, 0); PG8_STAGE(PG8_SA(1, 1), a1 + hstep, voffA);
            PG8_WAIT_V(8); PG8_WAIT_L(0); PG8_BAR; PG8_MMA(0, 0, At, B0); PG8_MMA(0, 1, At, B1); PG8_BAR; PG8_SCHED;
            PG8_LDA(At, 0, 1); PG8_STAGE(PG8_SB(0, 0), b2, voffB); PG8_STAGE(PG8_SB(0, 1), b2 + hstep, voffB); PG8_STAGE(PG8_SA(0, 0), a2, voffA);
            PG8_WAIT_V(8); PG8_WAIT_L(0); PG8_BAR; PG8_MMA(1, 0, At, B0); PG8_MMA(1, 1, At, B1); PG8_BAR; PG8_SCHED;
            PG8_LDB(B0, 1, 0); PG8_LDB(B1, 1, 1); PG8_SCHED; PG8_LDA(At, 1, 0); PG8_STAGE(PG8_SA(0, 1), a2 + hstep, voffA);
            PG8_WAIT_V(8); PG8_WAIT_L(0); PG8_BAR; PG8_MMA(0, 0, At, B0); PG8_MMA(0, 1, At, B1); PG8_BAR; PG8_SCHED;
            PG8_LDA(At, 1, 1); PG8_STAGE(PG8_SB(1, 0), b3, voffB); PG8_STAGE(PG8_SB(1, 1), b3 + hstep, voffB); PG8_STAGE(PG8_SA(1, 0), a3, voffA);
            PG8_WAIT_V(8); PG8_WAIT_L(0); PG8_BAR; PG8_MMA(1, 0, At, B0); PG8_MMA(1, 1, At, B1); PG8_BAR; PG8_SCHED;
            } else {
            PG8_LDB(B0, 0, 0); PG8_SCHED; PG8_LDA(At, 0, 0); PG8_STAGE(PG8_SA(1, 1), a1 + hstep, voffA);
            PG8_WAIT_L(8); PG8_BAR; PG8_WAIT_L(0); PG8_MMA(0, 0, At, B0); PG8_BAR; PG8_SCHED;
            PG8_LDB(B1, 0, 1); PG8_STAGE(PG8_SB(0, 0), b2, voffB);
            PG8_BAR; PG8_WAIT_L(0); PG8_MMA(0, 1, At, B1); PG8_BAR;
            PG8_LDA(At, 0, 1); PG8_STAGE(PG8_SA(0, 0), a2, voffA);
            PG8_BAR; PG8_WAIT_L(0); PG8_MMA(1, 0, At, B0); PG8_BAR; PG8_SCHED;
            PG8_STAGE(PG8_SB(0, 1), b2 + hstep, voffB);
            PG8_WAIT_V(6); PG8_BAR; PG8_MMA(1, 1, At, B1); PG8_BAR;
            PG8_LDB(B0, 1, 0); PG8_SCHED; PG8_LDA(At, 1, 0); PG8_STAGE(PG8_SA(0, 1), a2 + hstep, voffA);
            PG8_WAIT_L(8); PG8_BAR; PG8_WAIT_L(0); PG8_MMA(0, 0, At, B0); PG8_BAR; PG8_SCHED;
            PG8_LDB(B1, 1, 1); PG8_STAGE(PG8_SB(1, 0), b3, voffB);
            PG8_BAR; PG8_WAIT_L(0); PG8_MMA(0, 1, At, B1); PG8_BAR;
            PG8_LDA(At, 1, 1); PG8_STAGE(PG8_SA(1, 0), a3, voffA);
            PG8_BAR; PG8_WAIT_L(0); PG8_MMA(1, 0, At, B0); PG8_BAR; PG8_SCHED;
            PG8_STAGE(PG8_SB(1, 1), b3 + hstep, voffB);
            PG8_WAIT_V(6); PG8_BAR; PG8_MMA(1, 1, At, B1); PG8_BAR;
            }
        }
        if constexpr (ALIGN_EPI) { if (wr == 0) PG8_BAR; }
        if constexpr (!Epi::AFTER_DRAIN) { E(acc, cur, wr, wc, fr, fq); S.done(cur); }
        if (!has_next) break;
#pragma unroll
        for (int a = 0; a < 2; ++a)
#pragma unroll
            for (int b = 0; b < 2; ++b)
#pragma unroll
                for (int m = 0; m < 4; ++m)
#pragma unroll
                    for (int n = 0; n < 2; ++n) acc[a][b][m][n] = (f32x4){0.f, 0.f, 0.f, 0.f};
        cur = nxt; cA = nA; cB = nB; ++ui;
        if constexpr (ALIGN_EPI) { if (wr == 1) PG8_BAR; }
    }
    PG8_WAIT_V(0);
    if constexpr (!ALIGN_EPI) { if (wr == 0) PG8_BAR; }
    PG8_BAR;
    if constexpr (Epi::AFTER_DRAIN) { E.fused(acc, cur, wr, wc, fr, fq, lds, wid, lane); S.done(cur); }
#undef PG8_SA
#undef PG8_SB
#undef PG8_STAGE
#undef PG8_LDA
#undef PG8_LDB
#undef PG8_MMA
#undef PG8_WAIT_V
#undef PG8_WAIT_L
#undef PG8_BAR
#undef PG8_SCHED
}
}
#ifndef PG8_SP2
#define PG8_SP2 true
#endif
#ifndef PG8_ALIGN
#define PG8_ALIGN true
#endif

constexpr int NWAVES = 8;
#ifndef MK_N_LAUNCHES
#define MK_N_LAUNCHES 1
#endif
constexpr int NPHASE = 9;
constexpr int N_LAUNCHES = MK_N_LAUNCHES;

constexpr int NB = 4, SEQ = 4096, M = NB * SEQ, D = 4096;
constexpr int D_SSD = 4096, D_CONV = 4096, D_MIX = 8192, NH = 64, HD = 64, NG = 8, NS = 128, D_XBC = 6144;
constexpr int NPROJ = 22592, NP = 22784, PP = NP - 4096;
constexpr int O_Z = 0, O_X = 4096, O_B = 8192, O_C = 9216, O_CH = 10240, O_U = 10240, R_SCB = 18432, R_DT = 22528, O_SCB = R_SCB - 4096, O_DT = R_DT - 4096, CH_TILE0 = O_CH / 256, CH_TILES = 32;
constexpr int SRC_DT = 10240, SRC_SCB = 10304, SRC_SCC = 14400, SRC_SCH = 18496;
__host__ __device__ constexpr int win_row_of_src_col(int n) {
    return n < SRC_DT ? n : n < SRC_SCB ? R_DT + (n - SRC_DT) : n < SRC_SCC ? R_SCB + (n - SRC_SCB)
         : n < SRC_SCH ? O_CH + ((n - SRC_SCC) >> 7) * 256 + ((n - SRC_SCC) & 127) : O_CH + ((n - SRC_SCH) >> 7) * 256 + 128 + ((n - SRC_SCH) & 127); }
constexpr int PH = 8, PK = 128, PTOP = 16, PQ = 2048, NEXP = 16384, HK = 128;
constexpr float EPS = 1e-6f;

constexpr size_t MiB = 1u << 20;
constexpr size_t WS_CTL = 0, CTL_ZERO_BYTES = 1 * MiB;
constexpr size_t WS_XN = 1 * MiB;
constexpr size_t WS_WIN = 129 * MiB;
constexpr size_t WS_WOUT = 307 * MiB;
constexpr size_t WS_WQ = 371 * MiB;
constexpr size_t WS_CONV = 1 * MiB;
constexpr size_t WS_Y = 387 * MiB;
constexpr size_t WS_PROJ = 643 * MiB;
constexpr size_t WS_U8 = 1227 * MiB;
constexpr size_t WS_V8 = 1291 * MiB;
constexpr size_t WS_SU = 1376 * MiB, WS_SV = 1376 * MiB + 65536;
constexpr size_t WS_XQ = 772 * MiB, WS_XS = 836 * MiB;
constexpr size_t WS_Q = 899 * MiB;
constexpr size_t WS_HB = 1027 * MiB;
constexpr size_t WS_SSQ = 1355 * MiB;
constexpr size_t WS_KH = 1359 * MiB;
constexpr size_t WS_IDX = 1360 * MiB;
constexpr size_t WS_GATE = 1368 * MiB;
constexpr size_t WS_END = 1377 * MiB;
static_assert(WS_WIN + (size_t)NP * D * 2 <= WS_WOUT && WS_Y + (size_t)M * D_MIX * 2 <= WS_PROJ && WS_PROJ + (size_t)M * PP * 2 <= WS_U8 && WS_V8 + (size_t)NEXP * D <= WS_SSQ && WS_Q + (size_t)M * PQ * 4 <= WS_SSQ, "d_ws map");
constexpr int CW_TMO = 0, CW_CODE = 1, CW_TICKET = 64;
constexpr int CW_BAR = 4096;

constexpr int RING_OFF = 0, RING_BYTES = 131072;
constexpr int LDSCTL_OFF = RING_BYTES, MISC_OFF = LDSCTL_OFF + 320;
constexpr int LDS_BYTES = 147456;
static_assert(MISC_OFF + 128 <= LDS_BYTES, "LDS map");

#define GAS __attribute__((address_space(1)))
#define LAS __attribute__((address_space(3)))
typedef unsigned short bf16;
typedef unsigned v4u __attribute__((ext_vector_type(4)));
typedef float f32x4 __attribute__((ext_vector_type(4)));
typedef short bf16x8 __attribute__((ext_vector_type(8)));
typedef GAS unsigned gu32;
typedef GAS unsigned long long gu64;
#define RLX_AGENT __ATOMIC_RELAXED, __HIP_MEMORY_SCOPE_AGENT
#define LDS_WAIT() asm volatile("s_waitcnt lgkmcnt(0)" ::: "memory")
#define VM_WAIT() asm volatile("s_waitcnt vmcnt(0)" ::: "memory")
__device__ __forceinline__ unsigned long long rt() { return __builtin_amdgcn_s_memrealtime(); }
__device__ __forceinline__ unsigned f2bf(float f) { unsigned u = __builtin_bit_cast(unsigned, f); return (u + 0x7fffu + ((u >> 16) & 1u)) >> 16; }
__device__ __forceinline__ unsigned pk2(float lo, float hi) { return f2bf(lo) | (f2bf(hi) << 16); }


#define XB_TMO      128
#define XB_XCNT(j)  (256  + 64 * (j))
#define XB_XSUB(j)  (1280 + 64 * (j))
#define XB_XGEN(j)  (2304 + 64 * (j))
#define XB_TOP      3328
#define XB_TOPGEN   3392
#define XCD_BAR_WORDS 3456
#define XB_SPIN_CAP (1u << 18)

__device__ __forceinline__ unsigned xb_ld(unsigned* p)              { return __hip_atomic_load(p, __ATOMIC_RELAXED, __HIP_MEMORY_SCOPE_AGENT); }
__device__ __forceinline__ unsigned xb_add(unsigned* p, unsigned v) { return __hip_atomic_fetch_add(p, v, __ATOMIC_RELAXED, __HIP_MEMORY_SCOPE_AGENT); }
__device__ __forceinline__ unsigned xb_xcc_id() { return (unsigned)__builtin_amdgcn_s_getreg((3 << 11) | 20) & 0xFu; }
#define XB_SPIN(cond, bar) do { unsigned _sp = 0; while (cond) { __builtin_amdgcn_s_sleep(1); \
    if ((++_sp & 255u) == 0u) { if (xb_ld(&(bar)[XB_TMO])) break; if (_sp > XB_SPIN_CAP) { atomicAdd(&(bar)[XB_TMO], 1u); break; } } } } while (0)

struct XcdBarrier {
    unsigned* bar; unsigned x;
    volatile LAS unsigned* st;
};

__device__ __forceinline__ XcdBarrier xcd_barrier_post(unsigned* bar, volatile LAS unsigned* st) {
    XcdBarrier b; b.bar = bar; b.x = xb_xcc_id(); b.st = st;
    if (threadIdx.x == 0) (void)xb_add(&bar[XB_XCNT(b.x)], 1u);
    return b;
}
__device__ __forceinline__ void xcd_barrier_complete(unsigned* bar, unsigned x, unsigned& nloc, unsigned& nx) {
    const unsigned G = gridDim.x * gridDim.y * gridDim.z;
    unsigned sum, cnt, mine, sp = 0u;
    for (;;) {
        sum = 0u; cnt = 0u; mine = 0u;
#pragma unroll
        for (unsigned j = 0; j < 16; ++j) { const unsigned c = xb_ld(&bar[XB_XCNT(j)]); sum += c; cnt += (c > 0u) ? 1u : 0u; mine = (j == x) ? c : mine; }
        if (sum == G) break;
        __builtin_amdgcn_s_sleep(1);
        if ((++sp & 255u) == 0u) { if (xb_ld(&bar[XB_TMO])) break; if (sp > XB_SPIN_CAP) { atomicAdd(&bar[XB_TMO], 1u); break; } }
    }
    nloc = mine > 0u ? mine : 1u; nx = cnt > 0u ? cnt : 1u;
}

__device__ __forceinline__ void xcd_barrier(const XcdBarrier& b) {
    asm volatile("s_waitcnt vmcnt(0)" ::: "memory");
    __syncthreads();
    if (threadIdx.x == 0) {
        unsigned* bar = b.bar;
        __builtin_amdgcn_s_waitcnt(0);
        unsigned nloc = b.st[0], nx = b.st[1];
        if (nloc == 0u) { xcd_barrier_complete(bar, b.x, nloc, nx); b.st[0] = nloc; b.st[1] = nx; }
        const unsigned old = xb_add(&bar[XB_XSUB(b.x)], 1u);
        const unsigned gen = old / nloc;
        if (old + 1u == (gen + 1u) * nloc) {
            __builtin_amdgcn_fence(__ATOMIC_RELEASE, "agent");
            asm volatile("s_waitcnt vmcnt(0)" ::: "memory");
            const unsigned og = xb_add(&bar[XB_TOP], 1u);
            const unsigned tg = og / nx;
            if (og + 1u == (tg + 1u) * nx) xb_add(&bar[XB_TOPGEN], 1u);
            else XB_SPIN(xb_ld(&bar[XB_TOPGEN]) == tg, bar);
            __builtin_amdgcn_fence(__ATOMIC_ACQUIRE, "agent");
            xb_add(&bar[XB_XGEN(b.x)], 1u);
            asm volatile("s_waitcnt vmcnt(0)" ::: "memory");
        } else {
            XB_SPIN(xb_ld(&bar[XB_XGEN(b.x)]) == gen, bar);
            __builtin_amdgcn_fence(__ATOMIC_ACQUIRE, "agent");
            asm volatile("s_waitcnt vmcnt(0)" ::: "memory");
        }
    }
    __syncthreads();
}


#ifndef PROBE_REP
#define PROBE_REP 0
#endif
#define NREP(k) (1 + (((PROBE_REP) >> (k)) & 1))
typedef unsigned u32x4 __attribute__((ext_vector_type(4)));
typedef unsigned u32x2 __attribute__((ext_vector_type(2)));
typedef float f32x2 __attribute__((ext_vector_type(2)));
typedef __bf16 bf2_t __attribute__((ext_vector_type(2)));

__device__ __forceinline__ float wave_sum(float v) {
#pragma unroll
    for (int o = 1; o < 64; o <<= 1) v += __shfl_xor(v, o);
    return v;
}
__device__ __forceinline__ unsigned cvtpk(float lo, float hi) { unsigned r; asm volatile("v_cvt_pk_bf16_f32 %0, %1, %2" : "=v"(r) : "v"(lo), "v"(hi)); return r; }
__device__ __forceinline__ float bflo(unsigned w) { return __uint_as_float(w << 16); }
__device__ __forceinline__ float bfhi(unsigned w) { return __uint_as_float(w & 0xffff0000u); }
__device__ __forceinline__ float siluf(float x) { return x * __builtin_amdgcn_rcpf(1.0f + __expf(-x)); }
__device__ __forceinline__ float dot2bf(unsigned a, unsigned b, float c) { return __builtin_amdgcn_fdot2_f32_bf16(__builtin_bit_cast(bf2_t, a), __builtin_bit_cast(bf2_t, b), c, false); }

__device__ __forceinline__ void p0_transpose_item(const float* W, int K, int N, bf16* WT, bool remap, const float* kgain, LAS float* scr, int item, int lane) {
    const int nblk = N / 32, kb = item / nblk, nb = item % nblk, k0 = 64 * kb, n0 = 32 * nb, d0 = remap ? win_row_of_src_col(n0) : n0;
#pragma unroll 8
    for (int i = 0; i < 32; ++i) { const int kk = 2 * i + (lane >> 5); scr[kk * 33 + (lane & 31)] = __builtin_nontemporal_load((const GAS float*)W + ((size_t)(k0 + kk) * N + n0 + (lane & 31))) * (kgain ? kgain[k0 + kk] : 1.0f); }
    LDS_WAIT(); asm volatile("" ::: "memory");
    const int c = lane & 7;
#pragma unroll
    for (int j = 0; j < 4; ++j) { const int n = (lane >> 3) + 8 * j; const LAS float* s = scr + (8 * c) * 33 + n;
        v4u o; o.x = pk2(s[0 * 33], s[1 * 33]); o.y = pk2(s[2 * 33], s[3 * 33]); o.z = pk2(s[4 * 33], s[5 * 33]); o.w = pk2(s[6 * 33], s[7 * 33]);
        *(GAS v4u*)(WT + (size_t)(d0 + n) * K + k0 + 8 * c) = o; }
    LDS_WAIT(); asm volatile("" ::: "memory");
}
__device__ __forceinline__ void rms_row_to_bf16(const float* xrow, const float* w, bf16* orow, int lane) {
    const GAS f32x4* xr = (const GAS f32x4*)xrow + lane;
    f32x4 v[16]; float s = 0.f;
#pragma unroll
    for (int j = 0; j < 16; ++j) { v[j] = __builtin_nontemporal_load(xr + 64 * j); s += (v[j].x * v[j].x + v[j].y * v[j].y) + (v[j].z * v[j].z + v[j].w * v[j].w); }
    const float rs = 1.0f / sqrtf(wave_sum(s) * (1.f / D) + EPS);
    const GAS f32x4* wr = (const GAS f32x4*)w + lane;
    GAS u32x2* o8 = (GAS u32x2*)orow + lane;
#pragma unroll
    for (int j = 0; j < 16; ++j) { const f32x4 g = wr[64 * j]; u32x2 o; o.x = cvtpk(v[j].x * rs * g.x, v[j].y * rs * g.y); o.y = cvtpk(v[j].z * rs * g.z, v[j].w * rs * g.w); o8[64 * j] = o; }
}

__device__ __forceinline__ void unpack8(const u32x4 v, float (&f)[8]) { f[0] = bflo(v.x); f[1] = bfhi(v.x); f[2] = bflo(v.y); f[3] = bfhi(v.y); f[4] = bflo(v.z); f[5] = bfhi(v.z); f[6] = bflo(v.w); f[7] = bfhi(v.w); }
__device__ __forceinline__ unsigned pack_i8x4(float a, float b, float c, float d) {
    const int ia = __float2int_rn(a), ib = __float2int_rn(b), ic = __float2int_rn(c), id = __float2int_rn(d);
    return ((unsigned)ia & 0xffu) | (((unsigned)ib & 0xffu) << 8) | (((unsigned)ic & 0xffu) << 16) | ((unsigned)id << 24);
}
__device__ __forceinline__ void rms_row_to_bf16_i8(const bf16* hrow, const float* w, float* rsout, unsigned char* qrow, float* qscale, int lane) {
    const GAS u32x4* hr = (const GAS u32x4*)hrow + lane;
    float v[8][8]; float s = 0.f;
#pragma unroll
    for (int j = 0; j < 8; ++j) { const u32x4 t = hr[64 * j]; v[j][0] = bflo(t.x); v[j][1] = bfhi(t.x); v[j][2] = bflo(t.y); v[j][3] = bfhi(t.y); v[j][4] = bflo(t.z); v[j][5] = bfhi(t.z); v[j][6] = bflo(t.w); v[j][7] = bfhi(t.w);
#pragma unroll
        for (int k = 0; k < 8; ++k) s += v[j][k] * v[j][k]; }
    const float rs = 1.0f / sqrtf(wave_sum(s) * (1.f / D) + EPS);
    float am = 0.f; if (lane == 0) *rsout = rs;
#pragma unroll
    for (int j = 0; j < 8; ++j) { const GAS f32x4* wp = (const GAS f32x4*)(w + (j * 64 + lane) * 8); const f32x4 ga = wp[0], gb = wp[1]; const float g[8] = {ga.x, ga.y, ga.z, ga.w, gb.x, gb.y, gb.z, gb.w};
#pragma unroll
        for (int k = 0; k < 8; ++k) { v[j][k] *= rs * g[k]; am = fmaxf(am, fabsf(v[j][k])); }
        }
#pragma unroll
    for (int o = 1; o < 64; o <<= 1) am = fmaxf(am, __shfl_xor(am, o));
    const float sc = am > 0.f ? am * (1.0f / 127.0f) : 1.0f, inv = 1.0f / sc;
    GAS u32x2* q8 = (GAS u32x2*)qrow + lane;
#pragma unroll
    for (int j = 0; j < 8; ++j) { u32x2 p; p.x = pack_i8x4(v[j][0] * inv, v[j][1] * inv, v[j][2] * inv, v[j][3] * inv); p.y = pack_i8x4(v[j][4] * inv, v[j][5] * inv, v[j][6] * inv, v[j][7] * inv); q8[64 * j] = p; }
    if (lane == 0) *qscale = sc;
}

__device__ __forceinline__ u32x4 pack8(const float (&f)[8]) { u32x4 o; o.x = cvtpk(f[0], f[1]); o.y = cvtpk(f[2], f[3]); o.z = cvtpk(f[4], f[5]); o.w = cvtpk(f[6], f[7]); return o; }
__device__ __forceinline__ void conv_prepass(const bf16* PROJ, const float* conv_w, const float* conv_b, bf16* CONV, int gtid, int gthreads) {
    constexpr int NCG = D_XBC / 8, NSEG = SEQ / 16, NIT = NB * NSEG * NCG;
    int it = gtid; if (it >= NIT) return;
#define CP_ITEM(IT, CG, ROW, Z) do { const int _bs = (IT) / NCG; CG = (IT) % NCG; const int _seg = _bs % NSEG, _b = _bs / NSEG; Z = (_seg == 0); ROW = _b * SEQ + _seg * 16; } while (0)
#define CP_SRC(ROW, CG) (PROJ + (size_t)(ROW) * PP + O_X + (CG) * 8)
    int cg, row; bool z0; CP_ITEM(it, cg, row, z0); const bf16* src = CP_SRC(row, cg);
    u32x4 raw[19];
#pragma unroll
    for (int rr = 0; rr < 19; ++rr) raw[rr] = __builtin_nontemporal_load((const GAS u32x4*)(src + (ptrdiff_t)((rr >= 3 || !z0) ? rr - 3 : 0) * PP));
    for (;;) {
        const int itn = it + gthreads; const bool has_next = itn < NIT;
        int cgn = cg, rown = row; bool zn = z0; if (has_next) CP_ITEM(itn, cgn, rown, zn); const bf16* srcn = CP_SRC(rown, cgn);
        const int ch = cg * 8;
        float w[4][8], bias[8];
#pragma unroll
        for (int k = 0; k < 4; ++k) { const f32x4 wa = *(const GAS f32x4*)(conv_w + (size_t)k * D_XBC + ch), wb = *(const GAS f32x4*)(conv_w + (size_t)k * D_XBC + ch + 4);
            w[k][0] = wa.x; w[k][1] = wa.y; w[k][2] = wa.z; w[k][3] = wa.w; w[k][4] = wb.x; w[k][5] = wb.y; w[k][6] = wb.z; w[k][7] = wb.w; }
        { const f32x4 ba = *(const GAS f32x4*)(conv_b + ch), bb = *(const GAS f32x4*)(conv_b + ch + 4); bias[0] = ba.x; bias[1] = ba.y; bias[2] = ba.z; bias[3] = ba.w; bias[4] = bb.x; bias[5] = bb.y; bias[6] = bb.z; bias[7] = bb.w; }
        float win[3][8];
#pragma unroll
        for (int rr = 0; rr < 3; ++rr) { const u32x4 v = z0 ? (u32x4){0u, 0u, 0u, 0u} : raw[rr]; unpack8(v, win[rr]);
            if (has_next) raw[rr] = __builtin_nontemporal_load((const GAS u32x4*)(srcn + (ptrdiff_t)(zn ? 0 : rr - 3) * PP)); }
        bf16* dst = CONV + (size_t)row * D_XBC + ch;
#pragma unroll
        for (int i = 0; i < 16; ++i) { float cur[8], o[8]; unpack8(raw[3 + i], cur);
            if (has_next) raw[3 + i] = __builtin_nontemporal_load((const GAS u32x4*)(srcn + (ptrdiff_t)i * PP));
#pragma unroll
            for (int j = 0; j < 8; ++j) { o[j] = siluf(bias[j] + w[0][j] * win[0][j] + w[1][j] * win[1][j] + w[2][j] * win[2][j] + w[3][j] * cur[j]); win[0][j] = win[1][j]; win[1][j] = win[2][j]; win[2][j] = cur[j]; }
            *(GAS u32x4*)(dst + (size_t)i * D_XBC) = pack8(o); }
        if (!has_next) break;
        it = itn; cg = cgn; row = rown; src = srcn; z0 = zn;
    }
#undef CP_ITEM
#undef CP_SRC
}
constexpr int C_CM = 0, C_BM = 32768, C_BTW = 65536, C_XDT = 98304, C_XB = 114688, C_SM = LDSCTL_OFF + 512;
static_assert(C_XB + 16384 <= RING_BYTES && C_SM + 2 * 2048 + 2048 <= LDS_BYTES, "ssd lds");
__device__ __forceinline__ int sw256(int r, int c) { return r * 256 + ((c ^ (r & 15)) << 4); }
__device__ __forceinline__ int sw128(int r, int c) { return r * 128 + ((c ^ (r & 7)) << 4); }
__device__ __forceinline__ int swT(int r, int c) { return r * 256 + ((c ^ (((r >> 3) ^ r) & 15)) << 4); }
__device__ __forceinline__ float wave_incl_scan(float x) {
    x += __builtin_bit_cast(float, __builtin_amdgcn_update_dpp(0, __builtin_bit_cast(int, x), 0x111, 0xf, 0xf, true));
    x += __builtin_bit_cast(float, __builtin_amdgcn_update_dpp(0, __builtin_bit_cast(int, x), 0x112, 0xf, 0xf, true));
    x += __builtin_bit_cast(float, __builtin_amdgcn_update_dpp(0, __builtin_bit_cast(int, x), 0x114, 0xf, 0xf, true));
    x += __builtin_bit_cast(float, __builtin_amdgcn_update_dpp(0, __builtin_bit_cast(int, x), 0x118, 0xf, 0xf, true));
    x += __builtin_bit_cast(float, __builtin_amdgcn_update_dpp(0, __builtin_bit_cast(int, x), 0x142, 0xa, 0xf, true));
    x += __builtin_bit_cast(float, __builtin_amdgcn_update_dpp(0, __builtin_bit_cast(int, x), 0x143, 0xc, 0xf, true));
    return x;
}
__device__ __forceinline__ void ssd_dt_scan(LAS float* sm, float r0, float r1, float a_neg, int lane) {
    const float d0 = r0 > 20.f ? r0 : __logf(1.0f + __expf(r0)), d1 = r1 > 20.f ? r1 : __logf(1.0f + __expf(r1));
    const float v0 = wave_incl_scan(d0 * a_neg); float v1 = wave_incl_scan(d1 * a_neg);
    v1 += __shfl(v0, 63);
    const float aend = __shfl(v1, 63);
    sm[lane] = d0; sm[64 + lane] = d1; sm[128 + lane] = v0; sm[192 + lane] = v1;
    sm[256 + lane] = __expf(aend - v0); sm[320 + lane] = __expf(aend - v1); sm[384 + lane] = __expf(v0); sm[448 + lane] = __expf(v1);
}
__device__ __forceinline__ void ssd_unit(LAS unsigned char* lds, int b, int h, const bf16* PROJ, const bf16* CONV, const float* dt_bias, const float* a_log, const float* ssd_d,
                                         bf16* Y, float* SSQ, int tid, int wave, int lane) {
    LAS float* smb = (LAS float*)(lds + C_SM); LAS float* ssqp = smb + 1024;
    const int g = h >> 3, pb = wave & 3, th = wave >> 2;
    const float a_neg = -__expf(a_log[h]), dtb = dt_bias[h], Dh = ssd_d[h];
    const size_t rowbase = (size_t)b * SEQ;
    const GAS unsigned char* convb = (const GAS unsigned char*)CONV; const GAS unsigned char* projb = (const GAS unsigned char*)PROJ; GAS unsigned char* yb = (GAS unsigned char*)Y; GAS unsigned char* ssqb = (GAS unsigned char*)SSQ;
#define SSD_ROLES(TT, LL) \
    const bool xitem = (TT) < 128, bitem = (TT) >= 128 && (TT) < 384; \
    const int icg = xitem ? ((TT) & 7) : (((TT) - 128) & 15), its = xitem ? ((TT) >> 3) : (((TT) - 128) >> 4); \
    const unsigned toff = (unsigned)(((rowbase + its * 8) * D_XBC + (xitem ? h * 64 + icg * 8 : D_SSD + g * 128 + icg * 8)) * 2); \
    const unsigned coff = (unsigned)(((rowbase + ((TT) >> 4)) * D_XBC + D_SSD + NG * NS + g * 128 + ((TT) & 15) * 8) * 2); \
    const unsigned doff = (unsigned)(((rowbase + (LL)) * PP + O_DT + h) * 2); \
    const int r = (LL) & 15, q = (LL) >> 4;
    f32x4 ST[8];
#pragma unroll
    for (int i = 0; i < 8; ++i) ST[i] = (f32x4){0.f, 0.f, 0.f, 0.f};
    u32x4 pft[8], pfc[4]; float dr0 = 0.f, dr1 = 0.f;
#define SSD_LBAR() do { asm volatile("s_waitcnt lgkmcnt(0)" ::: "memory"); __builtin_amdgcn_s_barrier(); asm volatile("" ::: "memory"); } while (0)
#define SSD_PREFETCH(cc) do { const unsigned _ro = (unsigned)(cc) * (128u * D_XBC * 2u); \
        if (xitem || bitem) { _Pragma("unroll") for (int _i = 0; _i < 8; ++_i) pft[_i] = *(const GAS u32x4*)(convb + (toff + _ro + (unsigned)_i * (D_XBC * 2u))); } \
        _Pragma("unroll") for (int _k = 0; _k < 4; ++_k) pfc[_k] = *(const GAS u32x4*)(convb + (coff + _ro + (unsigned)_k * (32u * D_XBC * 2u))); } while (0)
#define SSD_DTLOAD(cc) do { if (wave == 0) { const unsigned _o = doff + (unsigned)(cc) * (128u * PP * 2u); \
        dr0 = __uint_as_float((unsigned)*(const GAS unsigned short*)(projb + _o) << 16) + dtb; dr1 = __uint_as_float((unsigned)*(const GAS unsigned short*)(projb + (_o + 64u * PP * 2u)) << 16) + dtb; } } while (0)
    { SSD_ROLES(tid, lane) SSD_DTLOAD(0); SSD_PREFETCH(0); (void)r; (void)q; }
    if (wave == 0) ssd_dt_scan(smb, dr0, dr1, a_neg, lane);
    for (int c = 0; c < SEQ / 128; ++c) {
        const int t0 = c * 128, cn = c + 1 < SEQ / 128 ? c + 1 : c;
        int tt = tid, ll = lane; asm volatile("" : "+v"(tt), "+v"(ll));
        SSD_ROLES(tt, ll)
        LAS float* dtv = smb + (c & 1) * 512; LAS float* acum = dtv + 128; LAS float* wend = dtv + 256; LAS float* eac = dtv + 384;
        SSD_LBAR();
        if (c > 0 && tt < 128) *(GAS float*)(ssqb + (unsigned)(((rowbase + t0 - 128 + tt) * NH + h) * 4)) = (ssqp[tt] + ssqp[128 + tt]) + (ssqp[256 + tt] + ssqp[384 + tt]);
#pragma unroll
        for (int k = 0; k < 4; ++k) *(LAS u32x4*)(lds + C_CM + sw256((tt >> 4) + 32 * k, tt & 15)) = pfc[k];
        if (xitem || bitem) {
            const LAS float* sc = xitem ? dtv : wend; const f32x4 sa = *(const LAS f32x4*)(sc + its * 8), sb2 = *(const LAS f32x4*)(sc + its * 8 + 4); const float s8[8] = {sa.x, sa.y, sa.z, sa.w, sb2.x, sb2.y, sb2.z, sb2.w};
            float o[8][8];
#pragma unroll
            for (int i = 0; i < 8; ++i) { unpack8(pft[i], o[i]);
                if (xitem) *(LAS u32x4*)(lds + C_XB + sw128(its * 8 + i, icg)) = pft[i]; else *(LAS u32x4*)(lds + C_BM + sw256(its * 8 + i, icg)) = pft[i]; }
#pragma unroll
            for (int j = 0; j < 8; ++j) { const float f[8] = {o[0][j] * s8[0], o[1][j] * s8[1], o[2][j] * s8[2], o[3][j] * s8[3], o[4][j] * s8[4], o[5][j] * s8[5], o[6][j] * s8[6], o[7][j] * s8[7]};
                *(LAS u32x4*)(lds + (xitem ? C_XDT : C_BTW) + swT(icg * 8 + j, its)) = pack8(f); }
        }
        SSD_DTLOAD(cn);
        SSD_LBAR();
        if (wave == 0) ssd_dt_scan(smb + ((c + 1) & 1) * 512, dr0, dr1, a_neg, ll);
        f32x4 cb[8];
        {   bf16x8 cfr[4];
#pragma unroll
            for (int ks = 0; ks < 4; ++ks) cfr[ks] = *(const LAS bf16x8*)(lds + C_CM + sw256(16 * wave + r, 4 * ks + q));
#pragma unroll
            for (int sp = 0; sp < 4; ++sp) { cb[2 * sp] = (f32x4){0.f, 0.f, 0.f, 0.f}; cb[2 * sp + 1] = (f32x4){0.f, 0.f, 0.f, 0.f};
                if (2 * sp <= wave) {
                    bf16x8 a0[4], a1[4];
#pragma unroll
                    for (int ks = 0; ks < 4; ++ks) { a0[ks] = *(const LAS bf16x8*)(lds + C_BM + sw256(32 * sp + r, 4 * ks + q)); a1[ks] = *(const LAS bf16x8*)(lds + C_BM + sw256(32 * sp + 16 + r, 4 * ks + q)); }
                    __builtin_amdgcn_sched_barrier(0);
#pragma unroll
                    for (int ks = 0; ks < 4; ++ks) { cb[2 * sp] = __builtin_amdgcn_mfma_f32_16x16x32_bf16(a0[ks], cfr[ks], cb[2 * sp], 0, 0, 0); cb[2 * sp + 1] = __builtin_amdgcn_mfma_f32_16x16x32_bf16(a1[ks], cfr[ks], cb[2 * sp + 1], 0, 0, 0); }
                    __builtin_amdgcn_sched_barrier(0); } } }
        SSD_LBAR();
        {   const float ac_t = acum[16 * wave + r]; const int row = 16 * wave + r;
#pragma unroll
            for (int sb = 0; sb < 8; ++sb) {
                if (sb <= wave) { const f32x4 as4 = *(const LAS f32x4*)(acum + 16 * sb + 4 * q); float m[4];
#pragma unroll
                    for (int j = 0; j < 4; ++j) { const float e = __expf(fminf(ac_t - as4[j], 0.f)); m[j] = (sb == wave && 4 * q + j > r) ? 0.f : cb[sb][j] * e; }
                    u32x2 pk; pk.x = cvtpk(m[0], m[1]); pk.y = cvtpk(m[2], m[3]);
                    *(LAS u32x2*)(lds + C_BM + row * 256 + (((2 * sb + (q >> 1)) ^ (row & 15)) << 4) + (q & 1) * 8) = pk;
                } else if (sb == wave + 1 && !(wave & 1)) {
                    *(LAS u32x2*)(lds + C_BM + row * 256 + (((2 * sb + (q >> 1)) ^ (row & 15)) << 4) + (q & 1) * 8) = (u32x2){0u, 0u}; } } }
        u32x2 zv[4];
#pragma unroll
        for (int j = 0; j < 4; ++j) zv[j] = *(const GAS u32x2*)(projb + (unsigned)(((rowbase + t0 + 16 * (4 * th + j) + r) * PP + O_Z + h * 64 + 16 * pb + 4 * q) * 2));
        SSD_PREFETCH(cn);
        SSD_LBAR();
        bf16x8 xfr[4], sfr[4];
#pragma unroll
        for (int ks = 0; ks < 4; ++ks) { xfr[ks] = *(const LAS bf16x8*)(lds + C_XDT + swT(16 * pb + r, 4 * ks + q));
            sfr[ks] = __builtin_bit_cast(bf16x8, (u32x4){cvtpk(ST[2 * ks][0], ST[2 * ks][1]), cvtpk(ST[2 * ks][2], ST[2 * ks][3]), cvtpk(ST[2 * ks + 1][0], ST[2 * ks + 1][1]), cvtpk(ST[2 * ks + 1][2], ST[2 * ks + 1][3])}); }
#pragma unroll
        for (int j = 0; j < 4; ++j) {
            const int tb = 4 * th + j, trow = 16 * tb + r; const size_t grow = rowbase + t0 + trow; const int p0 = 16 * pb + 4 * q;
            f32x4 ad = (f32x4){0.f, 0.f, 0.f, 0.f}, ao = (f32x4){0.f, 0.f, 0.f, 0.f};
            bf16x8 mmf[4]; u32x2 clo[4], chi[4];
            {   const int cbase = C_CM + trow * 256 + (q & 1) * 8;
#pragma unroll
                for (int ks = 0; ks < 4; ++ks) { mmf[ks] = *(const LAS bf16x8*)(lds + C_BM + sw256(trow, 4 * ks + q));
                    clo[ks] = *(const LAS u32x2*)(lds + cbase + (((4 * ks + (q >> 1)) ^ (trow & 15)) << 4)); chi[ks] = *(const LAS u32x2*)(lds + cbase + (((4 * ks + 2 + (q >> 1)) ^ (trow & 15)) << 4)); } }
            __builtin_amdgcn_sched_barrier(0);
#pragma unroll
            for (int ks = 0; ks < 4; ++ks) { if (2 * ks <= tb) ad = __builtin_amdgcn_mfma_f32_16x16x32_bf16(xfr[ks], mmf[ks], ad, 0, 0, 0);
                ao = __builtin_amdgcn_mfma_f32_16x16x32_bf16(sfr[ks], __builtin_bit_cast(bf16x8, (u32x4){clo[ks].x, clo[ks].y, chi[ks].x, chi[ks].y}), ao, 0, 0, 0); }
            __builtin_amdgcn_sched_barrier(0);
            const float ea = eac[trow];
            const u32x2 xv = *(const LAS u32x2*)(lds + C_XB + trow * 128 + (((2 * pb + (q >> 1)) ^ (trow & 7)) << 4) + (q & 1) * 8);
            const float xx[4] = {bflo(xv.x), bfhi(xv.x), bflo(xv.y), bfhi(xv.y)}, zz[4] = {bflo(zv[j].x), bfhi(zv[j].x), bflo(zv[j].y), bfhi(zv[j].y)};
            float y[4], sq = 0.f;
#pragma unroll
            for (int k = 0; k < 4; ++k) { y[k] = (ad[k] + ea * ao[k] + Dh * xx[k]) * siluf(zz[k]); sq += y[k] * y[k]; }
            u32x2 ov; ov.x = cvtpk(y[0], y[1]); ov.y = cvtpk(y[2], y[3]);
            *(GAS u32x2*)(yb + (unsigned)((grow * D_MIX + h * 64 + p0) * 2)) = ov;
            sq += __shfl_xor(sq, 16); sq += __shfl_xor(sq, 32);
            if (q == 0) ssqp[pb * 128 + trow] = sq;
            __builtin_amdgcn_sched_barrier(0);
        }
        {   const float dend = __expf(acum[127]);
#pragma unroll
            for (int np = 0; np < 4; ++np) { ST[2 * np] = ST[2 * np] * dend; ST[2 * np + 1] = ST[2 * np + 1] * dend;
                bf16x8 a0[4], a1[4];
#pragma unroll
                for (int ks = 0; ks < 4; ++ks) { a0[ks] = *(const LAS bf16x8*)(lds + C_BTW + swT(32 * np + r, 4 * ks + q)); a1[ks] = *(const LAS bf16x8*)(lds + C_BTW + swT(32 * np + 16 + r, 4 * ks + q)); }
                __builtin_amdgcn_sched_barrier(0);
#pragma unroll
                for (int ks = 0; ks < 4; ++ks) { ST[2 * np] = __builtin_amdgcn_mfma_f32_16x16x32_bf16(a0[ks], xfr[ks], ST[2 * np], 0, 0, 0); ST[2 * np + 1] = __builtin_amdgcn_mfma_f32_16x16x32_bf16(a1[ks], xfr[ks], ST[2 * np + 1], 0, 0, 0); }
                __builtin_amdgcn_sched_barrier(0); } }
    }
#undef SSD_ROLES
#undef SSD_LBAR
#undef SSD_PREFETCH
#undef SSD_DTLOAD
    __syncthreads();
    if (tid < 128) *(GAS float*)(ssqb + (unsigned)(((rowbase + SEQ - 128 + tid) * NH + h) * 4)) = (ssqp[tid] + ssqp[128 + tid]) + (ssqp[256 + tid] + ssqp[384 + tid]);
}

__device__ __forceinline__ void p3_rows2(int row0, const bf16* PROJ, const float* sc_w, const float* sc_nw, const float* ssd_nw, const float* SSQ, bf16* Y, LAS unsigned char* scr, int lane) {
    const int s0 = row0 & (SEQ - 1); const bool halo = s0 >= 2;
    const bf16* pr = PROJ + (size_t)row0 * PP + lane * 8;
    float ss0 = 0.f, ss1 = 0.f;
#pragma unroll 2
    for (int i = 0; i < 8; ++i) {
        const int c0 = (i * 64 + lane) * 8; const bf16* q = pr + i * 512; const bf16* qh = halo ? q : q + 2 * PP;
        const u32x4 um2v = *(const GAS u32x4*)(qh - 2 * PP + O_U), um1v = *(const GAS u32x4*)(qh - PP + O_U), u0v = *(const GAS u32x4*)(q + O_U), u1v = *(const GAS u32x4*)(q + PP + O_U);
        const u32x4 b0v = *(const GAS u32x4*)(q + O_SCB), b1v = *(const GAS u32x4*)(q + PP + O_SCB);
        const f32x4 w0a = *(const GAS f32x4*)(sc_w + c0), w0b = *(const GAS f32x4*)(sc_w + c0 + 4), w1a = *(const GAS f32x4*)(sc_w + D_CONV + c0), w1b = *(const GAS f32x4*)(sc_w + D_CONV + c0 + 4),
                    w2a = *(const GAS f32x4*)(sc_w + 2 * D_CONV + c0), w2b = *(const GAS f32x4*)(sc_w + 2 * D_CONV + c0 + 4);
        const float w0[8] = {w0a.x, w0a.y, w0a.z, w0a.w, w0b.x, w0b.y, w0b.z, w0b.w}, w1[8] = {w1a.x, w1a.y, w1a.z, w1a.w, w1b.x, w1b.y, w1b.z, w1b.w}, w2[8] = {w2a.x, w2a.y, w2a.z, w2a.w, w2b.x, w2b.y, w2b.z, w2b.w};
        float um2[8], um1[8], u0[8], u1[8], b0[8], b1[8];
        unpack8(um2v, um2); unpack8(um1v, um1); unpack8(u0v, u0); unpack8(u1v, u1);
#pragma unroll
        for (int j = 0; j < 8; ++j) { um2[j] = halo ? um2[j] : 0.f; um1[j] = halo ? um1[j] : 0.f; }
        unpack8(b0v, b0); unpack8(b1v, b1);
        float y0[8], y1[8];
#pragma unroll
        for (int j = 0; j < 8; ++j) { y0[j] = b0[j] * (w2[j] * u0[j] + w0[j] * um2[j] + w1[j] * um1[j]); y1[j] = b1[j] * (w2[j] * u1[j] + w0[j] * um1[j] + w1[j] * u0[j]); ss0 += y0[j] * y0[j]; ss1 += y1[j] * y1[j]; }
        *(LAS u32x4*)(scr + c0 * 2) = pack8(y0); *(LAS u32x4*)(scr + 8192 + c0 * 2) = pack8(y1);
    }
    const float rs0 = 1.0f / sqrtf(wave_sum(ss0) * (1.f / D_CONV) + EPS), rs1 = 1.0f / sqrtf(wave_sum(ss1) * (1.f / D_CONV) + EPS);
    bf16* yrow = Y + (size_t)row0 * D_MIX + lane * 8;
#pragma unroll 2
    for (int i = 0; i < 8; ++i) { const int c0 = (i * 64 + lane) * 8;
        float f0[8], f1[8]; unpack8(*(const LAS u32x4*)(scr + c0 * 2), f0); unpack8(*(const LAS u32x4*)(scr + 8192 + c0 * 2), f1);
        const f32x4 ga = *(const GAS f32x4*)(sc_nw + c0), gb = *(const GAS f32x4*)(sc_nw + c0 + 4); const float g[8] = {ga.x, ga.y, ga.z, ga.w, gb.x, gb.y, gb.z, gb.w};
#pragma unroll
        for (int j = 0; j < 8; ++j) { f0[j] *= rs0 * g[j]; f1[j] *= rs1 * g[j]; }
        *(GAS u32x4*)(yrow + D_SSD + i * 512) = pack8(f0); *(GAS u32x4*)(yrow + D_MIX + D_SSD + i * 512) = pack8(f1); }
    float gs0 = SSQ[(size_t)row0 * NH + lane], gs1 = SSQ[(size_t)(row0 + 1) * NH + lane];
    gs0 += __shfl_xor(gs0, 1); gs0 += __shfl_xor(gs0, 2); gs0 += __shfl_xor(gs0, 4); gs1 += __shfl_xor(gs1, 1); gs1 += __shfl_xor(gs1, 2); gs1 += __shfl_xor(gs1, 4);
#pragma unroll 2
    for (int i = 0; i < 8; ++i) { const int c0 = (i * 64 + lane) * 8;
        const float rg0 = 1.0f / sqrtf(__shfl(gs0, i * 8) * (1.f / 512.f) + EPS), rg1 = 1.0f / sqrtf(__shfl(gs1, i * 8) * (1.f / 512.f) + EPS);
        float f0[8], f1[8]; unpack8(*(const GAS u32x4*)(yrow + i * 512), f0); unpack8(*(const GAS u32x4*)(yrow + D_MIX + i * 512), f1);
        const f32x4 ga = *(const GAS f32x4*)(ssd_nw + c0), gb = *(const GAS f32x4*)(ssd_nw + c0 + 4); const float g[8] = {ga.x, ga.y, ga.z, ga.w, gb.x, gb.y, gb.z, gb.w};
#pragma unroll
        for (int j = 0; j < 8; ++j) { f0[j] *= rg0 * g[j]; f1[j] *= rg1 * g[j]; }
        *(GAS u32x4*)(yrow + i * 512) = pack8(f0); *(GAS u32x4*)(yrow + D_MIX + i * 512) = pack8(f1); }
}

constexpr int KROW = 272;
constexpr int RT_KH = 0, RT_KL = 128 * KROW, RT_LST = 2 * 128 * KROW, RT_END = RT_LST + 2 * 128 * 16 * 4;
static_assert(RT_END <= RING_BYTES, "route lds");
__device__ __forceinline__ unsigned ord_enc(float s) { const unsigned b = __float_as_uint(s); return (b & 0x80000000u) ? ~b : (b | 0x80000000u); }
__device__ __forceinline__ float ord_dec(unsigned p) { const unsigned o = p & ~127u; return __uint_as_float((o & 0x80000000u) ? (o & 0x7fffffffu) : ~o); }
__device__ __forceinline__ void cex_desc(unsigned& a, unsigned& b) { const unsigned hi = a > b ? a : b, lo = a > b ? b : a; a = hi; b = lo; }
__device__ __forceinline__ void bitonic_merge16_desc(unsigned (&v)[16]) {
#pragma unroll
    for (int j = 8; j > 0; j >>= 1)
#pragma unroll
        for (int i = 0; i < 16; ++i) if ((i & j) == 0) cex_desc(v[i], v[i | j]);
}
__device__ __forceinline__ void bitonic_sort16_desc(unsigned (&v)[16]) {
#pragma unroll
    for (int k = 2; k <= 16; k <<= 1)
#pragma unroll
        for (int j = k >> 1; j > 0; j >>= 1)
#pragma unroll
            for (int i = 0; i < 16; ++i) if ((i & j) == 0) { if ((i & k) == 0) cex_desc(v[i], v[i | j]); else cex_desc(v[i | j], v[i]); }
}
__device__ __forceinline__ void top16_merge_desc(unsigned (&a)[16], const unsigned (&b)[16]) {
#pragma unroll
    for (int j = 0; j < 16; ++j) a[j] = a[j] > b[15 - j] ? a[j] : b[15 - j];
    bitonic_merge16_desc(a);
}
__device__ __forceinline__ void route_wg(LAS unsigned char* lds, int nun, int pm0, int ph0, int pm1, int ph1, const float* Q, int* IDX, float* GATE, int tid, int wave, int lane) {
    LAS unsigned* lst = (LAS unsigned*)lds;
    const int kq = lane >> 4, lr = lane & 15;
    __syncthreads();
#pragma unroll 1
    for (int ps = 0; ps < 2 * nun; ++ps) { const int un = ps >> 1, pm = un ? pm1 : pm0, h = un ? ph1 : ph0, ltok = ps * 128 + wave * 16 + lr;
        const float* qp = Q + (size_t)(pm * 256 + (ps & 1) * 128 + wave * 16 + lr) * PQ + h * 256 + kq * 4;
        f32x4 sc[2][8];
#pragma unroll
        for (int c = 0; c < 2; ++c)
#pragma unroll
            for (int t = 0; t < 8; ++t) sc[c][t] = *(const GAS f32x4*)(qp + c * 128 + 16 * t);
#pragma unroll
        for (int c = 0; c < 2; ++c) {
            unsigned L[16], Hh[16];
#pragma unroll
            for (int t = 0; t < 4; ++t)
#pragma unroll
                for (int r = 0; r < 4; ++r) { L[4 * t + r] = (ord_enc(sc[c][t][r]) & ~127u) | (unsigned)(127 - (16 * t + 4 * kq + r)); Hh[4 * t + r] = (ord_enc(sc[c][t + 4][r]) & ~127u) | (unsigned)(127 - (16 * (t + 4) + 4 * kq + r)); }
            bitonic_sort16_desc(L); bitonic_sort16_desc(Hh);
            top16_merge_desc(L, Hh);
#pragma unroll
            for (int sh = 16; sh <= 32; sh <<= 1) { unsigned P[16];
#pragma unroll
                for (int j = 0; j < 16; ++j) P[j] = (unsigned)__shfl_xor((int)L[j], sh);
                top16_merge_desc(L, P); }
            if (kq == 0) { LAS u32x4* lp = (LAS u32x4*)(lst + (c * 512 + ltok) * 16);
                lp[0] = (u32x4){L[0], L[1], L[2], L[3]}; lp[1] = (u32x4){L[4], L[5], L[6], L[7]}; lp[2] = (u32x4){L[8], L[9], L[10], L[11]}; lp[3] = (u32x4){L[12], L[13], L[14], L[15]}; }
        }
    }
    __syncthreads();
    if (tid < 256 * nun) { const int un = tid >> 8, h = un ? ph1 : ph0; const size_t gtok = (size_t)((un ? pm1 : pm0) * 256 + (tid & 255));
        const LAS unsigned* l0 = lst + (0 * 512 + tid) * 16; const LAS unsigned* l1 = lst + (1 * 512 + tid) * 16;
        float fr[16]; const float s10 = ord_dec(l1[0]);
#pragma unroll
        for (int a = 0; a < 16; ++a) fr[a] = ord_dec(l0[a]) + s10;
        unsigned long long P = 0ull; float bs[16]; int be[16];
#pragma unroll
        for (int k = 0; k < 16; ++k) {
            float best = fr[0]; int ba = 0;
#pragma unroll
            for (int a = 1; a < 16; ++a) { const bool gt = fr[a] > best; best = gt ? fr[a] : best; ba = gt ? a : ba; }
            const int pb = (int)((P >> (4 * ba)) & 15ull);
            const unsigned p0 = l0[ba], p1 = l1[pb];
            bs[k] = best; be[k] = (127 - (int)(p0 & 127u)) * PK + (127 - (int)(p1 & 127u));
            const int nb2 = pb + 1; float nf = -3.0e38f;
            if (nb2 < 16) { P += 1ull << (4 * ba); nf = ord_dec(p0) + ord_dec(l1[nb2]); }
#pragma unroll
            for (int a = 0; a < 16; ++a) fr[a] = (a == ba) ? nf : fr[a];
        }
        float e[16], sum = 0.f;
#pragma unroll
        for (int k = 0; k < 16; ++k) { e[k] = __expf(bs[k] - bs[0]); sum += e[k]; }
        const float inv = 1.0f / sum;
        int* ip = IDX + gtok * HK + h * 16; float* gp = GATE + gtok * HK + h * 16;
#pragma unroll
        for (int k = 0; k < 16; ++k) { ip[k] = be[k]; gp[k] = e[k] * inv; }
    }
}

__device__ __forceinline__ float gelu_erf(float v) { return 0.5f * v * (1.0f + erff(v * 0.70710678118654752f)); }
constexpr size_t SLICE_BYTES = (size_t)NEXP * 128;
__device__ __forceinline__ void quant_row_fp8(const float* src, unsigned char* dst, float* scale, int lane) {
    const GAS f32x4* xr = (const GAS f32x4*)src + lane;
    f32x4 v[16]; float am = 0.f;
#pragma unroll
    for (int j = 0; j < 16; ++j) { v[j] = __builtin_nontemporal_load(xr + 64 * j); am = fmaxf(am, fmaxf(fmaxf(fabsf(v[j].x), fabsf(v[j].y)), fmaxf(fabsf(v[j].z), fabsf(v[j].w)))); }
#pragma unroll
    for (int o = 1; o < 64; o <<= 1) am = fmaxf(am, __shfl_xor(am, o));
    const float sc = am > 0.f ? am * (1.0f / 224.0f) : 1.0f, inv = 1.0f / sc;
    GAS unsigned char* o1 = (GAS unsigned char*)dst + (size_t)(lane >> 5) * SLICE_BYTES + (lane & 31) * 4;
#pragma unroll
    for (int j = 0; j < 16; ++j) { int p = __builtin_amdgcn_cvt_pk_fp8_f32(v[j].x * inv, v[j].y * inv, 0, false); p = __builtin_amdgcn_cvt_pk_fp8_f32(v[j].z * inv, v[j].w * inv, p, true); *(GAS unsigned*)(o1 + (size_t)(2 * j) * SLICE_BYTES) = (unsigned)p; }
    if (lane == 0) *scale = sc;
}
__device__ __forceinline__ void quant_row_i8(const float* src, unsigned char* dst, float* scale, int lane) {
    const GAS f32x4* xr = (const GAS f32x4*)src + lane;
    f32x4 v[16]; float am = 0.f;
#pragma unroll
    for (int j = 0; j < 16; ++j) { v[j] = __builtin_nontemporal_load(xr + 64 * j); am = fmaxf(am, fmaxf(fmaxf(fabsf(v[j].x), fabsf(v[j].y)), fmaxf(fabsf(v[j].z), fabsf(v[j].w)))); }
#pragma unroll
    for (int o = 1; o < 64; o <<= 1) am = fmaxf(am, __shfl_xor(am, o));
    const float sc = am > 0.f ? am * (1.0f / 127.0f) : 1.0f, inv = 1.0f / sc;
    GAS unsigned char* o1 = (GAS unsigned char*)dst + (size_t)(lane >> 5) * SLICE_BYTES + (lane & 31) * 4;
#pragma unroll
    for (int j = 0; j < 16; ++j) *(GAS unsigned*)(o1 + (size_t)(2 * j) * SLICE_BYTES) = pack_i8x4(v[j].x * inv, v[j].y * inv, v[j].z * inv, v[j].w * inv);
    if (lane == 0) *scale = sc;
}
__device__ __forceinline__ void rs16(const float (&d)[16], int bit, int sh1, int sh2, int sh3, float (&out)[2]) {
    float n8[8], n4[4];
#pragma unroll
    for (int m = 0; m < 8; ++m) { const bool up = (bit & sh1) != 0; const float mine = up ? d[8 + m] : d[m], theirs = up ? d[m] : d[8 + m]; n8[m] = mine + __shfl_xor(theirs, sh1); }
#pragma unroll
    for (int m = 0; m < 4; ++m) { const bool up = (bit & sh2) != 0; const float mine = up ? n8[4 + m] : n8[m], theirs = up ? n8[m] : n8[4 + m]; n4[m] = mine + __shfl_xor(theirs, sh2); }
#pragma unroll
    for (int m = 0; m < 2; ++m) { const bool up = (bit & sh3) != 0; const float mine = up ? n4[2 + m] : n4[m], theirs = up ? n4[m] : n4[2 + m]; out[m] = mine + __shfl_xor(theirs, sh3); }
}
__device__ __forceinline__ void peer_block(LAS unsigned char* wl, int tok0, const unsigned char* XQ, const float* XS, const unsigned char* U8, const unsigned char* V8, const float* SU, const float* SV, const int* IDX, const float* GATE, const bf16* HB, float* HO, bf16* X2, const float* wfin, int lane) {
    const int rg = lane >> 3, c = lane & 7; const unsigned cofs = (unsigned)c * 16u;
    LAS unsigned short* idxL = (LAS unsigned short*)wl; LAS float* actL = (LAS float*)(wl + 2048); LAS float* ssqL = (LAS float*)(wl + 6144);
#pragma unroll
    for (int j = 0; j < 8; ++j) {
#pragma unroll
        for (int hh = 0; hh < 2; ++hh) { const int k = hh * 64 + lane; idxL[(j * 8 + (k & 7)) * 16 + (k >> 3)] = (unsigned short)IDX[(size_t)(tok0 + j) * HK + k]; }
        *(LAS f32x2*)(actL + j * 128 + lane * 2) = (f32x2){0.f, 0.f}; ssqL[j * 64 + lane] = 0.f; }
    LDS_WAIT();
    for (int urep = 0; urep < NREP(8); ++urep) {
    if (urep) { for (int j = 0; j < 8; ++j) *(LAS f32x2*)(actL + j * 128 + lane * 2) = (f32x2){0.f, 0.f}; LDS_WAIT(); }
#define PB_LOAD(buf, tab, it) do { const int _s = (it) >> 3, _j = (it) & 7; const GAS unsigned char* _base = (const GAS unsigned char*)(tab) + (size_t)_s * SLICE_BYTES; \
        const u32x4 _ia = *(const LAS u32x4*)(idxL + (_j * 8 + rg) * 16), _ib = *(const LAS u32x4*)(idxL + (_j * 8 + rg) * 16 + 8); const unsigned _iw[8] = {_ia.x, _ia.y, _ia.z, _ia.w, _ib.x, _ib.y, _ib.z, _ib.w}; \
        _Pragma("unroll") for (int _i = 0; _i < 16; ++_i) { const unsigned _e = (_iw[_i >> 1] >> (16 * (_i & 1))) & 0xffffu; buf[_i] = *(const GAS u32x4*)(_base + (_e * 128u + cofs)); } } while (0)
    LAS unsigned char* xsL = wl + 6144; u32x4 xg;
#define PB_XSLICE(s) do { const int _ss = (s) < 32 ? (s) : 31; xg = __builtin_nontemporal_load((const GAS u32x4*)(XQ + (size_t)(tok0 + (lane >> 3)) * D + _ss * 128 + (lane & 7) * 16)); } while (0)
#define PB_XLOAD(xa, it) do { if (((it) & 7) == 0) { *(LAS u32x4*)(xsL + (((it) >> 3) & 1) * 1024 + lane * 16) = xg; LDS_WAIT(); } \
        if (((it) & 7) == 7) PB_XSLICE(((it) >> 3) + 1); \
        xa = *(const LAS u32x4*)(xsL + (((it) >> 3) & 1) * 1024 + ((it) & 7) * 128 + c * 16); } while (0)
#define PB_UCOMP(buf, xa, it) do { const int _j = (it) & 7; float _d[16]; \
        _Pragma("unroll") for (int _i = 0; _i < 16; ++_i) { int _a = __builtin_amdgcn_sdot4((int)buf[_i].x, (int)xa.x, 0, false); _a = __builtin_amdgcn_sdot4((int)buf[_i].y, (int)xa.y, _a, false); \
            _a = __builtin_amdgcn_sdot4((int)buf[_i].z, (int)xa.z, _a, false); _a = __builtin_amdgcn_sdot4((int)buf[_i].w, (int)xa.w, _a, false); _d[_i] = (float)_a; } \
        float _n2[2]; rs16(_d, c, 4, 2, 1, _n2); \
        LAS f32x2* _pp = (LAS f32x2*)(actL + _j * 128 + lane * 2); f32x2 _p = *_pp; _p.x += _n2[0]; _p.y += _n2[1]; *_pp = _p; } while (0)
    {   u32x4 bufA[16], bufB[16], xaA, xaB;
        PB_XSLICE(0); PB_XLOAD(xaA, 0); PB_LOAD(bufA, U8, 0);
#pragma unroll 1
        for (int it = 0; it < 256; it += 2) {
            PB_XLOAD(xaB, it + 1); PB_LOAD(bufB, U8, it + 1);
            __builtin_amdgcn_sched_barrier(0);
            PB_UCOMP(bufA, xaA, it);
            __builtin_amdgcn_sched_barrier(0);
            PB_XLOAD(xaA, (it + 2) & 255); PB_LOAD(bufA, U8, (it + 2) & 255);
            __builtin_amdgcn_sched_barrier(0);
            PB_UCOMP(bufB, xaB, it + 1);
            __builtin_amdgcn_sched_barrier(0);
        }
    }
    }
#pragma unroll 1
    for (int j = 0; j < 8; ++j) { const int tok = tok0 + j, k0 = 16 * c + rg, k1 = k0 + 8;
        LAS f32x2* pp = (LAS f32x2*)(actL + j * 128 + lane * 2); const f32x2 p = *pp;
        const unsigned ew = *(const LAS unsigned*)(idxL + (j * 8 + rg) * 16 + 2 * c); const int e0 = (int)(ew & 0xffffu), e1 = (int)(ew >> 16);
        const float g0 = GATE[(size_t)tok * HK + k0], g1 = GATE[(size_t)tok * HK + k1];
        const float xs = XS[tok]; const float a0 = gelu_erf(p.x * xs * SU[e0]) * g0 * SV[e0], a1 = gelu_erf(p.y * xs * SU[e1]) * g1 * SV[e1];
        *pp = (f32x2){a0, a1}; }
    LDS_WAIT();
    for (int vrep = 0; vrep < NREP(9); ++vrep) {
    if (vrep) { for (int j = 0; j < 8; ++j) ssqL[j * 64 + lane] = 0.f; LDS_WAIT(); }
#define PB_HOFF(it) ((size_t)(tok0 + ((it) & 7)) * D + ((it) >> 3) * 128 + 16 * c + 2 * rg)
#define PB_VCOMP(buf, it) do { const int _j = (it) & 7; \
        const LAS f32x4* _ap = (const LAS f32x4*)(actL + (_j * 8 + rg) * 16); const f32x4 _a0 = _ap[0], _a1 = _ap[1], _a2 = _ap[2], _a3 = _ap[3]; \
        const float _av[16] = {_a0.x, _a0.y, _a0.z, _a0.w, _a1.x, _a1.y, _a1.z, _a1.w, _a2.x, _a2.y, _a2.z, _a2.w, _a3.x, _a3.y, _a3.z, _a3.w}; \
        f32x2 _o[8]; _Pragma("unroll") for (int _m = 0; _m < 8; ++_m) _o[_m] = (f32x2){0.f, 0.f}; \
        _Pragma("unroll") for (int _i = 0; _i < 16; ++_i) { const f32x2 _a2v = (f32x2){_av[_i], _av[_i]}; const unsigned _w[4] = {buf[_i].x, buf[_i].y, buf[_i].z, buf[_i].w}; \
            _Pragma("unroll") for (int _q = 0; _q < 4; ++_q) { const f32x2 _lo = __builtin_amdgcn_cvt_pk_f32_fp8((int)_w[_q], false), _hi = __builtin_amdgcn_cvt_pk_f32_fp8((int)_w[_q], true); _o[2 * _q] += _a2v * _lo; _o[2 * _q + 1] += _a2v * _hi; } } \
        const float _ov[16] = {_o[0].x, _o[0].y, _o[1].x, _o[1].y, _o[2].x, _o[2].y, _o[3].x, _o[3].y, _o[4].x, _o[4].y, _o[5].x, _o[5].y, _o[6].x, _o[6].y, _o[7].x, _o[7].y}; \
        float _n2[2]; rs16(_ov, lane, 32, 16, 8, _n2); \
        __builtin_nontemporal_store(cvtpk(_n2[0], _n2[1]), (GAS unsigned*)(X2 + PB_HOFF(it))); } while (0)
    {   u32x4 bufA[16], bufB[16];
        PB_LOAD(bufA, V8, 0);
#pragma unroll 1
        for (int it = 0; it < 256; it += 2) {
            PB_LOAD(bufB, V8, it + 1);
            __builtin_amdgcn_sched_barrier(0);
            PB_VCOMP(bufA, it);
            __builtin_amdgcn_sched_barrier(0);
            if (it + 2 < 256) { PB_LOAD(bufA, V8, it + 2); }
            __builtin_amdgcn_sched_barrier(0);
            PB_VCOMP(bufB, it + 1);
            __builtin_amdgcn_sched_barrier(0);
        }
    }
    }
#undef PB_LOAD
#undef PB_XLOAD
#undef PB_XSLICE
#undef PB_UCOMP
#undef PB_HOFF
#undef PB_VCOMP
    LDS_WAIT();
    asm volatile("s_waitcnt vmcnt(0)" ::: "memory");
    f32x4 gfin[16];
    { int lq = lane; asm volatile("" : "+v"(lq));
#pragma unroll
    for (int q = 0; q < 16; ++q) gfin[q] = *((const GAS f32x4*)wfin + lq + 64 * q); }
#pragma unroll 1
    for (int j = 0; j < 8; ++j) { const size_t ro = (size_t)(tok0 + j) * D;
        const GAS u32x2* sp = (const GAS u32x2*)(X2 + ro) + lane; const GAS u32x2* hp = (const GAS u32x2*)(HB + ro) + lane;
        f32x4 xv[16]; float ss = 0.f;
#pragma unroll
        for (int q = 0; q < 16; ++q) { const u32x2 v = __builtin_nontemporal_load(sp + 64 * q), hv = __builtin_nontemporal_load(hp + 64 * q);
            xv[q] = (f32x4){bflo(v.x) + bflo(hv.x), bfhi(v.x) + bfhi(hv.x), bflo(v.y) + bflo(hv.y), bfhi(v.y) + bfhi(hv.y)}; ss += (xv[q].x * xv[q].x + xv[q].y * xv[q].y) + (xv[q].z * xv[q].z + xv[q].w * xv[q].w); }
        const float rs = 1.0f / sqrtf(wave_sum(ss) * (1.f / D) + EPS);
        GAS f32x4* rp = (GAS f32x4*)(HO + ro) + lane;
#pragma unroll
        for (int q = 0; q < 16; ++q) { const f32x4 g = gfin[q]; rp[64 * q] = (f32x4){xv[q].x * rs * g.x, xv[q].y * rs * g.y, xv[q].z * rs * g.z, xv[q].w * rs * g.w}; } }
}

struct Args { const float* in[18]; float* out; unsigned char* ws; int ph_lo, ph_hi, li, pad; };
__global__ void __launch_bounds__(NWAVES * 64, 2) mk_fwd(Args args) {
    extern __shared__ __attribute__((aligned(16))) unsigned char lds_raw[];
    LAS unsigned char* lds = (LAS unsigned char*)lds_raw;
    volatile LAS unsigned* MISC = (volatile LAS unsigned*)(lds + MISC_OFF);
    const int tid = threadIdx.x, lane = tid & 63, wave = __builtin_amdgcn_readfirstlane(tid >> 6);
    const int G = gridDim.x, bid = blockIdx.x;
    const int vcu = (G % 8 == 0) ? (bid % 8) * (G / 8) + bid / 8 : bid;
    unsigned char* ws = args.ws;
    gu32* ctl = (gu32*)(ws + WS_CTL);
    const float* x = args.in[0]; const float* w_in = args.in[1]; const float* ssd_conv_w = args.in[2]; const float* ssd_conv_b = args.in[3]; const float* ssd_dt_bias = args.in[4];
    const float* ssd_a_log = args.in[5]; const float* ssd_d = args.in[6]; const float* ssd_norm_w = args.in[7]; const float* sc_conv_w = args.in[8]; const float* sc_norm_w = args.in[9];
    const float* w_out = args.in[10]; const float* norm_mix_w = args.in[11]; const float* norm_ffn_w = args.in[12]; const float* w_query = args.in[13]; const float* sub_keys = args.in[14];
    const float* peer_u = args.in[15]; const float* peer_v = args.in[16]; const float* norm_final_w = args.in[17];
    float* out = args.out;
    bf16* XN = (bf16*)(ws + WS_XN); bf16* WIN = (bf16*)(ws + WS_WIN); bf16* WOUT = (bf16*)(ws + WS_WOUT); bf16* WQ = (bf16*)(ws + WS_WQ); bf16* Y = (bf16*)(ws + WS_Y); bf16* PROJ = (bf16*)(ws + WS_PROJ);
    unsigned char* U8 = ws + WS_U8; unsigned char* V8 = ws + WS_V8; float* SU = (float*)(ws + WS_SU); float* SV = (float*)(ws + WS_SV); unsigned char* XQ = ws + WS_XQ; float* XS = (float*)(ws + WS_XS); float* RS = XS + 16384; float* QF = (float*)(ws + WS_Q); float* SSQ = (float*)(ws + WS_SSQ); bf16* HB = (bf16*)(ws + WS_HB); bf16* KHI = (bf16*)(ws + WS_KH); bf16* KLO = KHI + 8 * 2 * 128 * 128;
    int* IDX = (int*)(ws + WS_IDX); float* GATE = (float*)(ws + WS_GATE);

    for (int u = tid; u < (LDS_BYTES - LDSCTL_OFF) / 4; u += NWAVES * 64) ((LAS unsigned*)(lds + LDSCTL_OFF))[u] = 0u;
    __syncthreads();
    XcdBarrier bar; bar.bar = (unsigned*)(ctl + CW_BAR); bar.x = 0; bar.st = nullptr;
    if (N_LAUNCHES == 1) bar = xcd_barrier_post((unsigned*)(ctl + CW_BAR), MISC + 8);
#define GRID_BAR() do { if (N_LAUNCHES == 1) xcd_barrier(bar); } while (0)
    const int lo = args.ph_lo, hi = args.ph_hi;
#ifndef PH_MASK
#define PH_MASK 0x1ff
#endif
#define PH_EN(k) (((PH_MASK) >> (k)) & 1)

#define IN(k) (lo <= (k) && (k) < hi)
#define BOTH(k) (IN(k) && IN((k) + 1 + ((k) == 6)))
    const int gw = vcu * NWAVES + wave, NGW = G * NWAVES;

    if (PH_EN(0) && IN(0)) { for (int rep = 0; rep < NREP(0); ++rep) {
        LAS float* scr = (LAS float*)(lds + RING_OFF + wave * 16384);
        constexpr int I_IN = (D / 64) * (NPROJ / 32);
        for (int it = gw; it < I_IN; it += NGW) p0_transpose_item(w_in, D, NPROJ, WIN, true, nullptr, scr, it, lane);
        { GAS v4u* z = (GAS v4u*)(WIN + (size_t)NPROJ * D); const size_t n16 = (size_t)(NP - NPROJ) * D * 2 / 16;
          for (size_t i = (size_t)bid * 512 + tid; i < n16; i += (size_t)G * 512) z[i] = (v4u){0u, 0u, 0u, 0u}; }
        for (int m = gw; m < M; m += NGW) rms_row_to_bf16(x + (size_t)m * D, norm_mix_w, XN + (size_t)m * D, lane);
        __syncthreads(); }
        if (BOTH(0)) GRID_BAR();
    }
    if (PH_EN(1) && IN(1)) {
        pg8::Gemm g{XN, WIN, M, NP, D}; pg8::StaticOrder S; S.init(M, NP, G, bid);
        pg8::EpiProj E{PROJ, PP, CH_TILE0, CH_TILES, O_U};
        pg8::gemm_phase<pg8::EpiProj, pg8::StaticOrder, PG8_ALIGN, PG8_SP2>(lds + RING_OFF, g, S, E);
        if (NREP(1) == 2) { __syncthreads(); pg8::gemm_phase<pg8::EpiProj, pg8::StaticOrder, PG8_ALIGN, PG8_SP2>(lds + RING_OFF, g, S, E); }
        {
            const int nwg = (M / 256) * (NP / 256), rem = nwg % G, first = rem ? rem : 0, nb = G - first;
            if (bid >= first) {
                __syncthreads();
                LAS float* scr = (LAS float*)(lds + RING_OFF + wave * 16384);
                const int fi0 = bid - first;
                for (int wt = fi0; wt < 16 * (D / 512); wt += nb) { const int kb = wt >> 3, d = (wt & 7) * 512 + tid;
                    LAS float* kl = (LAS float*)(lds + RING_OFF);
                    for (int i = tid; i < 128 * 128 / 4; i += 512) ((LAS f32x4*)kl)[i] = ((const GAS f32x4*)(sub_keys + (size_t)kb * 16384))[i];
                    float wq[128]; const float gd = norm_ffn_w[d];
#pragma unroll
                    for (int jj = 0; jj < 32; ++jj) { const f32x4 t = *(const GAS f32x4*)(w_query + (size_t)d * PQ + kb * 128 + 4 * jj); wq[4 * jj] = t.x * gd; wq[4 * jj + 1] = t.y * gd; wq[4 * jj + 2] = t.z * gd; wq[4 * jj + 3] = t.w * gd; }
                    __syncthreads();
#pragma unroll 1
                    for (int k = 0; k < 128; ++k) { float a0 = 0.f, a1 = 0.f;
#pragma unroll
                        for (int jj = 0; jj < 32; ++jj) { const f32x4 kk = *(const LAS f32x4*)(kl + k * 128 + 4 * jj); a0 += wq[4 * jj] * kk.x + wq[4 * jj + 2] * kk.z; a1 += wq[4 * jj + 1] * kk.y + wq[4 * jj + 3] * kk.w; }
                        ((GAS unsigned short*)WQ)[(size_t)(kb * 128 + k) * D + d] = (unsigned short)(cvtpk(a0 + a1, 0.f) & 0xffffu); }
                    __syncthreads(); }
                constexpr int I_OUT = (D_MIX / 64) * (D / 32);
                const int gwt = (bid - first) * NWAVES + wave, ngwt = nb * NWAVES;
                for (int it = gwt; it < I_OUT; it += ngwt) p0_transpose_item(w_out, D_MIX, D, WOUT, false, nullptr, scr, it, lane);
            }
        }
        {
            unsigned* tk = (unsigned*)(ctl + CW_TICKET);
            for (;;) { unsigned t0 = 0; if (lane == 0) t0 = xb_add(tk, 1u); t0 = __builtin_amdgcn_readfirstlane(t0); if (t0 >= 2u * NEXP / 4u) break;
#pragma unroll 1
                for (int k = 0; k < 4; ++k) { const int r = (int)t0 * 4 + k; const bool second = r >= NEXP; const int e = second ? r - NEXP : r;
                    if (second) quant_row_fp8(peer_v + (size_t)e * D, V8 + (size_t)e * 128, SV + e, lane); else quant_row_i8(peer_u + (size_t)e * D, U8 + (size_t)e * 128, SU + e, lane); } }
        }
        if (BOTH(1)) GRID_BAR();
    }
    if (PH_EN(2) && IN(2)) {
        bf16* CONV = (bf16*)(ws + WS_CONV);
        for (int rep = 0; rep < NREP(2); ++rep) {
        for (int prep = 0; prep < NREP(10); ++prep) conv_prepass(PROJ, ssd_conv_w, ssd_conv_b, CONV, vcu * 512 + tid, G * 512);
        GRID_BAR();
        for (int u = bid; u < NB * NH; u += G) {
            const int xc = u & 7, j = u >> 3, bg = xc * 4 + (j >> 3), hh = j & 7, b = bg >> 3, gq = bg & 7, h = gq * 8 + hh;
            ssd_unit(lds, b, h, PROJ, CONV, ssd_dt_bias, ssd_a_log, ssd_d, Y, SSQ, tid, wave, lane);
        }
        }
        if (BOTH(2)) GRID_BAR();
    }
    if (PH_EN(3) && IN(3)) {
        for (int m2 = gw; m2 < M / 2; m2 += NGW) p3_rows2(2 * m2, PROJ, sc_conv_w, sc_norm_w, ssd_norm_w, SSQ, Y, lds + RING_OFF + wave * 16384, lane);
        if (BOTH(3)) GRID_BAR();
    }
    if (PH_EN(4) && IN(4)) {
        pg8::Gemm g{Y, WOUT, M, D, D_MIX}; pg8::StaticOrder S; S.init(M, D, G, bid);
        pg8::EpiResBf16 E{HB, x, D};
        pg8::gemm_phase<pg8::EpiResBf16, pg8::StaticOrder, PG8_ALIGN, PG8_SP2>(lds + RING_OFF, g, S, E);
        if (NREP(4) == 2) { __syncthreads(); pg8::gemm_phase<pg8::EpiResBf16, pg8::StaticOrder, PG8_ALIGN, PG8_SP2>(lds + RING_OFF, g, S, E); }
        if (BOTH(4)) GRID_BAR();
    }
    if (PH_EN(5) && IN(5)) { for (int rep = 0; rep < NREP(5); ++rep) {
        for (int m = gw; m < M; m += NGW) rms_row_to_bf16_i8(HB + (size_t)m * D, norm_ffn_w, RS + m, XQ + (size_t)m * D, XS + m, lane);
        }
        if (BOTH(5)) GRID_BAR();
    }
    if (PH_EN(6) && IN(6)) {
        pg8::Gemm g{HB, WQ, M, PQ, D}; pg8::StaticOrder S; S.init(M, PQ, G, bid);
        pg8::EpiRowScaleF32 E{QF, RS, PQ};
        pg8::gemm_phase<pg8::EpiRowScaleF32, pg8::StaticOrder, PG8_ALIGN, PG8_SP2>(lds + RING_OFF, g, S, E);
        if (NREP(6) == 2) { __syncthreads(); pg8::gemm_phase<pg8::EpiRowScaleF32, pg8::StaticOrder, PG8_ALIGN, PG8_SP2>(lds + RING_OFF, g, S, E); }
        asm volatile("s_waitcnt vmcnt(0)" ::: "memory"); __syncthreads();
        for (int i = 0; ; i += 2) { pg8::Unit u0, u1; if (!S.next(i, u0)) break; const bool two = S.next(i + 1, u1);
            route_wg(lds + RING_OFF, two ? 2 : 1, u0.pm, u0.pn, two ? u1.pm : u0.pm, two ? u1.pn : u0.pn, QF, IDX, GATE, tid, wave, lane); }
        if (BOTH(6)) GRID_BAR();
    }
    if (PH_EN(8) && IN(8)) {
        for (int t8 = bid * NWAVES + wave; t8 < M / 8; t8 += G * NWAVES) peer_block(lds + wave * 8192, t8 * 8, XQ, XS, U8, V8, SU, SV, IDX, GATE, HB, out, (bf16*)(ws + WS_Y), norm_final_w, lane);
    }
#undef IN
#undef BOTH
#undef GRID_BAR
}

extern "C" void kernel_launch(void* const* d_in, const int* in_sizes, int n_in, void* d_out, int out_size, void* d_ws, size_t ws_size, hipStream_t stream) {
    static int grid = 0;
    if (grid == 0) {
        if (n_in != 18 || in_sizes[0] != M * D || out_size != M * D || ws_size < WS_END) { fprintf(stderr, "kernel_launch: unexpected shapes / workspace: n_in %d in0 %d out %d ws %zu (need %zu)\n", n_in, n_in > 0 ? in_sizes[0] : -1, out_size, ws_size, (size_t)WS_END); grid = -1; return; }
        int dev = 0, cus = 0, per_cu = 0;
        if (hipGetDevice(&dev) != hipSuccess || hipDeviceGetAttribute(&cus, hipDeviceAttributeMultiprocessorCount, dev) != hipSuccess) { fprintf(stderr, "kernel_launch: device query failed\n"); grid = -1; return; }
        if (hipFuncSetAttribute((const void*)mk_fwd, hipFuncAttributeMaxDynamicSharedMemorySize, LDS_BYTES) != hipSuccess) { fprintf(stderr, "kernel_launch: hipFuncSetAttribute failed\n"); grid = -1; return; }
        if (hipOccupancyMaxActiveBlocksPerMultiprocessor(&per_cu, (const void*)mk_fwd, NWAVES * 64, LDS_BYTES) != hipSuccess || per_cu < 1)
            fprintf(stderr, "kernel_launch: note: occupancy query reports %d workgroups per CU\n", per_cu);
        (void)hipGetLastError();
        grid = cus;
    }
    if (grid < 0) return;
    if (hipMemsetAsync((char*)d_ws + WS_CTL, 0, CTL_ZERO_BYTES, stream) != hipSuccess) { fprintf(stderr, "kernel_launch: memset failed\n"); return; }
    Args a{};
    for (int i = 0; i < 18; ++i) a.in[i] = (const float*)d_in[i];
    a.out = (float*)d_out; a.ws = (unsigned char*)d_ws;
    for (int li = 0; li < N_LAUNCHES; ++li) {
        a.ph_lo = (N_LAUNCHES == 1) ? 0 : li; a.ph_hi = (N_LAUNCHES == 1) ? NPHASE : li + 1; a.li = li; a.pad = 0;
        hipLaunchKernelGGL(mk_fwd, dim3(grid), dim3(NWAVES * 64), LDS_BYTES, stream, a);
        const hipError_t le = hipPeekAtLastError();
        if (le != hipSuccess) { fprintf(stderr, "kernel_launch: launch %d failed: %s\n", li, hipGetErrorName(le)); break; }
    }
}
```

```cpp
#include <hip/hip_runtime.h>
#include <cstdio>
#include <cstdint>
namespace pg8 {
#define PG8_LAS __attribute__((address_space(3)))
typedef unsigned short bf16_t;
typedef short bf16x8 __attribute__((ext_vector_type(8)));
typedef float f32x4 __attribute__((ext_vector_type(4)));
typedef unsigned u32x4 __attribute__((ext_vector_type(4)));
constexpr int BM = 256, BK = 64, HALF = 128, HTB = HALF * BK * 2  , STAGE_BYTES = 8 * HTB, NXCD = 8, WGM = 8;

__host__ __device__ __forceinline__ int lds_byte(int r, int c) { const int st = (r >> 4) * 2 + (c >> 5), rr = r & 15, cc = c & 31, ob = rr * 64 + cc * 2; return st * 1024 + (ob ^ (((ob >> 9) & 1) << 5)); }
__host__ __device__ __forceinline__ void stage_rc(int b, int& R, int& C) { const int st = b / 1024, sb = b % 1024, swz = sb ^ (((sb >> 9) & 1) << 5); R = (st >> 1) * 16 + swz / 64; C = (st & 1) * 32 + (swz % 64) / 2; }
__host__ __device__ __forceinline__ int perm32(int rho) { const int n = rho >> 4, i = rho & 15; return 8 * (i >> 2) + 4 * n + (i & 3); }

struct Unit { int pm, pn; };
struct Gemm { const bf16_t* A; const bf16_t* Bt; int M, N, K; };

struct StaticOrder {
    int nM, nN, nwg, G, c;
    __host__ __device__ void init(int M, int N, int G_, int c_) { nM = M / BM; nN = N / BM; nwg = nM * nN; G = G_; c = c_; }
    __host__ __device__ bool next(int i, Unit& u) const {
        const long L = (long)i * G + c; if (L >= nwg) return false;
        int wgid = (int)L; { const int q = nwg / NXCD, r = nwg % NXCD, xcd = wgid % NXCD, off = wgid / NXCD; wgid = (xcd < r ? xcd * (q + 1) : r * (q + 1) + (xcd - r) * q) + off; }
        const int nig = WGM * nN, gid = wgid / nig, fm = gid * WGM, gsz = (nM - fm) < WGM ? (nM - fm) : WGM;
        u.pm = fm + ((wgid % nig) % gsz); u.pn = (wgid % nig) / gsz; return true;
    }
    __device__ __forceinline__ void a_ready(const Unit&) const {}
    __device__ __forceinline__ void done(const Unit&) const {}
};

__device__ __forceinline__ unsigned cvt_pk_bf16(float lo, float hi) { unsigned r; asm volatile("v_cvt_pk_bf16_f32 %0, %1, %2" : "=v"(r) : "v"(lo), "v"(hi)); return r; }
typedef float f32x2 __attribute__((ext_vector_type(2)));
__device__ __forceinline__ f32x2 gelu_pk(f32x2 v) {
    const f32x2 av = __builtin_elementwise_abs(v), d = av * 0.2316418882f + 1.0f;
    f32x2 t; t.x = __builtin_amdgcn_rcpf(d.x); t.y = __builtin_amdgcn_rcpf(d.y);
    f32x2 q = t * 0.5307027145f + (-0.7265760135f); q = q * t + 0.7107068705f; q = q * t + (-0.142248368f); q = q * t + 0.127414796f; q = q * t;
    const f32x2 s = (v * v) * (-0.72134752044f);
    f32x2 e; e.x = __builtin_amdgcn_exp2f(s.x); e.y = __builtin_amdgcn_exp2f(s.y);
    const f32x2 m = v * (q * e), r = v - m;
    f32x2 o; o.x = v.x < 0.f ? m.x : r.x; o.y = v.y < 0.f ? m.y : r.y; return o;
}

template <int ACT  > struct EpiBf16 {
    static constexpr bool PERM = true, AFTER_DRAIN = false; static_assert(ACT == 0 || ACT == 1, "EpiBf16: ACT is 0 (none) or 1 (gelu_pk)");
    bf16_t* O; int ldc; const float* bias; int split_cols; size_t split_stride; float scale0;
    __device__ __forceinline__ void operator()(const f32x4 (&acc)[2][2][4][2], const Unit& u, int wr, int wc, int fr, int fq) const {
        const int row0 = u.pm * BM + wr * 64 + fr; int colt = u.pn * BM; bf16_t* base = O;
        float sc = 1.f; if (split_cols) { const int t = colt / split_cols; base += (size_t)t * split_stride; colt -= t * split_cols; if (t == 0) sc = scale0; }
        const int col0 = colt + wc * 32 + 8 * fq, bcol0 = u.pn * BM + wc * 32 + 8 * fq;
        f32x4 bv[2][2];
#pragma unroll
        for (int bj = 0; bj < 2; ++bj)
#pragma unroll
            for (int n = 0; n < 2; ++n) bv[bj][n] = bias ? *(const f32x4*)(bias + bcol0 + bj * HALF + 4 * n) : (f32x4){0.f, 0.f, 0.f, 0.f};
#pragma unroll
        for (int ai = 0; ai < 2; ++ai)
#pragma unroll
            for (int m = 0; m < 4; ++m) { bf16_t* rowp = base + (size_t)(row0 + ai * HALF + m * 16) * ldc + col0;
#pragma unroll
                for (int bj = 0; bj < 2; ++bj) { f32x4 v0 = acc[ai][bj][m][0] + bv[bj][0], v1 = acc[ai][bj][m][1] + bv[bj][1];
                    if (ACT == 1) { f32x2 a = gelu_pk((f32x2){v0[0], v0[1]}), b = gelu_pk((f32x2){v0[2], v0[3]}), c = gelu_pk((f32x2){v1[0], v1[1]}), d = gelu_pk((f32x2){v1[2], v1[3]});
                        v0 = (f32x4){a.x, a.y, b.x, b.y}; v1 = (f32x4){c.x, c.y, d.x, d.y}; }
                    v0 = v0 * sc; v1 = v1 * sc; u32x4 w; w.x = cvt_pk_bf16(v0[0], v0[1]); w.y = cvt_pk_bf16(v0[2], v0[3]); w.z = cvt_pk_bf16(v1[0], v1[1]); w.w = cvt_pk_bf16(v1[2], v1[3]);
                    __builtin_nontemporal_store(w, (u32x4*)(rowp + bj * HALF)); } }
    }
};

struct EpiResF32 {
    static constexpr bool PERM = false, AFTER_DRAIN = false;
    float* C; const float* R; int ldc;
    __device__ __forceinline__ void operator()(const f32x4 (&acc)[2][2][4][2], const Unit& u, int wr, int wc, int fr, int fq) const {
        const int row0 = u.pm * BM + wr * 64 + fr, col0 = u.pn * BM + wc * 32 + 4 * fq;
#pragma unroll
        for (int ai = 0; ai < 2; ++ai)
#pragma unroll
            for (int m = 0; m < 4; ++m) { const size_t off = (size_t)(row0 + ai * HALF + m * 16) * ldc + col0;
#pragma unroll
                for (int bj = 0; bj < 2; ++bj)
#pragma unroll
                    for (int n = 0; n < 2; ++n) { f32x4 r = (f32x4){0.f, 0.f, 0.f, 0.f}; if (R) r = *(const f32x4*)(R + off + bj * HALF + n * 16);
                        __builtin_nontemporal_store(acc[ai][bj][m][n] + r, (f32x4*)(C + off + bj * HALF + n * 16)); }
                asm volatile("" ::: "memory"); }
    }
};
struct EpiResBf16 {
    static constexpr bool PERM = true, AFTER_DRAIN = false;
    bf16_t* O; const float* R; int ldc;
    __device__ __forceinline__ void operator()(const f32x4 (&acc)[2][2][4][2], const Unit& u, int wr, int wc, int fr, int fq) const {
        const int row0 = u.pm * BM + wr * 64 + fr, col0 = u.pn * BM + wc * 32 + 8 * fq;
#pragma unroll
        for (int ai = 0; ai < 2; ++ai)
#pragma unroll
            for (int m = 0; m < 4; ++m) { const size_t off = (size_t)(row0 + ai * HALF + m * 16) * ldc + col0;
#pragma unroll
                for (int bj = 0; bj < 2; ++bj) { const f32x4 r0 = __builtin_nontemporal_load((const f32x4*)(R + off + bj * HALF)), r1 = __builtin_nontemporal_load((const f32x4*)(R + off + bj * HALF + 4));
                    const f32x4 v0 = acc[ai][bj][m][0] + r0, v1 = acc[ai][bj][m][1] + r1;
                    u32x4 w; w.x = cvt_pk_bf16(v0[0], v0[1]); w.y = cvt_pk_bf16(v0[2], v0[3]); w.z = cvt_pk_bf16(v1[0], v1[1]); w.w = cvt_pk_bf16(v1[2], v1[3]);
                    __builtin_nontemporal_store(w, (u32x4*)(O + off + bj * HALF)); }
                asm volatile("" ::: "memory"); }
    }
};
struct EpiProj {
    static constexpr bool PERM = true, AFTER_DRAIN = false;
    bf16_t* O; int ldc, ch_tile0, ch_tiles, u_col0;
    __device__ __forceinline__ void operator()(const f32x4 (&acc)[2][2][4][2], const Unit& u, int wr, int wc, int fr, int fq) const {
        const int row0 = u.pm * BM + wr * 64 + fr, cin = wc * 32 + 8 * fq;
        const bool chv = u.pn >= ch_tile0 && u.pn < ch_tile0 + ch_tiles;
        if (chv) { const int col0 = u_col0 + (u.pn - ch_tile0) * HALF + cin;
#pragma unroll
            for (int ai = 0; ai < 2; ++ai)
#pragma unroll
                for (int m = 0; m < 4; ++m) { const f32x4 v0 = acc[ai][0][m][0] * acc[ai][1][m][0], v1 = acc[ai][0][m][1] * acc[ai][1][m][1];
                    u32x4 w; w.x = cvt_pk_bf16(v0[0], v0[1]); w.y = cvt_pk_bf16(v0[2], v0[3]); w.z = cvt_pk_bf16(v1[0], v1[1]); w.w = cvt_pk_bf16(v1[2], v1[3]);
                    __builtin_nontemporal_store(w, (u32x4*)(O + (size_t)(row0 + ai * HALF + m * 16) * ldc + col0)); }
        } else { const int col0 = (u.pn >= ch_tile0 + ch_tiles ? u.pn - ch_tiles / 2 : u.pn) * BM + cin;
#pragma unroll
            for (int ai = 0; ai < 2; ++ai)
#pragma unroll
                for (int m = 0; m < 4; ++m) { bf16_t* rowp = O + (size_t)(row0 + ai * HALF + m * 16) * ldc + col0;
#pragma unroll
                    for (int bj = 0; bj < 2; ++bj) { const f32x4 v0 = acc[ai][bj][m][0], v1 = acc[ai][bj][m][1];
                        u32x4 w; w.x = cvt_pk_bf16(v0[0], v0[1]); w.y = cvt_pk_bf16(v0[2], v0[3]); w.z = cvt_pk_bf16(v1[0], v1[1]); w.w = cvt_pk_bf16(v1[2], v1[3]);
                        __builtin_nontemporal_store(w, (u32x4*)(rowp + bj * HALF)); } }
        }
    }
};
struct EpiRowScaleF32 {
    static constexpr bool PERM = false, AFTER_DRAIN = false;
    float* C; const float* rowscale; int ldc;
    __device__ __forceinline__ void operator()(const f32x4 (&acc)[2][2][4][2], const Unit& u, int wr, int wc, int fr, int fq) const {
        const int row0 = u.pm * BM + wr * 64 + fr, col0 = u.pn * BM + wc * 32 + 4 * fq;
#pragma unroll
        for (int ai = 0; ai < 2; ++ai)
#pragma unroll
            for (int m = 0; m < 4; ++m) { const int row = row0 + ai * HALF + m * 16; const float rsv = rowscale[row]; const size_t off = (size_t)row * ldc + col0;
#pragma unroll
                for (int bj = 0; bj < 2; ++bj)
#pragma unroll
                    for (int n = 0; n < 2; ++n) __builtin_nontemporal_store(acc[ai][bj][m][n] * rsv, (f32x4*)(C + off + bj * HALF + n * 16)); }
    }
};
template <class Epi, class Sched, bool ALIGN_EPI = false, bool SP2 = false>
__device__ __forceinline__ void gemm_phase(PG8_LAS unsigned char* lds, const Gemm g, const Sched& S, const Epi& E) {
    const int tid = threadIdx.x, wid = __builtin_amdgcn_readfirstlane(tid >> 6), lane = tid & 63, wr = wid >> 2, wc = wid & 3, fr = lane & 15, fq = lane >> 4;
    const int K = g.K, nt = K / BK;
    unsigned voffA[2], voffB[2];
#pragma unroll
    for (int i = 0; i < 2; ++i) { int R, C; stage_rc(tid * 16 + i * 8192, R, C); const int Rb = Epi::PERM ? ((R & ~31) + perm32(R & 31)) : R;
        voffA[i] = (unsigned)(R * K + C) * 2u; voffB[i] = (unsigned)(Rb * K + C) * 2u; }
    const size_t kstep = (size_t)(BK * 2);
    const size_t hstep = (size_t)HALF * K * 2;
    const size_t tstep = 2 * hstep;
    const unsigned ldsw = (unsigned)wid * 1024u;
    const int aoff = lds_byte(wr * 64 + fr, fq * 8), boff = lds_byte(wc * 32 + fr, fq * 8);
#define PG8_SA(b, h) (((b) * 2 + (h)) * HTB)
#define PG8_SB(b, h) ((4 + (b) * 2 + (h)) * HTB)
#define PG8_STAGE(bufoff, gbase, voff) do { _Pragma("unroll") for (int _i = 0; _i < 2; ++_i) \
        __builtin_amdgcn_global_load_lds((const unsigned*)((const char*)(gbase) + (voff)[_i]), (PG8_LAS unsigned*)(lds + (bufoff) + ldsw + _i * 8192), 16, 0, 0); } while (0)
#define PG8_LDA(dst, b, h) do { _Pragma("unroll") for (int m = 0; m < 4; ++m) _Pragma("unroll") for (int k = 0; k < 2; ++k) dst[m][k] = *(const PG8_LAS bf16x8*)(lds + PG8_SA(b, h) + aoff + m * 2048 + k * 1024); } while (0)
#define PG8_LDB(dst, b, h) do { _Pragma("unroll") for (int n = 0; n < 2; ++n) _Pragma("unroll") for (int k = 0; k < 2; ++k) dst[n][k] = *(const PG8_LAS bf16x8*)(lds + PG8_SB(b, h) + boff + n * 2048 + k * 1024); } while (0)
#define PG8_MMA(ai, bj, At, Bt) do { __builtin_amdgcn_s_setprio(1); _Pragma("unroll") for (int m = 0; m < 4; ++m) _Pragma("unroll") for (int n = 0; n < 2; ++n) _Pragma("unroll") for (int k = 0; k < 2; ++k) \
        acc[ai][bj][m][n] = __builtin_amdgcn_mfma_f32_16x16x32_bf16(Bt[n][k], At[m][k], acc[ai][bj][m][n], 0, 0, 0); __builtin_amdgcn_s_setprio(0); } while (0)
#define PG8_WAIT_V(n) asm volatile("s_waitcnt vmcnt(" #n ")" ::: "memory")
#define PG8_WAIT_L(n) asm volatile("s_waitcnt lgkmcnt(" #n ")" ::: "memory")
#define PG8_BAR __builtin_amdgcn_s_barrier()
#define PG8_SCHED __builtin_amdgcn_sched_barrier(0)
    Unit cur, nxt; int ui = 0;
    if (!S.next(0, cur)) return;
    f32x4 acc[2][2][4][2];
#pragma unroll
    for (int a = 0; a < 2; ++a)
#pragma unroll
        for (int b = 0; b < 2; ++b)
#pragma unroll
            for (int m = 0; m < 4; ++m)
#pragma unroll
                for (int n = 0; n < 2; ++n) acc[a][b][m][n] = (f32x4){0.f, 0.f, 0.f, 0.f};
    bf16x8 At[4][2], B0[2][2], B1[2][2];
    const char* cA = (const char*)g.A + (size_t)cur.pm * tstep; const char* cB = (const char*)g.Bt + (size_t)cur.pn * tstep;
    S.a_ready(cur);
    if constexpr (SP2) {
        PG8_STAGE(PG8_SB(0, 0), cB, voffB); PG8_STAGE(PG8_SB(0, 1), cB + hstep, voffB); PG8_STAGE(PG8_SA(0, 0), cA, voffA); PG8_STAGE(PG8_SA(0, 1), cA + hstep, voffA);
        if (wr == 1) PG8_BAR;
        PG8_WAIT_V(2); PG8_BAR;
        PG8_STAGE(PG8_SB(1, 0), cB + kstep, voffB); PG8_STAGE(PG8_SA(1, 0), cA + kstep, voffA); PG8_STAGE(PG8_SB(1, 1), cB + hstep + kstep, voffB);
        PG8_WAIT_V(6); PG8_BAR;
    } else {
        PG8_STAGE(PG8_SB(0, 0), cB, voffB); PG8_STAGE(PG8_SA(0, 0), cA, voffA); PG8_STAGE(PG8_SB(0, 1), cB + hstep, voffB); PG8_STAGE(PG8_SA(0, 1), cA + hstep, voffA);
        if (wr == 1) PG8_BAR;
        PG8_WAIT_V(4); PG8_BAR;
        PG8_STAGE(PG8_SB(1, 0), cB + kstep, voffB); PG8_STAGE(PG8_SA(1, 0), cA + kstep, voffA); PG8_STAGE(PG8_SB(1, 1), cB + hstep + kstep, voffB);
        PG8_WAIT_V(6); PG8_BAR;
    }
    for (;;) {
        const bool has_next = S.next(ui + 1, nxt);
        const char* nA = has_next ? (const char*)g.A + (size_t)nxt.pm * tstep : cA; const char* nB = has_next ? (const char*)g.Bt + (size_t)nxt.pn * tstep : cB;
        for (int t = 0; t < nt; t += 2) {
            const bool last = (t == nt - 2);
            const char* a1 = cA + (size_t)(t + 1) * kstep;
            const char* a2 = last ? nA : cA + (size_t)(t + 2) * kstep; const char* b2 = last ? nB : cB + (size_t)(t + 2) * kstep;
            const char* a3 = a2 + kstep; const char* b3 = b2 + kstep;
            if (last && has_next) S.a_ready(nxt);
            if constexpr (SP2) {
            PG8_LDB(B0, 0, 0); PG8_LDB(B1, 0, 1); PG8_SCHED; PG8_LDA(At, 0, 0); PG8_STAGE(PG8_SA(1, 1), a1 + hstep, voffA);
            PG8_WAIT_V(8); PG8_WAIT_L(0); PG8_BAR; PG8_MMA(0, 0, At, B0); PG8_MMA(0, 1, At, B1); PG8_BAR; PG8_SCHED;
            PG8_LDA(At, 0, 1); PG8_STAGE(PG8_SB(0, 0), b2, voffB); PG8_STAGE(PG8_SB(0, 1), b2 + hstep, voffB); PG8_STAGE(PG8_SA(0, 0), a2, voffA);
            PG8_WAIT_V(8); PG8_WAIT_L(0); PG8_BAR; PG8_MMA(1, 0, At, B0); PG8_MMA(1, 1, At, B1); PG8_BAR; PG8_SCHED;
            PG8_LDB(B0, 1, 0); PG8_LDB(B1, 1, 1); PG8_SCHED; PG8_LDA(At, 1, 0); PG8_STAGE(PG8_SA(0, 1), a2 + hstep, voffA);
            PG8_WAIT_V(8); PG8_WAIT_L(0); PG8_BAR; PG8_MMA(0, 0, At, B0); PG8_MMA(0, 1, At, B1); PG8_BAR; PG8_SCHED;
            PG8_LDA(At, 1, 1); PG8_STAGE(PG8_SB(1, 0), b3, voffB); PG8_STAGE(PG8_SB(1, 1), b3 + hstep, voffB); PG8_STAGE(PG8_SA(1, 0), a3, voffA);
            PG8_WAIT_V(8); PG8_WAIT_L(0); PG8_BAR; PG8_MMA(1, 0, At, B0); PG8_MMA(1, 1, At, B1); PG8_BAR; PG8_SCHED;
            } else {
            PG8_LDB(B0, 0, 0); PG8_SCHED; PG8_LDA(At, 0, 0); PG8_STAGE(PG8_SA(1, 1), a1 + hstep, voffA);
            PG8_WAIT_L(8); PG8_BAR; PG8_WAIT_L(0); PG8_MMA(0, 0, At, B0); PG8_BAR; PG8_SCHED;
            PG8_LDB(B1, 0, 1); PG8_STAGE(PG8_SB(0, 0), b2, voffB);
            PG8_BAR; PG8_WAIT_L(0); PG8_MMA(0, 1, At, B1); PG8_BAR;
            PG8_LDA(At, 0, 1); PG8_STAGE(PG8_SA(0, 0), a2, voffA);
            PG8_BAR; PG8_WAIT_L(0); PG8_MMA(1, 0, At, B0); PG8_BAR; PG8_SCHED;
            PG8_STAGE(PG8_SB(0, 1), b2 + hstep, voffB);
            PG8_WAIT_V(6); PG8_BAR; PG8_MMA(1, 1, At, B1); PG8_BAR;
            PG8_LDB(B0, 1, 0); PG8_SCHED; PG8_LDA(At, 1, 0); PG8_STAGE(PG8_SA(0, 1), a2 + hstep, voffA);
            PG8_WAIT_L(8); PG8_BAR; PG8_WAIT_L(0); PG8_MMA(0, 0, At, B0); PG8_BAR; PG8_SCHED;
            PG8_LDB(B1, 1, 1); PG8_STAGE(PG8_SB(1, 0), b3, voffB);
            PG8_BAR; PG8_WAIT_L(0); PG8_MMA(0, 1, At, B1); PG8_BAR;
            PG8_LDA(At, 1, 1); PG8_STAGE(PG8_SA(1, 0), a3, voffA);
            PG8_BAR; PG8_WAIT_L(0); PG8_MMA(1, 0, At, B0); PG8_BAR; PG8_SCHED;
            PG8_STAGE(PG8_SB(1, 1), b3 + hstep, voffB);
            PG8_WAIT_V(6); PG8_BAR; PG8_MMA(1, 1, At, B1); PG8_BAR;
            }
        }
        if constexpr (ALIGN_EPI) { if (wr == 0) PG8_BAR; }
        if constexpr (!Epi::AFTER_DRAIN) { E(acc, cur, wr, wc, fr, fq); S.done(cur); }
        if (!has_next) break;
#pragma unroll
        for (int a = 0; a < 2; ++a)
#pragma unroll
            for (int b = 0; b < 2; ++b)
#pragma unroll
                for (int m = 0; m < 4; ++m)
#pragma unroll
                    for (int n = 0; n < 2; ++n) acc[a][b][m][n] = (f32x4){0.f, 0.f, 0.f, 0.f};
        cur = nxt; cA = nA; cB = nB; ++ui;
        if constexpr (ALIGN_EPI) { if (wr == 1) PG8_BAR; }
    }
    PG8_WAIT_V(0);
    if constexpr (!ALIGN_EPI) { if (wr == 0) PG8_BAR; }
    PG8_BAR;
    if constexpr (Epi::AFTER_DRAIN) { E.fused(acc, cur, wr, wc, fr, fq, lds, wid, lane); S.done(cur); }
#undef PG8_SA
#undef PG8_SB
#undef PG8_STAGE
#undef PG8_LDA
#undef PG8_LDB
#undef PG8_MMA
#undef PG8_WAIT_V
#undef PG8_WAIT_L
#undef PG8_BAR
#undef PG8_SCHED
}
}
#ifndef PG8_SP2
#define PG8_SP2 true
#endif
#ifndef PG8_ALIGN
#define PG8_ALIGN true
#endif

constexpr int NWAVES = 8;
#ifndef MK_N_LAUNCHES
#define MK_N_LAUNCHES 1
#endif
constexpr int NPHASE = 9;
constexpr int N_LAUNCHES = MK_N_LAUNCHES;

constexpr int NB = 4, SEQ = 4096, M = NB * SEQ, D = 4096;
constexpr int D_SSD = 4096, D_CONV = 4096, D_MIX = 8192, NH = 64, HD = 64, NG = 8, NS = 128, D_XBC = 6144;
constexpr int NPROJ = 22592, NP = 22784, PP = NP - 4096;
constexpr int O_Z = 0, O_X = 4096, O_B = 8192, O_C = 9216, O_CH = 10240, O_U = 10240, R_SCB = 18432, R_DT = 22528, O_SCB = R_SCB - 4096, O_DT = R_DT - 4096, CH_TILE0 = O_CH / 256, CH_TILES = 32;
constexpr int SRC_DT = 10240, SRC_SCB = 10304, SRC_SCC = 14400, SRC_SCH = 18496;
__host__ __device__ constexpr int win_row_of_src_col(int n) {
    return n < SRC_DT ? n : n < SRC_SCB ? R_DT + (n - SRC_DT) : n < SRC_SCC ? R_SCB + (n - SRC_SCB)
         : n < SRC_SCH ? O_CH + ((n - SRC_SCC) >> 7) * 256 + ((n - SRC_SCC) & 127) : O_CH + ((n - SRC_SCH) >> 7) * 256 + 128 + ((n - SRC_SCH) & 127); }
constexpr int PH = 8, PK = 128, PTOP = 16, PQ = 2048, NEXP = 16384, HK = 128;
constexpr float EPS = 1e-6f;

constexpr size_t MiB = 1u << 20;
constexpr size_t WS_CTL = 0, CTL_ZERO_BYTES = 1 * MiB;
constexpr size_t WS_XN = 1 * MiB;
constexpr size_t WS_WIN = 129 * MiB;
constexpr size_t WS_WOUT = 307 * MiB;
constexpr size_t WS_WQ = 371 * MiB;
constexpr size_t WS_CONV = 1 * MiB;
constexpr size_t WS_Y = 387 * MiB;
constexpr size_t WS_PROJ = 643 * MiB;
constexpr size_t WS_U8 = 1227 * MiB;
constexpr size_t WS_V8 = 1291 * MiB;
constexpr size_t WS_SU = 1376 * MiB, WS_SV = 1376 * MiB + 65536;
constexpr size_t WS_XQ = 772 * MiB, WS_XS = 836 * MiB;
constexpr size_t WS_Q = 899 * MiB;
constexpr size_t WS_HB = 1027 * MiB;
constexpr size_t WS_SSQ = 1355 * MiB;
constexpr size_t WS_KH = 1359 * MiB;
constexpr size_t WS_IDX = 1360 * MiB;
constexpr size_t WS_GATE = 1368 * MiB;
constexpr size_t WS_END = 1377 * MiB;
static_assert(WS_WIN + (size_t)NP * D * 2 <= WS_WOUT && WS_Y + (size_t)M * D_MIX * 2 <= WS_PROJ && WS_PROJ + (size_t)M * PP * 2 <= WS_U8 && WS_V8 + (size_t)NEXP * D <= WS_SSQ && WS_Q + (size_t)M * PQ * 4 <= WS_SSQ, "d_ws map");
constexpr int CW_TMO = 0, CW_CODE = 1, CW_TICKET = 64;
constexpr int CW_BAR = 4096;

constexpr int RING_OFF = 0, RING_BYTES = 131072;
constexpr int LDSCTL_OFF = RING_BYTES, MISC_OFF = LDSCTL_OFF + 320;
constexpr int LDS_BYTES = 147456;
static_assert(MISC_OFF + 128 <= LDS_BYTES, "LDS map");

#define GAS __attribute__((address_space(1)))
#define LAS __attribute__((address_space(3)))
typedef unsigned short bf16;
typedef unsigned v4u __attribute__((ext_vector_type(4)));
typedef float f32x4 __attribute__((ext_vector_type(4)));
typedef short bf16x8 __attribute__((ext_vector_type(8)));
typedef GAS unsigned gu32;
typedef GAS unsigned long long gu64;
#define RLX_AGENT __ATOMIC_RELAXED, __HIP_MEMORY_SCOPE_AGENT
#define LDS_WAIT() asm volatile("s_waitcnt lgkmcnt(0)" ::: "memory")
#define VM_WAIT() asm volatile("s_waitcnt vmcnt(0)" ::: "memory")
__device__ __forceinline__ unsigned long long rt() { return __builtin_amdgcn_s_memrealtime(); }
__device__ __forceinline__ unsigned f2bf(float f) { unsigned u = __builtin_bit_cast(unsigned, f); return (u + 0x7fffu + ((u >> 16) & 1u)) >> 16; }
__device__ __forceinline__ unsigned pk2(float lo, float hi) { return f2bf(lo) | (f2bf(hi) << 16); }


#define XB_TMO      128
#define XB_XCNT(j)  (256  + 64 * (j))
#define XB_XSUB(j)  (1280 + 64 * (j))
#define XB_XGEN(j)  (2304 + 64 * (j))
#define XB_TOP      3328
#define XB_TOPGEN   3392
#define XCD_BAR_WORDS 3456
#define XB_SPIN_CAP (1u << 18)

__device__ __forceinline__ unsigned xb_ld(unsigned* p)              { return __hip_atomic_load(p, __ATOMIC_RELAXED, __HIP_MEMORY_SCOPE_AGENT); }
__device__ __forceinline__ unsigned xb_add(unsigned* p, unsigned v) { return __hip_atomic_fetch_add(p, v, __ATOMIC_RELAXED, __HIP_MEMORY_SCOPE_AGENT); }
__device__ __forceinline__ unsigned xb_xcc_id() { return (unsigned)__builtin_amdgcn_s_getreg((3 << 11) | 20) & 0xFu; }
#define XB_SPIN(cond, bar) do { unsigned _sp = 0; while (cond) { __builtin_amdgcn_s_sleep(1); \
    if ((++_sp & 255u) == 0u) { if (xb_ld(&(bar)[XB_TMO])) break; if (_sp > XB_SPIN_CAP) { atomicAdd(&(bar)[XB_TMO], 1u); break; } } } } while (0)

struct XcdBarrier {
    unsigned* bar; unsigned x;
    volatile LAS unsigned* st;
};

__device__ __forceinline__ XcdBarrier xcd_barrier_post(unsigned* bar, volatile LAS unsigned* st) {
    XcdBarrier b; b.bar = bar; b.x = xb_xcc_id(); b.st = st;
    if (threadIdx.x == 0) (void)xb_add(&bar[XB_XCNT(b.x)], 1u);
    return b;
}
__device__ __forceinline__ void xcd_barrier_complete(unsigned* bar, unsigned x, unsigned& nloc, unsigned& nx) {
    const unsigned G = gridDim.x * gridDim.y * gridDim.z;
    unsigned sum, cnt, mine, sp = 0u;
    for (;;) {
        sum = 0u; cnt = 0u; mine = 0u;
#pragma unroll
        for (unsigned j = 0; j < 16; ++j) { const unsigned c = xb_ld(&bar[XB_XCNT(j)]); sum += c; cnt += (c > 0u) ? 1u : 0u; mine = (j == x) ? c : mine; }
        if (sum == G) break;
        __builtin_amdgcn_s_sleep(1);
        if ((++sp & 255u) == 0u) { if (xb_ld(&bar[XB_TMO])) break; if (sp > XB_SPIN_CAP) { atomicAdd(&bar[XB_TMO], 1u); break; } }
    }
    nloc = mine > 0u ? mine : 1u; nx = cnt > 0u ? cnt : 1u;
}

__device__ __forceinline__ void xcd_barrier(const XcdBarrier& b) {
    asm volatile("s_waitcnt vmcnt(0)" ::: "memory");
    __syncthreads();
    if (threadIdx.x == 0) {
        unsigned* bar = b.bar;
        __builtin_amdgcn_s_waitcnt(0);
        unsigned nloc = b.st[0], nx = b.st[1];
        if (nloc == 0u) { xcd_barrier_complete(bar, b.x, nloc, nx); b.st[0] = nloc; b.st[1] = nx; }
        const unsigned old = xb_add(&bar[XB_XSUB(b.x)], 1u);
        const unsigned gen = old / nloc;
        if (old + 1u == (gen + 1u) * nloc) {
            __builtin_amdgcn_fence(__ATOMIC_RELEASE, "agent");
            asm volatile("s_waitcnt vmcnt(0)" ::: "memory");
            const unsigned og = xb_add(&bar[XB_TOP], 1u);
            const unsigned tg = og / nx;
            if (og + 1u == (tg + 1u) * nx) xb_add(&bar[XB_TOPGEN], 1u);
            else XB_SPIN(xb_ld(&bar[XB_TOPGEN]) == tg, bar);
            __builtin_amdgcn_fence(__ATOMIC_ACQUIRE, "agent");
            xb_add(&bar[XB_XGEN(b.x)], 1u);
            asm volatile("s_waitcnt vmcnt(0)" ::: "memory");
        } else {
            XB_SPIN(xb_ld(&bar[XB_XGEN(b.x)]) == gen, bar);
            __builtin_amdgcn_fence(__ATOMIC_ACQUIRE, "agent");
            asm volatile("s_waitcnt vmcnt(0)" ::: "memory");
        }
    }
    __syncthreads();
}


#ifndef PROBE_REP
#define PROBE_REP 0
#endif
#define NREP(k) (1 + (((PROBE_REP) >> (k)) & 1))
typedef unsigned u32x4 __attribute__((ext_vector_type(4)));
typedef unsigned u32x2 __attribute__((ext_vector_type(2)));
typedef float f32x2 __attribute__((ext_vector_type(2)));
typedef __bf16 bf2_t __attribute__((ext_vector_type(2)));

__device__ __forceinline__ float wave_sum(float v) {
#pragma unroll
    for (int o = 1; o < 64; o <<= 1) v += __shfl_xor(v, o);
    return v;
}
__device__ __forceinline__ unsigned cvtpk(float lo, float hi) { unsigned r; asm volatile("v_cvt_pk_bf16_f32 %0, %1, %2" : "=v"(r) : "v"(lo), "v"(hi)); return r; }
__device__ __forceinline__ float bflo(unsigned w) { return __uint_as_float(w << 16); }
__device__ __forceinline__ float bfhi(unsigned w) { return __uint_as_float(w & 0xffff0000u); }
__device__ __forceinline__ float siluf(float x) { return x * __builtin_amdgcn_rcpf(1.0f + __expf(-x)); }
__device__ __forceinline__ float dot2bf(unsigned a, unsigned b, float c) { return __builtin_amdgcn_fdot2_f32_bf16(__builtin_bit_cast(bf2_t, a), __builtin_bit_cast(bf2_t, b), c, false); }

__device__ __forceinline__ void p0_transpose_item(const float* W, int K, int N, bf16* WT, bool remap, const float* kgain, LAS float* scr, int item, int lane) {
    const int nblk = N / 32, kb = item / nblk, nb = item % nblk, k0 = 64 * kb, n0 = 32 * nb, d0 = remap ? win_row_of_src_col(n0) : n0;
#pragma unroll 8
    for (int i = 0; i < 32; ++i) { const int kk = 2 * i + (lane >> 5); scr[kk * 33 + (lane & 31)] = __builtin_nontemporal_load((const GAS float*)W + ((size_t)(k0 + kk) * N + n0 + (lane & 31))) * (kgain ? kgain[k0 + kk] : 1.0f); }
    LDS_WAIT(); asm volatile("" ::: "memory");
    const int c = lane & 7;
#pragma unroll
    for (int j = 0; j < 4; ++j) { const int n = (lane >> 3) + 8 * j; const LAS float* s = scr + (8 * c) * 33 + n;
        v4u o; o.x = pk2(s[0 * 33], s[1 * 33]); o.y = pk2(s[2 * 33], s[3 * 33]); o.z = pk2(s[4 * 33], s[5 * 33]); o.w = pk2(s[6 * 33], s[7 * 33]);
        *(GAS v4u*)(WT + (size_t)(d0 + n) * K + k0 + 8 * c) = o; }
    LDS_WAIT(); asm volatile("" ::: "memory");
}
__device__ __forceinline__ void rms_row_to_bf16(const float* xrow, const float* w, bf16* orow, int lane) {
    const GAS f32x4* xr = (const GAS f32x4*)xrow + lane;
    f32x4 v[16]; float s = 0.f;
#pragma unroll
    for (int j = 0; j < 16; ++j) { v[j] = __builtin_nontemporal_load(xr + 64 * j); s += (v[j].x * v[j].x + v[j].y * v[j].y) + (v[j].z * v[j].z + v[j].w * v[j].w); }
    const float rs = 1.0f / sqrtf(wave_sum(s) * (1.f / D) + EPS);
    const GAS f32x4* wr = (const GAS f32x4*)w + lane;
    GAS u32x2* o8 = (GAS u32x2*)orow + lane;
#pragma unroll
    for (int j = 0; j < 16; ++j) { const f32x4 g = wr[64 * j]; u32x2 o; o.x = cvtpk(v[j].x * rs * g.x, v[j].y * rs * g.y); o.y = cvtpk(v[j].z * rs * g.z, v[j].w * rs * g.w); o8[64 * j] = o; }
}

__device__ __forceinline__ void unpack8(const u32x4 v, float (&f)[8]) { f[0] = bflo(v.x); f[1] = bfhi(v.x); f[2] = bflo(v.y); f[3] = bfhi(v.y); f[4] = bflo(v.z); f[5] = bfhi(v.z); f[6] = bflo(v.w); f[7] = bfhi(v.w); }
__device__ __forceinline__ unsigned pack_i8x4(float a, float b, float c, float d) {
    const int ia = __float2int_rn(a), ib = __float2int_rn(b), ic = __float2int_rn(c), id = __float2int_rn(d);
    return ((unsigned)ia & 0xffu) | (((unsigned)ib & 0xffu) << 8) | (((unsigned)ic & 0xffu) << 16) | ((unsigned)id << 24);
}
__device__ __forceinline__ void rms_row_to_bf16_i8(const bf16* hrow, const float* w, float* rsout, unsigned char* qrow, float* qscale, int lane) {
    const GAS u32x4* hr = (const GAS u32x4*)hrow + lane;
    float v[8][8]; float s = 0.f;
#pragma unroll
    for (int j = 0; j < 8; ++j) { const u32x4 t = hr[64 * j]; v[j][0] = bflo(t.x); v[j][1] = bfhi(t.x); v[j][2] = bflo(t.y); v[j][3] = bfhi(t.y); v[j][4] = bflo(t.z); v[j][5] = bfhi(t.z); v[j][6] = bflo(t.w); v[j][7] = bfhi(t.w);
#pragma unroll
        for (int k = 0; k < 8; ++k) s += v[j][k] * v[j][k]; }
    const float rs = 1.0f / sqrtf(wave_sum(s) * (1.f / D) + EPS);
    float am = 0.f; if (lane == 0) *rsout = rs;
#pragma unroll
    for (int j = 0; j < 8; ++j) { const GAS f32x4* wp = (const GAS f32x4*)(w + (j * 64 + lane) * 8); const f32x4 ga = wp[0], gb = wp[1]; const float g[8] = {ga.x, ga.y, ga.z, ga.w, gb.x, gb.y, gb.z, gb.w};
#pragma unroll
        for (int k = 0; k < 8; ++k) { v[j][k] *= rs * g[k]; am = fmaxf(am, fabsf(v[j][k])); }
        }
#pragma unroll
    for (int o = 1; o < 64; o <<= 1) am = fmaxf(am, __shfl_xor(am, o));
    const float sc = am > 0.f ? am * (1.0f / 127.0f) : 1.0f, inv = 1.0f / sc;
    GAS u32x2* q8 = (GAS u32x2*)qrow + lane;
#pragma unroll
    for (int j = 0; j < 8; ++j) { u32x2 p; p.x = pack_i8x4(v[j][0] * inv, v[j][1] * inv, v[j][2] * inv, v[j][3] * inv); p.y = pack_i8x4(v[j][4] * inv, v[j][5] * inv, v[j][6] * inv, v[j][7] * inv); q8[64 * j] = p; }
    if (lane == 0) *qscale = sc;
}

__device__ __forceinline__ u32x4 pack8(const float (&f)[8]) { u32x4 o; o.x = cvtpk(f[0], f[1]); o.y = cvtpk(f[2], f[3]); o.z = cvtpk(f[4], f[5]); o.w = cvtpk(f[6], f[7]); return o; }
__device__ __forceinline__ void conv_prepass(const bf16* PROJ, const float* conv_w, const float* conv_b, bf16* CONV, int gtid, int gthreads) {
    constexpr int NCG = D_XBC / 8, NSEG = SEQ / 16, NIT = NB * NSEG * NCG;
    int it = gtid; if (it >= NIT) return;
#define CP_ITEM(IT, CG, ROW, Z) do { const int _bs = (IT) / NCG; CG = (IT) % NCG; const int _seg = _bs % NSEG, _b = _bs / NSEG; Z = (_seg == 0); ROW = _b * SEQ + _seg * 16; } while (0)
#define CP_SRC(ROW, CG) (PROJ + (size_t)(ROW) * PP + O_X + (CG) * 8)
    int cg, row; bool z0; CP_ITEM(it, cg, row, z0); const bf16* src = CP_SRC(row, cg);
    u32x4 raw[19];
#pragma unroll
    for (int rr = 0; rr < 19; ++rr) raw[rr] = __builtin_nontemporal_load((const GAS u32x4*)(src + (ptrdiff_t)((rr >= 3 || !z0) ? rr - 3 : 0) * PP));
    for (;;) {
        const int itn = it + gthreads; const bool has_next = itn < NIT;
        int cgn = cg, rown = row; bool zn = z0; if (has_next) CP_ITEM(itn, cgn, rown, zn); const bf16* srcn = CP_SRC(rown, cgn);
        const int ch = cg * 8;
        float w[4][8], bias[8];
#pragma unroll
        for (int k = 0; k < 4; ++k) { const f32x4 wa = *(const GAS f32x4*)(conv_w + (size_t)k * D_XBC + ch), wb = *(const GAS f32x4*)(conv_w + (size_t)k * D_XBC + ch + 4);
            w[k][0] = wa.x; w[k][1] = wa.y; w[k][2] = wa.z; w[k][3] = wa.w; w[k][4] = wb.x; w[k][5] = wb.y; w[k][6] = wb.z; w[k][7] = wb.w; }
        { const f32x4 ba = *(const GAS f32x4*)(conv_b + ch), bb = *(const GAS f32x4*)(conv_b + ch + 4); bias[0] = ba.x; bias[1] = ba.y; bias[2] = ba.z; bias[3] = ba.w; bias[4] = bb.x; bias[5] = bb.y; bias[6] = bb.z; bias[7] = bb.w; }
        float win[3][8];
#pragma unroll
        for (int rr = 0; rr < 3; ++rr) { const u32x4 v = z0 ? (u32x4){0u, 0u, 0u, 0u} : raw[rr]; unpack8(v, win[rr]);
            if (has_next) raw[rr] = __builtin_nontemporal_load((const GAS u32x4*)(srcn + (ptrdiff_t)(zn ? 0 : rr - 3) * PP)); }
        bf16* dst = CONV + (size_t)row * D_XBC + ch;
#pragma unroll
        for (int i = 0; i < 16; ++i) { float cur[8], o[8]; unpack8(raw[3 + i], cur);
            if (has_next) raw[3 + i] = __builtin_nontemporal_load((const GAS u32x4*)(srcn + (ptrdiff_t)i * PP));
#pragma unroll
            for (int j = 0; j < 8; ++j) { o[j] = siluf(bias[j] + w[0][j] * win[0][j] + w[1][j] * win[1][j] + w[2][j] * win[2][j] + w[3][j] * cur[j]); win[0][j] = win[1][j]; win[1][j] = win[2][j]; win[2][j] = cur[j]; }
            *(GAS u32x4*)(dst + (size_t)i * D_XBC) = pack8(o); }
        if (!has_next) break;
        it = itn; cg = cgn; row = rown; src = srcn; z0 = zn;
    }
#undef CP_ITEM
#undef CP_SRC
}
constexpr int C_CM = 0, C_BM = 32768, C_BTW = 65536, C_XDT = 98304, C_XB = 114688, C_SM = LDSCTL_OFF + 512;
static_assert(C_XB + 16384 <= RING_BYTES && C_SM + 2 * 2048 + 2048 <= LDS_BYTES, "ssd lds");
__device__ __forceinline__ int sw256(int r, int c) { return r * 256 + ((c ^ (r & 15)) << 4); }
__device__ __forceinline__ int sw128(int r, int c) { return r * 128 + ((c ^ (r & 7)) << 4); }
__device__ __forceinline__ int swT(int r, int c) { return r * 256 + ((c ^ (((r >> 3) ^ r) & 15)) << 4); }
__device__ __forceinline__ float wave_incl_scan(float x) {
    x += __builtin_bit_cast(float, __builtin_amdgcn_update_dpp(0, __builtin_bit_cast(int, x), 0x111, 0xf, 0xf, true));
    x += __builtin_bit_cast(float, __builtin_amdgcn_update_dpp(0, __builtin_bit_cast(int, x), 0x112, 0xf, 0xf, true));
    x += __builtin_bit_cast(float, __builtin_amdgcn_update_dpp(0, __builtin_bit_cast(int, x), 0x114, 0xf, 0xf, true));
    x += __builtin_bit_cast(float, __builtin_amdgcn_update_dpp(0, __builtin_bit_cast(int, x), 0x118, 0xf, 0xf, true));
    x += __builtin_bit_cast(float, __builtin_amdgcn_update_dpp(0, __builtin_bit_cast(int, x), 0x142, 0xa, 0xf, true));
    x += __builtin_bit_cast(float, __builtin_amdgcn_update_dpp(0, __builtin_bit_cast(int, x), 0x143, 0xc, 0xf, true));
    return x;
}
__device__ __forceinline__ void ssd_dt_scan(LAS float* sm, float r0, float r1, float a_neg, int lane) {
    const float d0 = r0 > 20.f ? r0 : __logf(1.0f + __expf(r0)), d1 = r1 > 20.f ? r1 : __logf(1.0f + __expf(r1));
    const float v0 = wave_incl_scan(d0 * a_neg); float v1 = wave_incl_scan(d1 * a_neg);
    v1 += __shfl(v0, 63);
    const float aend = __shfl(v1, 63);
    sm[lane] = d0; sm[64 + lane] = d1; sm[128 + lane] = v0; sm[192 + lane] = v1;
    sm[256 + lane] = __expf(aend - v0); sm[320 + lane] = __expf(aend - v1); sm[384 + lane] = __expf(v0); sm[448 + lane] = __expf(v1);
}
__device__ __forceinline__ void ssd_unit(LAS unsigned char* lds, int b, int h, const bf16* PROJ, const bf16* CONV, const float* dt_bias, const float* a_log, const float* ssd_d,
                                         bf16* Y, float* SSQ, int tid, int wave, int lane) {
    LAS float* smb = (LAS float*)(lds + C_SM); LAS float* ssqp = smb + 1024;
    const int g = h >> 3, pb = wave & 3, th = wave >> 2;
    const float a_neg = -__expf(a_log[h]), dtb = dt_bias[h], Dh = ssd_d[h];
    const size_t rowbase = (size_t)b * SEQ;
    const GAS unsigned char* convb = (const GAS unsigned char*)CONV; const GAS unsigned char* projb = (const GAS unsigned char*)PROJ; GAS unsigned char* yb = (GAS unsigned char*)Y; GAS unsigned char* ssqb = (GAS unsigned char*)SSQ;
#define SSD_ROLES(TT, LL) \
    const bool xitem = (TT) < 128, bitem = (TT) >= 128 && (TT) < 384; \
    const int icg = xitem ? ((TT) & 7) : (((TT) - 128) & 15), its = xitem ? ((TT) >> 3) : (((TT) - 128) >> 4); \
    const unsigned toff = (unsigned)(((rowbase + its * 8) * D_XBC + (xitem ? h * 64 + icg * 8 : D_SSD + g * 128 + icg * 8)) * 2); \
    const unsigned coff = (unsigned)(((rowbase + ((TT) >> 4)) * D_XBC + D_SSD + NG * NS + g * 128 + ((TT) & 15) * 8) * 2); \
    const unsigned doff = (unsigned)(((rowbase + (LL)) * PP + O_DT + h) * 2); \
    const int r = (LL) & 15, q = (LL) >> 4;
    f32x4 ST[8];
#pragma unroll
    for (int i = 0; i < 8; ++i) ST[i] = (f32x4){0.f, 0.f, 0.f, 0.f};
    u32x4 pft[8], pfc[4]; float dr0 = 0.f, dr1 = 0.f;
#define SSD_LBAR() do { asm volatile("s_waitcnt lgkmcnt(0)" ::: "memory"); __builtin_amdgcn_s_barrier(); asm volatile("" ::: "memory"); } while (0)
#define SSD_PREFETCH(cc) do { const unsigned _ro = (unsigned)(cc) * (128u * D_XBC * 2u); \
        if (xitem || bitem) { _Pragma("unroll") for (int _i = 0; _i < 8; ++_i) pft[_i] = *(const GAS u32x4*)(convb + (toff + _ro + (unsigned)_i * (D_XBC * 2u))); } \
        _Pragma("unroll") for (int _k = 0; _k < 4; ++_k) pfc[_k] = *(const GAS u32x4*)(convb + (coff + _ro + (unsigned)_k * (32u * D_XBC * 2u))); } while (0)
#define SSD_DTLOAD(cc) do { if (wave == 0) { const unsigned _o = doff + (unsigned)(cc) * (128u * PP * 2u); \
        dr0 = __uint_as_float((unsigned)*(const GAS unsigned short*)(projb + _o) << 16) + dtb; dr1 = __uint_as_float((unsigned)*(const GAS unsigned short*)(projb + (_o + 64u * PP * 2u)) << 16) + dtb; } } while (0)
    { SSD_ROLES(tid, lane) SSD_DTLOAD(0); SSD_PREFETCH(0); (void)r; (void)q; }
    if (wave == 0) ssd_dt_scan(smb, dr0, dr1, a_neg, lane);
    for (int c = 0; c < SEQ / 128; ++c) {
        const int t0 = c * 128, cn = c + 1 < SEQ / 128 ? c + 1 : c;
        int tt = tid, ll = lane; asm volatile("" : "+v"(tt), "+v"(ll));
        SSD_ROLES(tt, ll)
        LAS float* dtv = smb + (c & 1) * 512; LAS float* acum = dtv + 128; LAS float* wend = dtv + 256; LAS float* eac = dtv + 384;
        SSD_LBAR();
        if (c > 0 && tt < 128) *(GAS float*)(ssqb + (unsigned)(((rowbase + t0 - 128 + tt) * NH + h) * 4)) = (ssqp[tt] + ssqp[128 + tt]) + (ssqp[256 + tt] + ssqp[384 + tt]);
#pragma unroll
        for (int k = 0; k < 4; ++k) *(LAS u32x4*)(lds + C_CM + sw256((tt >> 4) + 32 * k, tt & 15)) = pfc[k];
        if (xitem || bitem) {
            const LAS float* sc = xitem ? dtv : wend; const f32x4 sa = *(const LAS f32x4*)(sc + its * 8), sb2 = *(const LAS f32x4*)(sc + its * 8 + 4); const float s8[8] = {sa.x, sa.y, sa.z, sa.w, sb2.x, sb2.y, sb2.z, sb2.w};
            float o[8][8];
#pragma unroll
            for (int i = 0; i < 8; ++i) { unpack8(pft[i], o[i]);
                if (xitem) *(LAS u32x4*)(lds + C_XB + sw128(its * 8 + i, icg)) = pft[i]; else *(LAS u32x4*)(lds + C_BM + sw256(its * 8 + i, icg)) = pft[i]; }
#pragma unroll
            for (int j = 0; j < 8; ++j) { const float f[8] = {o[0][j] * s8[0], o[1][j] * s8[1], o[2][j] * s8[2], o[3][j] * s8[3], o[4][j] * s8[4], o[5][j] * s8[5], o[6][j] * s8[6], o[7][j] * s8[7]};
                *(LAS u32x4*)(lds + (xitem ? C_XDT : C_BTW) + swT(icg * 8 + j, its)) = pack8(f); }
        }
        SSD_DTLOAD(cn);
        SSD_LBAR();
        if (wave == 0) ssd_dt_scan(smb + ((c + 1) & 1) * 512, dr0, dr1, a_neg, ll);
        f32x4 cb[8];
        {   bf16x8 cfr[4];
#pragma unroll
            for (int ks = 0; ks < 4; ++ks) cfr[ks] = *(const LAS bf16x8*)(lds + C_CM + sw256(16 * wave + r, 4 * ks + q));
#pragma unroll
            for (int sp = 0; sp < 4; ++sp) { cb[2 * sp] = (f32x4){0.f, 0.f, 0.f, 0.f}; cb[2 * sp + 1] = (f32x4){0.f, 0.f, 0.f, 0.f};
                if (2 * sp <= wave) {
                    bf16x8 a0[4], a1[4];
#pragma unroll
                    for (int ks = 0; ks < 4; ++ks) { a0[ks] = *(const LAS bf16x8*)(lds + C_BM + sw256(32 * sp + r, 4 * ks + q)); a1[ks] = *(const LAS bf16x8*)(lds + C_BM + sw256(32 * sp + 16 + r, 4 * ks + q)); }
                    __builtin_amdgcn_sched_barrier(0);
#pragma unroll
                    for (int ks = 0; ks < 4; ++ks) { cb[2 * sp] = __builtin_amdgcn_mfma_f32_16x16x32_bf16(a0[ks], cfr[ks], cb[2 * sp], 0, 0, 0); cb[2 * sp + 1] = __builtin_amdgcn_mfma_f32_16x16x32_bf16(a1[ks], cfr[ks], cb[2 * sp + 1], 0, 0, 0); }
                    __builtin_amdgcn_sched_barrier(0); } } }
        SSD_LBAR();
        {   const float ac_t = acum[16 * wave + r]; const int row = 16 * wave + r;
#pragma unroll
            for (int sb = 0; sb < 8; ++sb) {
                if (sb <= wave) { const f32x4 as4 = *(const LAS f32x4*)(acum + 16 * sb + 4 * q); float m[4];
#pragma unroll
                    for (int j = 0; j < 4; ++j) { const float e = __expf(fminf(ac_t - as4[j], 0.f)); m[j] = (sb == wave && 4 * q + j > r) ? 0.f : cb[sb][j] * e; }
                    u32x2 pk; pk.x = cvtpk(m[0], m[1]); pk.y = cvtpk(m[2], m[3]);
                    *(LAS u32x2*)(lds + C_BM + row * 256 + (((2 * sb + (q >> 1)) ^ (row & 15)) << 4) + (q & 1) * 8) = pk;
                } else if (sb == wave + 1 && !(wave & 1)) {
                    *(LAS u32x2*)(lds + C_BM + row * 256 + (((2 * sb + (q >> 1)) ^ (row & 15)) << 4) + (q & 1) * 8) = (u32x2){0u, 0u}; } } }
        u32x2 zv[4];
#pragma unroll
        for (int j = 0; j < 4; ++j) zv[j] = *(const GAS u32x2*)(projb + (unsigned)(((rowbase + t0 + 16 * (4 * th + j) + r) * PP + O_Z + h * 64 + 16 * pb + 4 * q) * 2));
        SSD_PREFETCH(cn);
        SSD_LBAR();
        bf16x8 xfr[4], sfr[4];
#pragma unroll
        for (int ks = 0; ks < 4; ++ks) { xfr[ks] = *(const LAS bf16x8*)(lds + C_XDT + swT(16 * pb + r, 4 * ks + q));
            sfr[ks] = __builtin_bit_cast(bf16x8, (u32x4){cvtpk(ST[2 * ks][0], ST[2 * ks][1]), cvtpk(ST[2 * ks][2], ST[2 * ks][3]), cvtpk(ST[2 * ks + 1][0], ST[2 * ks + 1][1]), cvtpk(ST[2 * ks + 1][2], ST[2 * ks + 1][3])}); }
#pragma unroll
        for (int j = 0; j < 4; ++j) {
            const int tb = 4 * th + j, trow = 16 * tb + r; const size_t grow = rowbase + t0 + trow; const int p0 = 16 * pb + 4 * q;
            f32x4 ad = (f32x4){0.f, 0.f, 0.f, 0.f}, ao = (f32x4){0.f, 0.f, 0.f, 0.f};
            bf16x8 mmf[4]; u32x2 clo[4], chi[4];
            {   const int cbase = C_CM + trow * 256 + (q & 1) * 8;
#pragma unroll
                for (int ks = 0; ks < 4; ++ks) { mmf[ks] = *(const LAS bf16x8*)(lds + C_BM + sw256(trow, 4 * ks + q));
                    clo[ks] = *(const LAS u32x2*)(lds + cbase + (((4 * ks + (q >> 1)) ^ (trow & 15)) << 4)); chi[ks] = *(const LAS u32x2*)(lds + cbase + (((4 * ks + 2 + (q >> 1)) ^ (trow & 15)) << 4)); } }
            __builtin_amdgcn_sched_barrier(0);
#pragma unroll
            for (int ks = 0; ks < 4; ++ks) { if (2 * ks <= tb) ad = __builtin_amdgcn_mfma_f32_16x16x32_bf16(xfr[ks], mmf[ks], ad, 0, 0, 0);
                ao = __builtin_amdgcn_mfma_f32_16x16x32_bf16(sfr[ks], __builtin_bit_cast(bf16x8, (u32x4){clo[ks].x, clo[ks].y, chi[ks].x, chi[ks].y}), ao, 0, 0, 0); }
            __builtin_amdgcn_sched_barrier(0);
            const float ea = eac[trow];
            const u32x2 xv = *(const LAS u32x2*)(lds + C_XB + trow * 128 + (((2 * pb + (q >> 1)) ^ (trow & 7)) << 4) + (q & 1) * 8);
            const float xx[4] = {bflo(xv.x), bfhi(xv.x), bflo(xv.y), bfhi(xv.y)}, zz[4] = {bflo(zv[j].x), bfhi(zv[j].x), bflo(zv[j].y), bfhi(zv[j].y)};
            float y[4], sq = 0.f;
#pragma unroll
            for (int k = 0; k < 4; ++k) { y[k] = (ad[k] + ea * ao[k] + Dh * xx[k]) * siluf(zz[k]); sq += y[k] * y[k]; }
            u32x2 ov; ov.x = cvtpk(y[0], y[1]); ov.y = cvtpk(y[2], y[3]);
            *(GAS u32x2*)(yb + (unsigned)((grow * D_MIX + h * 64 + p0) * 2)) = ov;
            sq += __shfl_xor(sq, 16); sq += __shfl_xor(sq, 32);
            if (q == 0) ssqp[pb * 128 + trow] = sq;
            __builtin_amdgcn_sched_barrier(0);
        }
        {   const float dend = __expf(acum[127]);
#pragma unroll
            for (int np = 0; np < 4; ++np) { ST[2 * np] = ST[2 * np] * dend; ST[2 * np + 1] = ST[2 * np + 1] * dend;
                bf16x8 a0[4], a1[4];
#pragma unroll
                for (int ks = 0; ks < 4; ++ks) { a0[ks] = *(const LAS bf16x8*)(lds + C_BTW + swT(32 * np + r, 4 * ks + q)); a1[ks] = *(const LAS bf16x8*)(lds + C_BTW + swT(32 * np + 16 + r, 4 * ks + q)); }
                __builtin_amdgcn_sched_barrier(0);
#pragma unroll
                for (int ks = 0; ks < 4; ++ks) { ST[2 * np] = __builtin_amdgcn_mfma_f32_16x16x32_bf16(a0[ks], xfr[ks], ST[2 * np], 0, 0, 0); ST[2 * np + 1] = __builtin_amdgcn_mfma_f32_16x16x32_bf16(a1[ks], xfr[ks], ST[2 * np + 1], 0, 0, 0); }
                __builtin_amdgcn_sched_barrier(0); } }
    }
#undef SSD_ROLES
#undef SSD_LBAR
#undef SSD_PREFETCH
#undef SSD_DTLOAD
    __syncthreads();
    if (tid < 128) *(GAS float*)(ssqb + (unsigned)(((rowbase + SEQ - 128 + tid) * NH + h) * 4)) = (ssqp[tid] + ssqp[128 + tid]) + (ssqp[256 + tid] + ssqp[384 + tid]);
}

__device__ __forceinline__ void p3_rows2(int row0, const bf16* PROJ, const float* sc_w, const float* sc_nw, const float* ssd_nw, const float* SSQ, bf16* Y, LAS unsigned char* scr, int lane) {
    const int s0 = row0 & (SEQ - 1); const bool halo = s0 >= 2;
    const bf16* pr = PROJ + (size_t)row0 * PP + lane * 8;
    float ss0 = 0.f, ss1 = 0.f;
#pragma unroll 2
    for (int i = 0; i < 8; ++i) {
        const int c0 = (i * 64 + lane) * 8; const bf16* q = pr + i * 512; const bf16* qh = halo ? q : q + 2 * PP;
        const u32x4 um2v = *(const GAS u32x4*)(qh - 2 * PP + O_U), um1v = *(const GAS u32x4*)(qh - PP + O_U), u0v = *(const GAS u32x4*)(q + O_U), u1v = *(const GAS u32x4*)(q + PP + O_U);
        const u32x4 b0v = *(const GAS u32x4*)(q + O_SCB), b1v = *(const GAS u32x4*)(q + PP + O_SCB);
        const f32x4 w0a = *(const GAS f32x4*)(sc_w + c0), w0b = *(const GAS f32x4*)(sc_w + c0 + 4), w1a = *(const GAS f32x4*)(sc_w + D_CONV + c0), w1b = *(const GAS f32x4*)(sc_w + D_CONV + c0 + 4),
                    w2a = *(const GAS f32x4*)(sc_w + 2 * D_CONV + c0), w2b = *(const GAS f32x4*)(sc_w + 2 * D_CONV + c0 + 4);
        const float w0[8] = {w0a.x, w0a.y, w0a.z, w0a.w, w0b.x, w0b.y, w0b.z, w0b.w}, w1[8] = {w1a.x, w1a.y, w1a.z, w1a.w, w1b.x, w1b.y, w1b.z, w1b.w}, w2[8] = {w2a.x, w2a.y, w2a.z, w2a.w, w2b.x, w2b.y, w2b.z, w2b.w};
        float um2[8], um1[8], u0[8], u1[8], b0[8], b1[8];
        unpack8(um2v, um2); unpack8(um1v, um1); unpack8(u0v, u0); unpack8(u1v, u1);
#pragma unroll
        for (int j = 0; j < 8; ++j) { um2[j] = halo ? um2[j] : 0.f; um1[j] = halo ? um1[j] : 0.f; }
        unpack8(b0v, b0); unpack8(b1v, b1);
        float y0[8], y1[8];
#pragma unroll
        for (int j = 0; j < 8; ++j) { y0[j] = b0[j] * (w2[j] * u0[j] + w0[j] * um2[j] + w1[j] * um1[j]); y1[j] = b1[j] * (w2[j] * u1[j] + w0[j] * um1[j] + w1[j] * u0[j]); ss0 += y0[j] * y0[j]; ss1 += y1[j] * y1[j]; }
        *(LAS u32x4*)(scr + c0 * 2) = pack8(y0); *(LAS u32x4*)(scr + 8192 + c0 * 2) = pack8(y1);
    }
    const float rs0 = 1.0f / sqrtf(wave_sum(ss0) * (1.f / D_CONV) + EPS), rs1 = 1.0f / sqrtf(wave_sum(ss1) * (1.f / D_CONV) + EPS);
    bf16* yrow = Y + (size_t)row0 * D_MIX + lane * 8;
#pragma unroll 2
    for (int i = 0; i < 8; ++i) { const int c0 = (i * 64 + lane) * 8;
        float f0[8], f1[8]; unpack8(*(const LAS u32x4*)(scr + c0 * 2), f0); unpack8(*(const LAS u32x4*)(scr + 8192 + c0 * 2), f1);
        const f32x4 ga = *(const GAS f32x4*)(sc_nw + c0), gb = *(const GAS f32x4*)(sc_nw + c0 + 4); const float g[8] = {ga.x, ga.y, ga.z, ga.w, gb.x, gb.y, gb.z, gb.w};
#pragma unroll
        for (int j = 0; j < 8; ++j) { f0[j] *= rs0 * g[j]; f1[j] *= rs1 * g[j]; }
        *(GAS u32x4*)(yrow + D_SSD + i * 512) = pack8(f0); *(GAS u32x4*)(yrow + D_MIX + D_SSD + i * 512) = pack8(f1); }
    float gs0 = SSQ[(size_t)row0 * NH + lane], gs1 = SSQ[(size_t)(row0 + 1) * NH + lane];
    gs0 += __shfl_xor(gs0, 1); gs0 += __shfl_xor(gs0, 2); gs0 += __shfl_xor(gs0, 4); gs1 += __shfl_xor(gs1, 1); gs1 += __shfl_xor(gs1, 2); gs1 += __shfl_xor(gs1, 4);
#pragma unroll 2
    for (int i = 0; i < 8; ++i) { const int c0 = (i * 64 + lane) * 8;
        const float rg0 = 1.0f / sqrtf(__shfl(gs0, i * 8) * (1.f / 512.f) + EPS), rg1 = 1.0f / sqrtf(__shfl(gs1, i * 8) * (1.f / 512.f) + EPS);
        float f0[8], f1[8]; unpack8(*(const GAS u32x4*)(yrow + i * 512), f0); unpack8(*(const GAS u32x4*)(yrow + D_MIX + i * 512), f1);
        const f32x4 ga = *(const GAS f32x4*)(ssd_nw + c0), gb = *(const GAS f32x4*)(ssd_nw + c0 + 4); const float g[8] = {ga.x, ga.y, ga.z, ga.w, gb.x, gb.y, gb.z, gb.w};
#pragma unroll
        for (int j = 0; j < 8; ++j) { f0[j] *= rg0 * g[j]; f1[j] *= rg1 * g[j]; }
        *(GAS u32x4*)(yrow + i * 512) = pack8(f0); *(GAS u32x4*)(yrow + D_MIX + i * 512) = pack8(f1); }
}

constexpr int KROW = 272;
constexpr int RT_KH = 0, RT_KL = 128 * KROW, RT_LST = 2 * 128 * KROW, RT_END = RT_LST + 2 * 128 * 16 * 4;
static_assert(RT_END <= RING_BYTES, "route lds");
__device__ __forceinline__ unsigned ord_enc(float s) { const unsigned b = __float_as_uint(s); return (b & 0x80000000u) ? ~b : (b | 0x80000000u); }
__device__ __forceinline__ float ord_dec(unsigned p) { const unsigned o = p & ~127u; return __uint_as_float((o & 0x80000000u) ? (o & 0x7fffffffu) : ~o); }
__device__ __forceinline__ void cex_desc(unsigned& a, unsigned& b) { const unsigned hi = a > b ? a : b, lo = a > b ? b : a; a = hi; b = lo; }
__device__ __forceinline__ void bitonic_merge16_desc(unsigned (&v)[16]) {
#pragma unroll
    for (int j = 8; j > 0; j >>= 1)
#pragma unroll
        for (int i = 0; i < 16; ++i) if ((i & j) == 0) cex_desc(v[i], v[i | j]);
}
__device__ __forceinline__ void bitonic_sort16_desc(unsigned (&v)[16]) {
#pragma unroll
    for (int k = 2; k <= 16; k <<= 1)
#pragma unroll
        for (int j = k >> 1; j > 0; j >>= 1)
#pragma unroll
            for (int i = 0; i < 16; ++i) if ((i & j) == 0) { if ((i & k) == 0) cex_desc(v[i], v[i | j]); else cex_desc(v[i | j], v[i]); }
}
__device__ __forceinline__ void top16_merge_desc(unsigned (&a)[16], const unsigned (&b)[16]) {
#pragma unroll
    for (int j = 0; j < 16; ++j) a[j] = a[j] > b[15 - j] ? a[j] : b[15 - j];
    bitonic_merge16_desc(a);
}
__device__ __forceinline__ void route_wg(LAS unsigned char* lds, int nun, int pm0, int ph0, int pm1, int ph1, const float* Q, int* IDX, float* GATE, int tid, int wave, int lane) {
    LAS unsigned* lst = (LAS unsigned*)lds;
    const int kq = lane >> 4, lr = lane & 15;
    __syncthreads();
#pragma unroll 1
    for (int ps = 0; ps < 2 * nun; ++ps) { const int un = ps >> 1, pm = un ? pm1 : pm0, h = un ? ph1 : ph0, ltok = ps * 128 + wave * 16 + lr;
        const float* qp = Q + (size_t)(pm * 256 + (ps & 1) * 128 + wave * 16 + lr) * PQ + h * 256 + kq * 4;
        f32x4 sc[2][8];
#pragma unroll
        for (int c = 0; c < 2; ++c)
#pragma unroll
            for (int t = 0; t < 8; ++t) sc[c][t] = *(const GAS f32x4*)(qp + c * 128 + 16 * t);
#pragma unroll
        for (int c = 0; c < 2; ++c) {
            unsigned L[16], Hh[16];
#pragma unroll
            for (int t = 0; t < 4; ++t)
#pragma unroll
                for (int r = 0; r < 4; ++r) { L[4 * t + r] = (ord_enc(sc[c][t][r]) & ~127u) | (unsigned)(127 - (16 * t + 4 * kq + r)); Hh[4 * t + r] = (ord_enc(sc[c][t + 4][r]) & ~127u) | (unsigned)(127 - (16 * (t + 4) + 4 * kq + r)); }
            bitonic_sort16_desc(L); bitonic_sort16_desc(Hh);
            top16_merge_desc(L, Hh);
#pragma unroll
            for (int sh = 16; sh <= 32; sh <<= 1) { unsigned P[16];
#pragma unroll
                for (int j = 0; j < 16; ++j) P[j] = (unsigned)__shfl_xor((int)L[j], sh);
                top16_merge_desc(L, P); }
            if (kq == 0) { LAS u32x4* lp = (LAS u32x4*)(lst + (c * 512 + ltok) * 16);
                lp[0] = (u32x4){L[0], L[1], L[2], L[3]}; lp[1] = (u32x4){L[4], L[5], L[6], L[7]}; lp[2] = (u32x4){L[8], L[9], L[10], L[11]}; lp[3] = (u32x4){L[12], L[13], L[14], L[15]}; }
        }
    }
    __syncthreads();
    if (tid < 256 * nun) { const int un = tid >> 8, h = un ? ph1 : ph0; const size_t gtok = (size_t)((un ? pm1 : pm0) * 256 + (tid & 255));
        const LAS unsigned* l0 = lst + (0 * 512 + tid) * 16; const LAS unsigned* l1 = lst + (1 * 512 + tid) * 16;
        float fr[16]; const float s10 = ord_dec(l1[0]);
#pragma unroll
        for (int a = 0; a < 16; ++a) fr[a] = ord_dec(l0[a]) + s10;
        unsigned long long P = 0ull; float bs[16]; int be[16];
#pragma unroll
        for (int k = 0; k < 16; ++k) {
            float best = fr[0]; int ba = 0;
#pragma unroll
            for (int a = 1; a < 16; ++a) { const bool gt = fr[a] > best; best = gt ? fr[a] : best; ba = gt ? a : ba; }
            const int pb = (int)((P >> (4 * ba)) & 15ull);
            const unsigned p0 = l0[ba], p1 = l1[pb];
            bs[k] = best; be[k] = (127 - (int)(p0 & 127u)) * PK + (127 - (int)(p1 & 127u));
            const int nb2 = pb + 1; float nf = -3.0e38f;
            if (nb2 < 16) { P += 1ull << (4 * ba); nf = ord_dec(p0) + ord_dec(l1[nb2]); }
#pragma unroll
            for (int a = 0; a < 16; ++a) fr[a] = (a == ba) ? nf : fr[a];
        }
        float e[16], sum = 0.f;
#pragma unroll
        for (int k = 0; k < 16; ++k) { e[k] = __expf(bs[k] - bs[0]); sum += e[k]; }
        const float inv = 1.0f / sum;
        int* ip = IDX + gtok * HK + h * 16; float* gp = GATE + gtok * HK + h * 16;
#pragma unroll
        for (int k = 0; k < 16; ++k) { ip[k] = be[k]; gp[k] = e[k] * inv; }
    }
}

__device__ __forceinline__ float gelu_erf(float v) { return 0.5f * v * (1.0f + erff(v * 0.70710678118654752f)); }
constexpr size_t SLICE_BYTES = (size_t)NEXP * 128;
__device__ __forceinline__ void quant_row_fp8(const float* src, unsigned char* dst, float* scale, int lane) {
    const GAS f32x4* xr = (const GAS f32x4*)src + lane;
    f32x4 v[16]; float am = 0.f;
#pragma unroll
    for (int j = 0; j < 16; ++j) { v[j] = __builtin_nontemporal_load(xr + 64 * j); am = fmaxf(am, fmaxf(fmaxf(fabsf(v[j].x), fabsf(v[j].y)), fmaxf(fabsf(v[j].z), fabsf(v[j].w)))); }
#pragma unroll
    for (int o = 1; o < 64; o <<= 1) am = fmaxf(am, __shfl_xor(am, o));
    const float sc = am > 0.f ? am * (1.0f / 224.0f) : 1.0f, inv = 1.0f / sc;
    GAS unsigned char* o1 = (GAS unsigned char*)dst + (size_t)(lane >> 5) * SLICE_BYTES + (lane & 31) * 4;
#pragma unroll
    for (int j = 0; j < 16; ++j) { int p = __builtin_amdgcn_cvt_pk_fp8_f32(v[j].x * inv, v[j].y * inv, 0, false); p = __builtin_amdgcn_cvt_pk_fp8_f32(v[j].z * inv, v[j].w * inv, p, true); *(GAS unsigned*)(o1 + (size_t)(2 * j) * SLICE_BYTES) = (unsigned)p; }
    if (lane == 0) *scale = sc;
}
__device__ __forceinline__ void quant_row_i8(const float* src, unsigned char* dst, float* scale, int lane) {
    const GAS f32x4* xr = (const GAS f32x4*)src + lane;
    f32x4 v[16]; float am = 0.f;
#pragma unroll
    for (int j = 0; j < 16; ++j) { v[j] = __builtin_nontemporal_load(xr + 64 * j); am = fmaxf(am, fmaxf(fmaxf(fabsf(v[j].x), fabsf(v[j].y)), fmaxf(fabsf(v[j].z), fabsf(v[j].w)))); }
#pragma unroll
    for (int o = 1; o < 64; o <<= 1) am = fmaxf(am, __shfl_xor(am, o));
    const float sc = am > 0.f ? am * (1.0f / 127.0f) : 1.0f, inv = 1.0f / sc;
    GAS unsigned char* o1 = (GAS unsigned char*)dst + (size_t)(lane >> 5) * SLICE_BYTES + (lane & 31) * 4;
#pragma unroll
    for (int j = 0; j < 16; ++j) *(GAS unsigned*)(o1 + (size_t)(2 * j) * SLICE_BYTES) = pack_i8x4(v[j].x * inv, v[j].y * inv, v[j].z * inv, v[j].w * inv);
    if (lane == 0) *scale = sc;
}
__device__ __forceinline__ void rs16(const float (&d)[16], int bit, int sh1, int sh2, int sh3, float (&out)[2]) {
    float n8[8], n4[4];
#pragma unroll
    for (int m = 0; m < 8; ++m) { const bool up = (bit & sh1) != 0; const float mine = up ? d[8 + m] : d[m], theirs = up ? d[m] : d[8 + m]; n8[m] = mine + __shfl_xor(theirs, sh1); }
#pragma unroll
    for (int m = 0; m < 4; ++m) { const bool up = (bit & sh2) != 0; const float mine = up ? n8[4 + m] : n8[m], theirs = up ? n8[m] : n8[4 + m]; n4[m] = mine + __shfl_xor(theirs, sh2); }
#pragma unroll
    for (int m = 0; m < 2; ++m) { const bool up = (bit & sh3) != 0; const float mine = up ? n4[2 + m] : n4[m], theirs = up ? n4[m] : n4[2 + m]; out[m] = mine + __shfl_xor(theirs, sh3); }
}
__device__ __forceinline__ void peer_block(LAS unsigned char* wl, int tok0, const unsigned char* XQ, const float* XS, const unsigned char* U8, const unsigned char* V8, const float* SU, const float* SV, const int* IDX, const float* GATE, const bf16* HB, float* HO, bf16* X2, const float* wfin, int lane) {
    const int rg = lane >> 3, c = lane & 7; const unsigned cofs = (unsigned)c * 16u;
    LAS unsigned short* idxL = (LAS unsigned short*)wl; LAS float* actL = (LAS float*)(wl + 2048); LAS float* ssqL = (LAS float*)(wl + 6144);
#pragma unroll
    for (int j = 0; j < 8; ++j) {
#pragma unroll
        for (int hh = 0; hh < 2; ++hh) { const int k = hh * 64 + lane; idxL[(j * 8 + (k & 7)) * 16 + (k >> 3)] = (unsigned short)IDX[(size_t)(tok0 + j) * HK + k]; }
        *(LAS f32x2*)(actL + j * 128 + lane * 2) = (f32x2){0.f, 0.f}; ssqL[j * 64 + lane] = 0.f; }
    LDS_WAIT();
    for (int urep = 0; urep < NREP(8); ++urep) {
    if (urep) { for (int j = 0; j < 8; ++j) *(LAS f32x2*)(actL + j * 128 + lane * 2) = (f32x2){0.f, 0.f}; LDS_WAIT(); }
#define PB_LOAD(buf, tab, it) do { const int _s = (it) >> 3, _j = (it) & 7; const GAS unsigned char* _base = (const GAS unsigned char*)(tab) + (size_t)_s * SLICE_BYTES; \
        const u32x4 _ia = *(const LAS u32x4*)(idxL + (_j * 8 + rg) * 16), _ib = *(const LAS u32x4*)(idxL + (_j * 8 + rg) * 16 + 8); const unsigned _iw[8] = {_ia.x, _ia.y, _ia.z, _ia.w, _ib.x, _ib.y, _ib.z, _ib.w}; \
        _Pragma("unroll") for (int _i = 0; _i < 16; ++_i) { const unsigned _e = (_iw[_i >> 1] >> (16 * (_i & 1))) & 0xffffu; buf[_i] = *(const GAS u32x4*)(_base + (_e * 128u + cofs)); } } while (0)
    LAS unsigned char* xsL = wl + 6144; u32x4 xg;
#define PB_XSLICE(s) do { const int _ss = (s) < 32 ? (s) : 31; xg = __builtin_nontemporal_load((const GAS u32x4*)(XQ + (size_t)(tok0 + (lane >> 3)) * D + _ss * 128 + (lane & 7) * 16)); } while (0)
#define PB_XLOAD(xa, it) do { if (((it) & 7) == 0) { *(LAS u32x4*)(xsL + (((it) >> 3) & 1) * 1024 + lane * 16) = xg; LDS_WAIT(); } \
        if (((it) & 7) == 7) PB_XSLICE(((it) >> 3) + 1); \
        xa = *(const LAS u32x4*)(xsL + (((it) >> 3) & 1) * 1024 + ((it) & 7) * 128 + c * 16); } while (0)
#define PB_UCOMP(buf, xa, it) do { const int _j = (it) & 7; float _d[16]; \
        _Pragma("unroll") for (int _i = 0; _i < 16; ++_i) { int _a = __builtin_amdgcn_sdot4((int)buf[_i].x, (int)xa.x, 0, false); _a = __builtin_amdgcn_sdot4((int)buf[_i].y, (int)xa.y, _a, false); \
            _a = __builtin_amdgcn_sdot4((int)buf[_i].z, (int)xa.z, _a, false); _a = __builtin_amdgcn_sdot4((int)buf[_i].w, (int)xa.w, _a, false); _d[_i] = (float)_a; } \
        float _n2[2]; rs16(_d, c, 4, 2, 1, _n2); \
        LAS f32x2* _pp = (LAS f32x2*)(actL + _j * 128 + lane * 2); f32x2 _p = *_pp; _p.x += _n2[0]; _p.y += _n2[1]; *_pp = _p; } while (0)
    {   u32x4 bufA[16], bufB[16], xaA, xaB;
        PB_XSLICE(0); PB_XLOAD(xaA, 0); PB_LOAD(bufA, U8, 0);
#pragma unroll 1
        for (int it = 0; it < 256; it += 2) {
            PB_XLOAD(xaB, it + 1); PB_LOAD(bufB, U8, it + 1);
            __builtin_amdgcn_sched_barrier(0);
            PB_UCOMP(bufA, xaA, it);
            __builtin_amdgcn_sched_barrier(0);
            PB_XLOAD(xaA, (it + 2) & 255); PB_LOAD(bufA, U8, (it + 2) & 255);
            __builtin_amdgcn_sched_barrier(0);
            PB_UCOMP(bufB, xaB, it + 1);
            __builtin_amdgcn_sched_barrier(0);
        }
    }
    }
#pragma unroll 1
    for (int j = 0; j < 8; ++j) { const int tok = tok0 + j, k0 = 16 * c + rg, k1 = k0 + 8;
        LAS f32x2* pp = (LAS f32x2*)(actL + j * 128 + lane * 2); const f32x2 p = *pp;
        const unsigned ew = *(const LAS unsigned*)(idxL + (j * 8 + rg) * 16 + 2 * c); const int e0 = (int)(ew & 0xffffu), e1 = (int)(ew >> 16);
        const float g0 = GATE[(size_t)tok * HK + k0], g1 = GATE[(size_t)tok * HK + k1];
        const float xs = XS[tok]; const float a0 = gelu_erf(p.x * xs * SU[e0]) * g0 * SV[e0], a1 = gelu_erf(p.y * xs * SU[e1]) * g1 * SV[e1];
        *pp = (f32x2){a0, a1}; }
    LDS_WAIT();
    for (int vrep = 0; vrep < NREP(9); ++vrep) {
    if (vrep) { for (int j = 0; j < 8; ++j) ssqL[j * 64 + lane] = 0.f; LDS_WAIT(); }
#define PB_HOFF(it) ((size_t)(tok0 + ((it) & 7)) * D + ((it) >> 3) * 128 + 16 * c + 2 * rg)
#define PB_VCOMP(buf, it) do { const int _j = (it) & 7; \
        const LAS f32x4* _ap = (const LAS f32x4*)(actL + (_j * 8 + rg) * 16); const f32x4 _a0 = _ap[0], _a1 = _ap[1], _a2 = _ap[2], _a3 = _ap[3]; \
        const float _av[16] = {_a0.x, _a0.y, _a0.z, _a0.w, _a1.x, _a1.y, _a1.z, _a1.w, _a2.x, _a2.y, _a2.z, _a2.w, _a3.x, _a3.y, _a3.z, _a3.w}; \
        f32x2 _o[8]; _Pragma("unroll") for (int _m = 0; _m < 8; ++_m) _o[_m] = (f32x2){0.f, 0.f}; \
        _Pragma("unroll") for (int _i = 0; _i < 16; ++_i) { const f32x2 _a2v = (f32x2){_av[_i], _av[_i]}; const unsigned _w[4] = {buf[_i].x, buf[_i].y, buf[_i].z, buf[_i].w}; \
            _Pragma("unroll") for (int _q = 0; _q < 4; ++_q) { const f32x2 _lo = __builtin_amdgcn_cvt_pk_f32_fp8((int)_w[_q], false), _hi = __builtin_amdgcn_cvt_pk_f32_fp8((int)_w[_q], true); _o[2 * _q] += _a2v * _lo; _o[2 * _q + 1] += _a2v * _hi; } } \
        const float _ov[16] = {_o[0].x, _o[0].y, _o[1].x, _o[1].y, _o[2].x, _o[2].y, _o[3].x, _o[3].y, _o[4].x, _o[4].y, _o[5].x, _o[5].y, _o[6].x, _o[6].y, _o[7].x, _o[7].y}; \
        float _n2[2]; rs16(_ov, lane, 32, 16, 8, _n2); \
        *(GAS unsigned*)(X2 + PB_HOFF(it)) = cvtpk(_n2[0], _n2[1]); } while (0)
    {   u32x4 bufA[16], bufB[16];
        PB_LOAD(bufA, V8, 0);
#pragma unroll 1
        for (int it = 0; it < 256; it += 2) {
            PB_LOAD(bufB, V8, it + 1);
            __builtin_amdgcn_sched_barrier(0);
            PB_VCOMP(bufA, it);
            __builtin_amdgcn_sched_barrier(0);
            if (it + 2 < 256) { PB_LOAD(bufA, V8, it + 2); }
            __builtin_amdgcn_sched_barrier(0);
            PB_VCOMP(bufB, it + 1);
            __builtin_amdgcn_sched_barrier(0);
        }
    }
    }
#undef PB_LOAD
#undef PB_XLOAD
#undef PB_XSLICE
#undef PB_UCOMP
#undef PB_HOFF
#undef PB_VCOMP
    LDS_WAIT();
    asm volatile("s_waitcnt vmcnt(0)" ::: "memory");
    f32x4 gfin[16];
    { int lq = lane; asm volatile("" : "+v"(lq));
#pragma unroll
    for (int q = 0; q < 16; ++q) gfin[q] = *((const GAS f32x4*)wfin + lq + 64 * q); }
#pragma unroll 1
    for (int j = 0; j < 8; ++j) { const size_t ro = (size_t)(tok0 + j) * D;
        const GAS u32x2* sp = (const GAS u32x2*)(X2 + ro) + lane; const GAS u32x2* hp = (const GAS u32x2*)(HB + ro) + lane;
        f32x4 xv[16]; float ss = 0.f;
#pragma unroll
        for (int q = 0; q < 16; ++q) { const u32x2 v = sp[64 * q], hv = __builtin_nontemporal_load(hp + 64 * q);
            xv[q] = (f32x4){bflo(v.x) + bflo(hv.x), bfhi(v.x) + bfhi(hv.x), bflo(v.y) + bflo(hv.y), bfhi(v.y) + bfhi(hv.y)}; ss += (xv[q].x * xv[q].x + xv[q].y * xv[q].y) + (xv[q].z * xv[q].z + xv[q].w * xv[q].w); }
        const float rs = 1.0f / sqrtf(wave_sum(ss) * (1.f / D) + EPS);
        GAS f32x4* rp = (GAS f32x4*)(HO + ro) + lane;
#pragma unroll
        for (int q = 0; q < 16; ++q) { const f32x4 g = gfin[q]; rp[64 * q] = (f32x4){xv[q].x * rs * g.x, xv[q].y * rs * g.y, xv[q].z * rs * g.z, xv[q].w * rs * g.w}; } }
}

struct Args { const float* in[18]; float* out; unsigned char* ws; int ph_lo, ph_hi, li, pad; };
__global__ void __launch_bounds__(NWAVES * 64, 2) mk_fwd(Args args) {
    extern __shared__ __attribute__((aligned(16))) unsigned char lds_raw[];
    LAS unsigned char* lds = (LAS unsigned char*)lds_raw;
    volatile LAS unsigned* MISC = (volatile LAS unsigned*)(lds + MISC_OFF);
    const int tid = threadIdx.x, lane = tid & 63, wave = __builtin_amdgcn_readfirstlane(tid >> 6);
    const int G = gridDim.x, bid = blockIdx.x;
    const int vcu = (G % 8 == 0) ? (bid % 8) * (G / 8) + bid / 8 : bid;
    unsigned char* ws = args.ws;
    gu32* ctl = (gu32*)(ws + WS_CTL);
    const float* x = args.in[0]; const float* w_in = args.in[1]; const float* ssd_conv_w = args.in[2]; const float* ssd_conv_b = args.in[3]; const float* ssd_dt_bias = args.in[4];
    const float* ssd_a_log = args.in[5]; const float* ssd_d = args.in[6]; const float* ssd_norm_w = args.in[7]; const float* sc_conv_w = args.in[8]; const float* sc_norm_w = args.in[9];
    const float* w_out = args.in[10]; const float* norm_mix_w = args.in[11]; const float* norm_ffn_w = args.in[12]; const float* w_query = args.in[13]; const float* sub_keys = args.in[14];
    const float* peer_u = args.in[15]; const float* peer_v = args.in[16]; const float* norm_final_w = args.in[17];
    float* out = args.out;
    bf16* XN = (bf16*)(ws + WS_XN); bf16* WIN = (bf16*)(ws + WS_WIN); bf16* WOUT = (bf16*)(ws + WS_WOUT); bf16* WQ = (bf16*)(ws + WS_WQ); bf16* Y = (bf16*)(ws + WS_Y); bf16* PROJ = (bf16*)(ws + WS_PROJ);
    unsigned char* U8 = ws + WS_U8; unsigned char* V8 = ws + WS_V8; float* SU = (float*)(ws + WS_SU); float* SV = (float*)(ws + WS_SV); unsigned char* XQ = ws + WS_XQ; float* XS = (float*)(ws + WS_XS); float* RS = XS + 16384; float* QF = (float*)(ws + WS_Q); float* SSQ = (float*)(ws + WS_SSQ); bf16* HB = (bf16*)(ws + WS_HB); bf16* KHI = (bf16*)(ws + WS_KH); bf16* KLO = KHI + 8 * 2 * 128 * 128;
    int* IDX = (int*)(ws + WS_IDX); float* GATE = (float*)(ws + WS_GATE);

    for (int u = tid; u < (LDS_BYTES - LDSCTL_OFF) / 4; u += NWAVES * 64) ((LAS unsigned*)(lds + LDSCTL_OFF))[u] = 0u;
    __syncthreads();
    XcdBarrier bar; bar.bar = (unsigned*)(ctl + CW_BAR); bar.x = 0; bar.st = nullptr;
    if (N_LAUNCHES == 1) bar = xcd_barrier_post((unsigned*)(ctl + CW_BAR), MISC + 8);
#define GRID_BAR() do { if (N_LAUNCHES == 1) xcd_barrier(bar); } while (0)
    const int lo = args.ph_lo, hi = args.ph_hi;
#ifndef PH_MASK
#define PH_MASK 0x1ff
#endif
#define PH_EN(k) (((PH_MASK) >> (k)) & 1)

#define IN(k) (lo <= (k) && (k) < hi)
#define BOTH(k) (IN(k) && IN((k) + 1 + ((k) == 6)))
    const int gw = vcu * NWAVES + wave, NGW = G * NWAVES;

    if (PH_EN(0) && IN(0)) { for (int rep = 0; rep < NREP(0); ++rep) {
        LAS float* scr = (LAS float*)(lds + RING_OFF + wave * 16384);
        constexpr int I_IN = (D / 64) * (NPROJ / 32);
        for (int it = gw; it < I_IN; it += NGW) p0_transpose_item(w_in, D, NPROJ, WIN, true, nullptr, scr, it, lane);
        { GAS v4u* z = (GAS v4u*)(WIN + (size_t)NPROJ * D); const size_t n16 = (size_t)(NP - NPROJ) * D * 2 / 16;
          for (size_t i = (size_t)bid * 512 + tid; i < n16; i += (size_t)G * 512) z[i] = (v4u){0u, 0u, 0u, 0u}; }
        for (int m = gw; m < M; m += NGW) rms_row_to_bf16(x + (size_t)m * D, norm_mix_w, XN + (size_t)m * D, lane);
        __syncthreads(); }
        if (BOTH(0)) GRID_BAR();
    }
    if (PH_EN(1) && IN(1)) {
        pg8::Gemm g{XN, WIN, M, NP, D}; pg8::StaticOrder S; S.init(M, NP, G, bid);
        pg8::EpiProj E{PROJ, PP, CH_TILE0, CH_TILES, O_U};
        pg8::gemm_phase<pg8::EpiProj, pg8::StaticOrder, PG8_ALIGN, PG8_SP2>(lds + RING_OFF, g, S, E);
        if (NREP(1) == 2) { __syncthreads(); pg8::gemm_phase<pg8::EpiProj, pg8::StaticOrder, PG8_ALIGN, PG8_SP2>(lds + RING_OFF, g, S, E); }
        {
            const int nwg = (M / 256) * (NP / 256), rem = nwg % G, first = rem ? rem : 0, nb = G - first;
            if (bid >= first) {
                __syncthreads();
                LAS float* scr = (LAS float*)(lds + RING_OFF + wave * 16384);
                const int fi0 = bid - first;
                for (int wt = fi0; wt < 16 * (D / 512); wt += nb) { const int kb = wt >> 3, d = (wt & 7) * 512 + tid;
                    LAS float* kl = (LAS float*)(lds + RING_OFF);
                    for (int i = tid; i < 128 * 128 / 4; i += 512) ((LAS f32x4*)kl)[i] = ((const GAS f32x4*)(sub_keys + (size_t)kb * 16384))[i];
                    float wq[128]; const float gd = norm_ffn_w[d];
#pragma unroll
                    for (int jj = 0; jj < 32; ++jj) { const f32x4 t = *(const GAS f32x4*)(w_query + (size_t)d * PQ + kb * 128 + 4 * jj); wq[4 * jj] = t.x * gd; wq[4 * jj + 1] = t.y * gd; wq[4 * jj + 2] = t.z * gd; wq[4 * jj + 3] = t.w * gd; }
                    __syncthreads();
#pragma unroll 1
                    for (int k = 0; k < 128; ++k) { float a0 = 0.f, a1 = 0.f;
#pragma unroll
                        for (int jj = 0; jj < 32; ++jj) { const f32x4 kk = *(const LAS f32x4*)(kl + k * 128 + 4 * jj); a0 += wq[4 * jj] * kk.x + wq[4 * jj + 2] * kk.z; a1 += wq[4 * jj + 1] * kk.y + wq[4 * jj + 3] * kk.w; }
                        ((GAS unsigned short*)WQ)[(size_t)(kb * 128 + k) * D + d] = (unsigned short)(cvtpk(a0 + a1, 0.f) & 0xffffu); }
                    __syncthreads(); }
                constexpr int I_OUT = (D_MIX / 64) * (D / 32);
                const int gwt = (bid - first) * NWAVES + wave, ngwt = nb * NWAVES;
                for (int it = gwt; it < I_OUT; it += ngwt) p0_transpose_item(w_out, D_MIX, D, WOUT, false, nullptr, scr, it, lane);
            }
        }
        {
            unsigned* tk = (unsigned*)(ctl + CW_TICKET);
            for (;;) { unsigned t0 = 0; if (lane == 0) t0 = xb_add(tk, 1u); t0 = __builtin_amdgcn_readfirstlane(t0); if (t0 >= 2u * NEXP / 4u) break;
#pragma unroll 1
                for (int k = 0; k < 4; ++k) { const int r = (int)t0 * 4 + k; const bool second = r >= NEXP; const int e = second ? r - NEXP : r;
                    if (second) quant_row_fp8(peer_v + (size_t)e * D, V8 + (size_t)e * 128, SV + e, lane); else quant_row_i8(peer_u + (size_t)e * D, U8 + (size_t)e * 128, SU + e, lane); } }
        }
        if (BOTH(1)) GRID_BAR();
    }
    if (PH_EN(2) && IN(2)) {
        bf16* CONV = (bf16*)(ws + WS_CONV);
        for (int rep = 0; rep < NREP(2); ++rep) {
        for (int prep = 0; prep < NREP(10); ++prep) conv_prepass(PROJ, ssd_conv_w, ssd_conv_b, CONV, vcu * 512 + tid, G * 512);
        GRID_BAR();
        for (int u = bid; u < NB * NH; u += G) {
            const int xc = u & 7, j = u >> 3, bg = xc * 4 + (j >> 3), hh = j & 7, b = bg >> 3, gq = bg & 7, h = gq * 8 + hh;
            ssd_unit(lds, b, h, PROJ, CONV, ssd_dt_bias, ssd_a_log, ssd_d, Y, SSQ, tid, wave, lane);
        }
        }
        if (BOTH(2)) GRID_BAR();
    }
    if (PH_EN(3) && IN(3)) {
        for (int m2 = gw; m2 < M / 2; m2 += NGW) p3_rows2(2 * m2, PROJ, sc_conv_w, sc_norm_w, ssd_norm_w, SSQ, Y, lds + RING_OFF + wave * 16384, lane);
        if (BOTH(3)) GRID_BAR();
    }
    if (PH_EN(4) && IN(4)) {
        pg8::Gemm g{Y, WOUT, M, D, D_MIX}; pg8::StaticOrder S; S.init(M, D, G, bid);
        pg8::EpiResBf16 E{HB, x, D};
        pg8::gemm_phase<pg8::EpiResBf16, pg8::StaticOrder, PG8_ALIGN, PG8_SP2>(lds + RING_OFF, g, S, E);
        if (NREP(4) == 2) { __syncthreads(); pg8::gemm_phase<pg8::EpiResBf16, pg8::StaticOrder, PG8_ALIGN, PG8_SP2>(lds + RING_OFF, g, S, E); }
        if (BOTH(4)) GRID_BAR();
    }
    if (PH_EN(5) && IN(5)) { for (int rep = 0; rep < NREP(5); ++rep) {
        for (int m = gw; m < M; m += NGW) rms_row_to_bf16_i8(HB + (size_t)m * D, norm_ffn_w, RS + m, XQ + (size_t)m * D, XS + m, lane);
        }
        if (BOTH(5)) GRID_BAR();
    }
    if (PH_EN(6) && IN(6)) {
        pg8::Gemm g{HB, WQ, M, PQ, D}; pg8::StaticOrder S; S.init(M, PQ, G, bid);
        pg8::EpiRowScaleF32 E{QF, RS, PQ};
        pg8::gemm_phase<pg8::EpiRowScaleF32, pg8::StaticOrder, PG8_ALIGN, PG8_SP2>(lds + RING_OFF, g, S, E);
        if (NREP(6) == 2) { __syncthreads(); pg8::gemm_phase<pg8::EpiRowScaleF32, pg8::StaticOrder, PG8_ALIGN, PG8_SP2>(lds + RING_OFF, g, S, E); }
        asm volatile("s_waitcnt vmcnt(0)" ::: "memory"); __syncthreads();
        for (int i = 0; ; i += 2) { pg8::Unit u0, u1; if (!S.next(i, u0)) break; const bool two = S.next(i + 1, u1);
            route_wg(lds + RING_OFF, two ? 2 : 1, u0.pm, u0.pn, two ? u1.pm : u0.pm, two ? u1.pn : u0.pn, QF, IDX, GATE, tid, wave, lane); }
        if (BOTH(6)) GRID_BAR();
    }
    if (PH_EN(8) && IN(8)) {
        for (int t8 = bid * NWAVES + wave; t8 < M / 8; t8 += G * NWAVES) peer_block(lds + wave * 8192, t8 * 8, XQ, XS, U8, V8, SU, SV, IDX, GATE, HB, out, (bf16*)(ws + WS_Y), norm_final_w, lane);
    }
#undef IN
#undef BOTH
#undef GRID_BAR
}

extern "C" void kernel_launch(void* const* d_in, const int* in_sizes, int n_in, void* d_out, int out_size, void* d_ws, size_t ws_size, hipStream_t stream) {
    static int grid = 0;
    if (grid == 0) {
        if (n_in != 18 || in_sizes[0] != M * D || out_size != M * D || ws_size < WS_END) { fprintf(stderr, "kernel_launch: unexpected shapes / workspace: n_in %d in0 %d out %d ws %zu (need %zu)\n", n_in, n_in > 0 ? in_sizes[0] : -1, out_size, ws_size, (size_t)WS_END); grid = -1; return; }
        int dev = 0, cus = 0, per_cu = 0;
        if (hipGetDevice(&dev) != hipSuccess || hipDeviceGetAttribute(&cus, hipDeviceAttributeMultiprocessorCount, dev) != hipSuccess) { fprintf(stderr, "kernel_launch: device query failed\n"); grid = -1; return; }
        if (hipFuncSetAttribute((const void*)mk_fwd, hipFuncAttributeMaxDynamicSharedMemorySize, LDS_BYTES) != hipSuccess) { fprintf(stderr, "kernel_launch: hipFuncSetAttribute failed\n"); grid = -1; return; }
        if (hipOccupancyMaxActiveBlocksPerMultiprocessor(&per_cu, (const void*)mk_fwd, NWAVES * 64, LDS_BYTES) != hipSuccess || per_cu < 1)
            fprintf(stderr, "kernel_launch: note: occupancy query reports %d workgroups per CU\n", per_cu);
        (void)hipGetLastError();
        grid = cus;
    }
    if (grid < 0) return;
    if (hipMemsetAsync((char*)d_ws + WS_CTL, 0, CTL_ZERO_BYTES, stream) != hipSuccess) { fprintf(stderr, "kernel_launch: memset failed\n"); return; }
    Args a{};
    for (int i = 0; i < 18; ++i) a.in[i] = (const float*)d_in[i];
    a.out = (float*)d_out; a.ws = (unsigned char*)d_ws;
    for (int li = 0; li < N_LAUNCHES; ++li) {
        a.ph_lo = (N_LAUNCHES == 1) ? 0 : li; a.ph_hi = (N_LAUNCHES == 1) ? NPHASE : li + 1; a.li = li; a.pad = 0;
        hipLaunchKernelGGL(mk_fwd, dim3(grid), dim3(NWAVES * 64), LDS_BYTES, stream, a);
        const hipError_t le = hipPeekAtLastError();
        if (le != hipSuccess) { fprintf(stderr, "kernel_launch: launch %d failed: %s\n", li, hipGetErrorName(le)); break; }
    }
}
```
